# Optimizing an MI355X kernel written in HIP

```python
import math
import jax, jax.numpy as jnp
from jax import lax
import numpy as np

D_MODEL = 1024
BATCH = 8
SEQ = 4096
DEPTH = 4

HEAD_DIM = 64
GMLP_WIDTH = D_MODEL // 4
GMLP_GROUPS = GMLP_WIDTH // HEAD_DIM
GMLP_CHUNK = 128
DSA_WIDTH = 3 * D_MODEL // 8
DSA_HEADS = DSA_WIDTH // HEAD_DIM
DSA_PATTERNS = ((128, 1), (512, 4), (2048, 16))
DSA_BLOCK = 64
GDN_WIDTH = D_MODEL - GMLP_WIDTH - DSA_WIDTH
GDN_HEADS = GDN_WIDTH // HEAD_DIM
GDN_CONV = 5
GDN_CHUNK = 64
ROT_DIM = HEAD_DIM // 4
ROPE_THETA = 500000.0
N_EXPERTS = 16
D_EXPERT = D_MODEL
EC_CAPACITY = 2
PLE_DIM = 256
NORM_EPS = 1e-6
MASK_VALUE = -1e30
IN_SPLITS = (GMLP_WIDTH, GMLP_WIDTH, DSA_WIDTH, DSA_WIDTH, DSA_WIDTH,
             3 * GDN_WIDTH, GDN_WIDTH, 2 * GDN_HEADS, 2 * GDN_HEADS)
IN_WIDTH = sum(IN_SPLITS)
MIX_WIDTH = GMLP_WIDTH + DSA_WIDTH + GDN_WIDTH

kernel_name = 'hybrid_bidir_encoder_block'

F32 = jnp.float32


def rmsnorm(x, g):
    xf = x.astype(F32)
    y = xf * lax.rsqrt(jnp.mean(xf * xf, axis=-1, keepdims=True) + NORM_EPS) * g.astype(F32)
    return y.astype(x.dtype)


def l2norm(x):
    return x * lax.rsqrt(jnp.sum(x * x, axis=-1, keepdims=True) + NORM_EPS)


def partial_rotary(t, positions):
    half = ROT_DIM // 2
    inv_freq = ROPE_THETA ** (-jnp.arange(half, dtype=F32) * 2.0 / ROT_DIM)
    ang = positions.astype(F32)[..., None] * inv_freq
    cos = jnp.cos(ang)[:, :, None, :]
    sin = jnp.sin(ang)[:, :, None, :]
    tf = t.astype(F32)
    x1, x2, rest = tf[..., :half], tf[..., half:ROT_DIM], tf[..., ROT_DIM:]
    out = jnp.concatenate([x1 * cos - x2 * sin, x2 * cos + x1 * sin, rest], axis=-1)
    return out.astype(t.dtype)


def gmlp_spatial_gating(u, v, ln_g, ln_b, w_s, b_s):
    B_, S, _ = u.shape
    u = jax.nn.gelu(u).reshape(B_, S, GMLP_GROUPS, HEAD_DIM)
    vf = jax.nn.gelu(v).astype(F32).reshape(B_, S, GMLP_GROUPS, HEAD_DIM)
    mu = jnp.mean(vf, axis=-1, keepdims=True)
    var = jnp.mean(jnp.square(vf - mu), axis=-1, keepdims=True)
    vn = ((vf - mu) * lax.rsqrt(var + NORM_EPS) * ln_g.astype(F32) + ln_b.astype(F32)).astype(u.dtype)
    vc = vn.reshape(B_, S // GMLP_CHUNK, GMLP_CHUNK, GMLP_GROUPS, HEAD_DIM)
    mixed = jnp.einsum('gij,bcjgd->bcigd', w_s, vc) + b_s.T[None, None, :, :, None]
    return (u * mixed.reshape(B_, S, GMLP_GROUPS, HEAD_DIM)).reshape(B_, S, GMLP_WIDTH)


def dilated_branch(q, k, v, window, dil):
    B_, S, H, Dh = q.shape
    steps = window // (2 * dil)
    L = S // dil
    nb = -(-L // DSA_BLOCK)
    Lp = nb * DSA_BLOCK

    def to_sub(t):
        return t.reshape(B_, L, dil, H, Dh).transpose(0, 2, 3, 1, 4)

    def neighbours(t):
        tp = jnp.pad(t, ((0, 0), (0, 0), (0, 0), (DSA_BLOCK, Lp - L + DSA_BLOCK), (0, 0)))
        tp = tp.reshape(B_, dil, H, nb + 2, DSA_BLOCK, Dh)
        return jnp.concatenate([tp[:, :, :, :-2], tp[:, :, :, 1:-1], tp[:, :, :, 2:]], axis=4)

    qs = to_sub(q)
    qb = jnp.pad(qs, ((0, 0), (0, 0), (0, 0), (0, Lp - L), (0, 0))).reshape(B_, dil, H, nb, DSA_BLOCK, Dh)
    kb, vb = neighbours(to_sub(k)), neighbours(to_sub(v))
    qi = jnp.arange(Lp).reshape(nb, DSA_BLOCK)
    kj = jnp.arange(nb)[:, None] * DSA_BLOCK - DSA_BLOCK + jnp.arange(3 * DSA_BLOCK)[None, :]
    rel = kj[:, None, :] - qi[:, :, None]
    mask = (jnp.abs(rel) <= steps) & (kj[:, None, :] >= 0) & (kj[:, None, :] < L)
    s = jnp.einsum('bxhntc,bxhnsc->bxhnts', qb, kb).astype(F32) * (Dh ** -0.5)
    s = jnp.where(mask, s, MASK_VALUE)
    lse = jax.nn.logsumexp(s, axis=-1)
    pr = jnp.exp(s - lse[..., None]).astype(v.dtype)
    o = jnp.einsum('bxhnts,bxhnsc->bxhntc', pr, vb)
    o = o.reshape(B_, dil, H, Lp, Dh)[:, :, :, :L].transpose(0, 3, 1, 2, 4).reshape(B_, S, H, Dh)
    lse = lse.reshape(B_, dil, H, Lp)[..., :L].transpose(0, 3, 1, 2).reshape(B_, S, H)
    return o, lse


def dilated_attention(q, k, v, positions, q_norm_g, k_norm_g):
    B_, S, _ = q.shape
    heads = lambda t: t.reshape(B_, S, DSA_HEADS, HEAD_DIM)
    q = partial_rotary(rmsnorm(heads(q), q_norm_g), positions)
    k = partial_rotary(rmsnorm(heads(k), k_norm_g), positions)
    v = heads(v)
    outs, lses = [], []
    for window, dil in DSA_PATTERNS:
        o, l = dilated_branch(q, k, v, window, dil)
        outs.append(o)
        lses.append(l)
    wts = jax.nn.softmax(jnp.stack(lses), axis=0).astype(v.dtype)
    o = jnp.einsum('pbsh,pbshd->bshd', wts, jnp.stack(outs))
    return o.reshape(B_, S, DSA_WIDTH)


def centred_depthwise_conv(x, w):
    K = w.shape[0]
    return lax.conv_general_dilated(x, w[:, None, :].astype(x.dtype), window_strides=(1,),
                                    padding=[(K // 2, K // 2)],
                                    dimension_numbers=('NWC', 'WIO', 'NWC'),
                                    feature_group_count=x.shape[-1])


def gated_delta_chunked(q, k, v, g, beta):
    B_, H, S, Dk = k.shape
    Dv = v.shape[-1]
    C = GDN_CHUNK
    N = S // C
    chunk = lambda t: t.reshape((B_, H, N, C) + t.shape[3:])
    qc, kc, vc = chunk(q * (Dk ** -0.5)), chunk(k), chunk(v)
    gc = jnp.cumsum(chunk(g), axis=-1)
    bc = chunk(beta)
    incl = jnp.tril(jnp.ones((C, C), bool))
    strict = jnp.tril(jnp.ones((C, C), bool), -1)
    decay = jnp.exp(jnp.where(incl, gc[..., :, None] - gc[..., None, :], -jnp.inf))
    k_beta = kc * bc[..., None]
    lower = jnp.where(strict, jnp.einsum('bhntd,bhnsd->bhnts', k_beta, kc) * decay, 0.0)
    eye = jnp.eye(C, dtype=F32)
    t_inv = lax.linalg.triangular_solve(lower + eye, jnp.broadcast_to(eye, lower.shape),
                                        left_side=True, lower=True, unit_diagonal=True)
    u = t_inv @ (vc * bc[..., None])
    w = t_inv @ (k_beta * jnp.exp(gc)[..., None])
    qk = jnp.where(incl, jnp.einsum('bhntd,bhnsd->bhnts', qc, kc) * decay, 0.0)

    def step(state, inp):
        q_n, k_n, u_n, w_n, g_n, qk_n = inp
        v_new = u_n - w_n @ state
        o_n = (q_n * jnp.exp(g_n)[..., None]) @ state + qk_n @ v_new
        g_last = g_n[..., -1:]
        state = state * jnp.exp(g_last)[..., None] + jnp.einsum(
            'bhtd,bhte->bhde', k_n * jnp.exp(g_last - g_n)[..., None], v_new)
        return state, o_n

    xs = tuple(jnp.moveaxis(t, 2, 0) for t in (qc, kc, u, w, gc, qk))
    _, o = lax.scan(step, jnp.zeros((B_, H, Dk, Dv), F32), xs)
    return jnp.moveaxis(o, 0, 2).reshape(B_, H, S, Dv)


def gated_deltanet(qkv, gate, a, b, conv_w, a_log, dt_bias, o_norm_g):
    B_, S, _ = qkv.shape
    out_dtype = qkv.dtype
    qkv = jax.nn.silu(centred_depthwise_conv(qkv, conv_w))
    q, k, v = jnp.split(qkv, 3, axis=-1)
    heads = lambda t: t.reshape(B_, S, GDN_HEADS, HEAD_DIM).transpose(0, 2, 1, 3).astype(F32)
    q, k, v = l2norm(heads(q)), l2norm(heads(k)), heads(v)
    a = a.astype(F32).reshape(B_, S, 2, GDN_HEADS).transpose(2, 0, 3, 1)
    b = b.astype(F32).reshape(B_, S, 2, GDN_HEADS).transpose(2, 0, 3, 1)
    g = -jnp.exp(a_log.astype(F32))[:, None, :, None] * jax.nn.softplus(a + dt_bias.astype(F32)[:, None, :, None])
    beta = jax.nn.sigmoid(b)
    o_f = gated_delta_chunked(q, k, v, g[0], beta[0])
    flip = lambda t: jnp.flip(t, axis=2)
    o_b = flip(gated_delta_chunked(flip(q), flip(k), flip(v), flip(g[1]), flip(beta[1])))
    o = (o_f + o_b).transpose(0, 2, 1, 3)
    o = rmsnorm(o, o_norm_g) * jax.nn.silu(gate.astype(F32).reshape(B_, S, GDN_HEADS, HEAD_DIM))
    return o.reshape(B_, S, GDN_WIDTH).astype(out_dtype)


def expert_choice_ffn(h, w_router, w_gate, w_up, w_down):
    B_, S, D = h.shape
    cap = EC_CAPACITY * S // N_EXPERTS
    logits = jnp.einsum('bsd,de->bse', h, w_router).astype(F32)
    aff = jax.nn.softmax(logits, axis=-1)
    gate, idx = lax.top_k(aff.transpose(0, 2, 1), cap)
    xe = jax.vmap(lambda hb, ib: hb[ib])(h, idx)
    hid = jax.nn.silu(jnp.einsum('becd,edf->becf', xe, w_gate)) * jnp.einsum('becd,edf->becf', xe, w_up)
    ye = jnp.einsum('becf,efd->becd', hid, w_down) * gate[..., None].astype(h.dtype)
    flat = (idx + (jnp.arange(B_, dtype=jnp.int32) * S)[:, None, None]).reshape(-1)
    y = jnp.zeros((B_ * S, D), h.dtype).at[flat].add(ye.reshape(-1, D))
    return y.reshape(B_, S, D)


def setup_inputs(seed: int = 0) -> dict:
    key = jax.random.key(seed)
    ks = jax.random.split(key, 26)

    def nrm(k, shape, fan_in):
        return jax.random.normal(k, shape, F32) * (fan_in ** -0.5)

    def gain(k, shape):
        return 1.0 + 0.02 * jax.random.normal(k, shape, F32)

    x = jax.random.normal(ks[0], (BATCH, SEQ, D_MODEL), F32)
    p = jax.random.normal(ks[1], (DEPTH, BATCH, SEQ, PLE_DIM), F32)
    positions = jnp.arange(SEQ, dtype=jnp.int32)[None, :] + jax.random.randint(ks[2], (BATCH, 1), 0, 1024, dtype=jnp.int32)
    dt = jnp.exp(jax.random.uniform(ks[13], (DEPTH, 2, GDN_HEADS), F32, math.log(1e-3), math.log(1e-1)))
    return {
        'x': x,
        'p': p,
        'positions': positions.astype(jnp.int32),
        'g_mix': gain(ks[3], (DEPTH, D_MODEL)),
        'w_in': nrm(ks[4], (DEPTH, D_MODEL, IN_WIDTH), D_MODEL),
        'ln_v_g': gain(ks[5], (DEPTH, GMLP_GROUPS, HEAD_DIM)),
        'ln_v_b': 0.02 * jax.random.normal(ks[6], (DEPTH, GMLP_GROUPS, HEAD_DIM), F32),
        'w_s': nrm(ks[7], (DEPTH, GMLP_GROUPS, GMLP_CHUNK, GMLP_CHUNK), GMLP_CHUNK),
        'b_s': 1.0 + 0.01 * jax.random.normal(ks[8], (DEPTH, GMLP_GROUPS, GMLP_CHUNK), F32),
        'q_norm_g': gain(ks[9], (DEPTH, HEAD_DIM)),
        'k_norm_g': gain(ks[10], (DEPTH, HEAD_DIM)),
        'conv_w': nrm(ks[11], (DEPTH, GDN_CONV, 3 * GDN_WIDTH), GDN_CONV),
        'a_log': jnp.log(jax.random.uniform(ks[12], (DEPTH, 2, GDN_HEADS), F32, 1.0, 16.0)),
        'dt_bias': dt + jnp.log(-jnp.expm1(-dt)),
        'o_norm_g': gain(ks[14], (DEPTH, HEAD_DIM)),
        'w_out': nrm(ks[15], (DEPTH, MIX_WIDTH, D_MODEL), MIX_WIDTH),
        'g_ffn': gain(ks[16], (DEPTH, D_MODEL)),
        'w_router': nrm(ks[17], (DEPTH, D_MODEL, N_EXPERTS), D_MODEL),
        'w_e_gate': nrm(ks[18], (DEPTH, N_EXPERTS, D_MODEL, D_EXPERT), D_MODEL),
        'w_e_up': nrm(ks[19], (DEPTH, N_EXPERTS, D_MODEL, D_EXPERT), D_MODEL),
        'w_e_down': nrm(ks[20], (DEPTH, N_EXPERTS, D_EXPERT, D_MODEL), D_EXPERT),
        'w_ple': nrm(ks[21], (DEPTH, PLE_DIM, D_MODEL), PLE_DIM),
        'g_ple': gain(ks[22], (DEPTH, D_MODEL)),
        'g_ple_gate': gain(ks[23], (DEPTH, D_MODEL)),
        'w_ple_gate': nrm(ks[24], (DEPTH, D_MODEL, D_MODEL), D_MODEL),
    }


def reference(x, p, positions, g_mix, w_in, ln_v_g, ln_v_b, w_s, b_s, q_norm_g, k_norm_g,
              conv_w, a_log, dt_bias, o_norm_g, w_out, g_ffn, w_router, w_e_gate, w_e_up,
              w_e_down, w_ple, g_ple, g_ple_gate, w_ple_gate):
    split_points = np.cumsum(IN_SPLITS)[:-1].tolist()
    for i in range(DEPTH):
        xn = rmsnorm(x, g_mix[i])
        proj = jnp.einsum('bsd,dn->bsn', xn, w_in[i])
        a_u, a_v, b_q, b_k, b_v, c_qkv, c_gate, c_a, c_b = jnp.split(proj, split_points, axis=-1)
        y_a = gmlp_spatial_gating(a_u, a_v, ln_v_g[i], ln_v_b[i], w_s[i], b_s[i])
        y_b = dilated_attention(b_q, b_k, b_v, positions, q_norm_g[i], k_norm_g[i])
        y_c = gated_deltanet(c_qkv, c_gate, c_a, c_b, conv_w[i], a_log[i], dt_bias[i], o_norm_g[i])
        x = x + jnp.einsum('bsm,md->bsd', jnp.concatenate([y_a, y_b, y_c], axis=-1), w_out[i])
        x = x + expert_choice_ffn(rmsnorm(x, g_ffn[i]), w_router[i], w_e_gate[i], w_e_up[i], w_e_down[i])
        e = rmsnorm(jnp.einsum('bsq,qd->bsd', p[i], w_ple[i]), g_ple[i])
        gate = jax.nn.sigmoid(jnp.einsum('bsd,de->bse', rmsnorm(x, g_ple_gate[i]), w_ple_gate[i]))
        x = x + e * gate
    return x
```

```cpp
#ifndef HOST_EMU
#include <hip/hip_runtime.h>
#include <cstdio>
#include <cstdint>
#include <cstring>
#define DEV __device__ __forceinline__
#define DEVM __device__ __forceinline__
#define LAS __attribute__((address_space(3)))
#define ASMV(...) asm volatile(__VA_ARGS__)
#else
#define DEV static inline
#define DEVM inline
#define LAS
#define ASMV(...) do {} while (0)
#define __global__
#define __launch_bounds__(...)
#endif

typedef unsigned short bf16_t;
typedef short bf16x8 __attribute__((ext_vector_type(8)));
typedef float f32x4 __attribute__((ext_vector_type(4)));
typedef float f32x16 __attribute__((ext_vector_type(16)));
typedef unsigned u32x4 __attribute__((ext_vector_type(4)));
typedef unsigned u32x2 __attribute__((ext_vector_type(2)));

#ifdef CFG_SMALL
constexpr int BATCH = 2, SEQ = 512, DM = 512, DEPTH = 2, NEXP = 4;
#else
constexpr int BATCH = 8, SEQ = 4096, DM = 1024, DEPTH = 4, NEXP = 16;
#endif
constexpr int PLE = 256, HD = 64;
constexpr int GW = DM / 4, GG = GW / HD, GCH = 128;
constexpr int BW = 3 * DM / 8, BH = BW / HD;
constexpr int CW = DM - GW - BW, CHN = CW / HD;
constexpr int CAP = 2 * SEQ / NEXP, DE = DM;
constexpr int M = BATCH * SEQ;
constexpr int O_AU = 0, O_AV = GW, O_BQ = 2 * GW, O_BK = O_BQ + BW, O_BV = O_BK + BW, O_CQKV = O_BV + BW, O_CG = O_CQKV + 3 * CW, O_CA = O_CG + CW, O_CB = O_CA + 2 * CHN, INW = O_CB + 2 * CHN;
constexpr int INWP = (INW + 255) / 256 * 256;
constexpr int ROWS_E = BATCH * CAP, MR = NEXP * ROWS_E;
constexpr int NCH = SEQ / 64;
constexpr int NCHAIN = BATCH * CHN * 2;
constexpr int RECB = 49152 + 256;
constexpr float NORM_EPS = 1e-6f;
constexpr int NPH = 14, NPHASES = 1 + NPH * DEPTH;
constexpr int NTHREADS = 512, NWAVES = 8;
static_assert(M % 256 == 0 && ROWS_E % 256 == 0 && DM % 256 == 0 && SEQ % 256 == 0, "shape");

constexpr size_t al4k(size_t x) { return (x + 4095) & ~(size_t)4095; }
constexpr size_t WS_CTL = 0, CTL_BYTES = 1u << 20;
constexpr size_t WS_ROPE = WS_CTL + CTL_BYTES;
constexpr size_t WS_AFF = WS_ROPE + al4k((size_t)M * 16 * 4);
constexpr size_t WS_IDX = WS_AFF + al4k((size_t)BATCH * NEXP * SEQ * 4);
constexpr size_t WS_GATEV = WS_IDX + al4k((size_t)MR * 4);
constexpr size_t WS_INV = WS_GATEV + al4k((size_t)MR * 4);
constexpr size_t WS_DEN = WS_INV + al4k((size_t)M * NEXP * 4);
constexpr size_t WS_PB = WS_DEN + al4k((size_t)3 * M * BH * 4);
constexpr size_t WS_WS16 = WS_PB + al4k((size_t)M * PLE * 2);
constexpr size_t WS_WIN = WS_WS16 + al4k((size_t)GG * 128 * 128 * 2);
constexpr size_t WS_WOUT = WS_WIN + al4k((size_t)INWP * DM * 2);
constexpr size_t WS_WGU = WS_WOUT + al4k((size_t)DM * DM * 2);
constexpr size_t WS_WD = WS_WGU + al4k((size_t)NEXP * 2 * DE * DM * 2);
constexpr size_t WS_WPLE = WS_WD + al4k((size_t)NEXP * DM * DE * 2);
constexpr size_t WS_WPG = WS_WPLE + al4k((size_t)DM * PLE * 2);
constexpr size_t WS_ACT = WS_WPG + al4k((size_t)DM * DM * 2);
constexpr size_t WS_BIG = WS_ACT + al4k((size_t)M * DM * 2);
constexpr size_t WS_PROJ = WS_BIG;
constexpr size_t WS_QN = WS_PROJ + al4k((size_t)M * INWP * 2);
constexpr size_t WS_KN = WS_QN + al4k((size_t)M * BW * 2);
constexpr size_t WS_VT = WS_KN + al4k((size_t)M * BW * 2);
constexpr size_t VT_STRIDE = al4k((size_t)M * BW * 2);
constexpr size_t WS_NUM = WS_VT + 3 * VT_STRIDE;
constexpr size_t WS_REC = WS_NUM + 3 * VT_STRIDE;
constexpr size_t WS_OF = WS_REC + al4k((size_t)NCHAIN * NCH * RECB);
constexpr size_t WS_MIXEND = WS_OF + al4k((size_t)2 * M * CW * 2);
constexpr size_t WS_XE = WS_BIG;
constexpr size_t WS_HID = WS_XE + al4k((size_t)MR * DM * 2);
constexpr size_t WS_YE = WS_HID + al4k((size_t)MR * DE * 2);
constexpr size_t WS_ERAW = WS_YE + al4k((size_t)MR * DM * 2);
constexpr size_t WS_MOEEND = WS_ERAW + al4k((size_t)M * DM * 2);
constexpr size_t WS_END = WS_MIXEND > WS_MOEEND ? WS_MIXEND : WS_MOEEND;
#ifndef CFG_SMALL
static_assert(WS_END <= ((size_t)1 << 30), "workspace must fit 1 GiB");
#endif

DEV float bf2f(bf16_t b) { unsigned u = ((unsigned)b) << 16; return __builtin_bit_cast(float, u); }
DEV unsigned f2bf(float f) { unsigned u = __builtin_bit_cast(unsigned, f); return (u + 0x7fffu + ((u >> 16) & 1u)) >> 16; }
DEV unsigned pk2(float lo, float hi) { return f2bf(lo) | (f2bf(hi) << 16); }
DEV float lo16(unsigned w) { return __builtin_bit_cast(float, w << 16); }
DEV float hi16(unsigned w) { return __builtin_bit_cast(float, w & 0xffff0000u); }
#ifndef HOST_EMU
DEV f32x4 mfma16(bf16x8 a, bf16x8 b, f32x4 c) { return __builtin_amdgcn_mfma_f32_16x16x32_bf16(a, b, c, 0, 0, 0); }
DEV f32x16 mfma32(bf16x8 a, bf16x8 b, f32x16 c) { return __builtin_amdgcn_mfma_f32_32x32x16_bf16(a, b, c, 0, 0, 0); }
DEV float shx(float v, int m) { return __shfl_xor(v, m); }
DEV unsigned shup(unsigned v, int d) { return __shfl_up(v, d); }
DEV void bsync() { __syncthreads(); }
DEV void wsync() { __builtin_amdgcn_wave_barrier(); }
DEV void rawbar() { __builtin_amdgcn_s_barrier(); }
DEV void glds16(const void* g, LAS void* l) { __builtin_amdgcn_global_load_lds((const unsigned*)g, (LAS unsigned*)l, 16, 0, 0); }
DEV float fexp(float x) { return __expf(x); }
DEV float flog(float x) { return __logf(x); }
DEV float frsqrt(float x) { return rsqrtf(x); }
DEV float frcp(float x) { return __builtin_amdgcn_rcpf(x); }
DEV int rfl(int v) { return __builtin_amdgcn_readfirstlane(v); }
#define SETPRIO(n) __builtin_amdgcn_s_setprio(n)
#define SCHEDB() __builtin_amdgcn_sched_barrier(0)
#else
DEV f32x4 mfma16(bf16x8 a, bf16x8 b, f32x4 c) { return emu_mfma16(a, b, c); }
DEV f32x16 mfma32(bf16x8 a, bf16x8 b, f32x16 c) { return emu_mfma32(a, b, c); }
DEV float shx(float v, int m) { return emu_shfl_xor(v, m); }
DEV unsigned shup(unsigned v, int d) { return emu_shfl_up(v, d); }
DEV void bsync() { emu::block_barrier(); }
DEV void wsync() { int d = 0, all[64]; emu::wave_all(d, all); }
DEV void rawbar() { emu::block_barrier(); }
DEV void glds16(const void* g, void* l) { memcpy((char*)l + (threadIdx.x & 63) * 16, g, 16); }
DEV float fexp(float x) { return expf(x); }
DEV float flog(float x) { return logf(x); }
DEV float frsqrt(float x) { return 1.0f / sqrtf(x); }
DEV float frcp(float x) { return 1.0f / x; }
DEV int rfl(int v) { return v; }
#define SETPRIO(n) do {} while (0)
#define SCHEDB() do {} while (0)
#endif
DEV float wave_sum(float v) {
#pragma unroll
    for (int o = 1; o < 64; o <<= 1) v += shx(v, o);
    return v;
}
DEV float wave_max(float v) {
#pragma unroll
    for (int o = 1; o < 64; o <<= 1) v = fmaxf(v, shx(v, o));
    return v;
}
DEV float gelu_tanh(float x) { const float y = 0.7978845608028654f * (x + 0.044715f * x * x * x); const float e = fexp(2.0f * y); return 0.5f * x * (2.0f - 2.0f * frcp(e + 1.0f)); }
DEV float sigmoidf_(float x) { return frcp(1.0f + fexp(-x)); }
DEV float siluf_(float x) { return x * sigmoidf_(x); }
DEV float softplusf_(float x) { return x > 20.f ? x : flog(1.0f + fexp(x)); }
DEV void unpack8(u32x4 r, float* v) { v[0] = lo16(r.x); v[1] = hi16(r.x); v[2] = lo16(r.y); v[3] = hi16(r.y); v[4] = lo16(r.z); v[5] = hi16(r.z); v[6] = lo16(r.w); v[7] = hi16(r.w); }
DEV u32x4 pack8(const float* v) { u32x4 r; r.x = pk2(v[0], v[1]); r.y = pk2(v[2], v[3]); r.z = pk2(v[4], v[5]); r.w = pk2(v[6], v[7]); return r; }

namespace pg8 {
constexpr int BM = 256, BK = 64, HALF = 128, HTB = HALF * BK * 2, STAGE_BYTES = 8 * HTB, NXCD = 8, WGM = 8;
DEV int lds_byte(int r, int c) { const int st = (r >> 4) * 2 + (c >> 5), rr = r & 15, cc = c & 31, ob = rr * 64 + cc * 2; return st * 1024 + (ob ^ (((ob >> 9) & 1) << 5)); }
DEV void stage_rc(int b, int& R, int& C) { const int st = b / 1024, sb = b % 1024, swz = sb ^ (((sb >> 9) & 1) << 5); R = (st >> 1) * 16 + swz / 64; C = (st & 1) * 32 + (swz % 64) / 2; }
DEV int perm32(int rho) { const int n = rho >> 4, i = rho & 15; return 8 * (i >> 2) + 4 * n + (i & 3); }
struct Unit { int pm, pn; };
struct Gemm { const bf16_t* A; const bf16_t* Bt; int M, N, K; int grp_tiles; size_t grp_stride; };
struct StaticOrder {
    int nM, nN, nwg, G, c;
    DEVM void init(int M_, int N_, int G_, int c_) { nM = M_ / BM; nN = N_ / BM; nwg = nM * nN; G = G_; c = c_; }
    DEVM bool next(int i, Unit& u) const {
        const long L = (long)i * G + c; if (L >= nwg) return false;
        int wgid = (int)L; { const int q = nwg / NXCD, r = nwg % NXCD, xcd = wgid % NXCD, off = wgid / NXCD; wgid = (xcd < r ? xcd * (q + 1) : r * (q + 1) + (xcd - r) * q) + off; }
        const int nig = WGM * nN, gid = wgid / nig, fm = gid * WGM, gsz = (nM - fm) < WGM ? (nM - fm) : WGM;
        u.pm = fm + ((wgid % nig) % gsz); u.pn = (wgid % nig) / gsz; return true;
    }
};
template <class Epi>
DEV void gemm_phase(LAS unsigned char* lds, const Gemm g, const StaticOrder& S, const Epi& E, const int tid) {
    const int wid = rfl(tid >> 6), lane = tid & 63, wr = wid >> 2, wc = wid & 3, fr = lane & 15, fq = lane >> 4;
    const int K = g.K, nt = K / BK;
    unsigned voffA[2], voffB[2];
#pragma unroll
    for (int i = 0; i < 2; ++i) { int R, C; stage_rc(tid * 16 + i * 8192, R, C); const int Rb = Epi::PERM ? ((R & ~31) + perm32(R & 31)) : R;
        voffA[i] = (unsigned)(R * K + C) * 2u; voffB[i] = (unsigned)(Rb * K + C) * 2u; }
    const size_t kstep = (size_t)(BK * 2);
    const size_t hstep = (size_t)HALF * K * 2;
    const size_t tstep = 2 * hstep;
    const unsigned ldsw = (unsigned)wid * 1024u;
    const int aoff = lds_byte(wr * 64 + fr, fq * 8), boff = lds_byte(wc * 32 + fr, fq * 8);
#define PG8_SA(b, h) (((b) * 2 + (h)) * HTB)
#define PG8_SB(b, h) ((4 + (b) * 2 + (h)) * HTB)
#define PG8_STAGE(bufoff, gbase, voff) do { _Pragma("unroll") for (int _i = 0; _i < 2; ++_i) \
        glds16((const char*)(gbase) + (voff)[_i], lds + (bufoff) + ldsw + _i * 8192); } while (0)
#define PG8_LDA(dst, b, h) do { _Pragma("unroll") for (int m = 0; m < 4; ++m) _Pragma("unroll") for (int k = 0; k < 2; ++k) dst[m][k] = *(const LAS bf16x8*)(lds + PG8_SA(b, h) + aoff + m * 2048 + k * 1024); } while (0)
#define PG8_LDB(dst, b, h) do { _Pragma("unroll") for (int n = 0; n < 2; ++n) _Pragma("unroll") for (int k = 0; k < 2; ++k) dst[n][k] = *(const LAS bf16x8*)(lds + PG8_SB(b, h) + boff + n * 2048 + k * 1024); } while (0)
#define PG8_MMA(ai, bj, At, Bt) do { SETPRIO(1); _Pragma("unroll") for (int m = 0; m < 4; ++m) _Pragma("unroll") for (int n = 0; n < 2; ++n) _Pragma("unroll") for (int k = 0; k < 2; ++k) \
        acc[ai][bj][m][n] = mfma16(Bt[n][k], At[m][k], acc[ai][bj][m][n]); SETPRIO(0); } while (0)
#define PG8_WAIT_V(n) ASMV("s_waitcnt vmcnt(" #n ")" ::: "memory")
#define PG8_WAIT_L(n) ASMV("s_waitcnt lgkmcnt(" #n ")" ::: "memory")
#define PG8_BAR rawbar()
#define PG8_SCHED SCHEDB()
#define PG8_BBASE(u) ((const char*)g.Bt + (g.grp_tiles ? (size_t)((u).pm / g.grp_tiles) * g.grp_stride : (size_t)0) + (size_t)(u).pn * tstep)
    Unit cur, nxt; int ui = 0;
    if (!S.next(0, cur)) return;
    f32x4 acc[2][2][4][2];
#pragma unroll
    for (int a = 0; a < 2; ++a)
#pragma unroll
        for (int b = 0; b < 2; ++b)
#pragma unroll
            for (int m = 0; m < 4; ++m)
#pragma unroll
                for (int n = 0; n < 2; ++n) acc[a][b][m][n] = (f32x4){0.f, 0.f, 0.f, 0.f};
    bf16x8 At[4][2], B0[2][2], B1[2][2];
    const char* cA = (const char*)g.A + (size_t)cur.pm * tstep; const char* cB = PG8_BBASE(cur);
    PG8_STAGE(PG8_SB(0, 0), cB, voffB); PG8_STAGE(PG8_SA(0, 0), cA, voffA); PG8_STAGE(PG8_SB(0, 1), cB + hstep, voffB); PG8_STAGE(PG8_SA(0, 1), cA + hstep, voffA);
    if (wr == 1) PG8_BAR;
    PG8_WAIT_V(4); PG8_BAR;
    PG8_STAGE(PG8_SB(1, 0), cB + kstep, voffB); PG8_STAGE(PG8_SA(1, 0), cA + kstep, voffA); PG8_STAGE(PG8_SB(1, 1), cB + hstep + kstep, voffB);
    PG8_WAIT_V(6); PG8_BAR;
    for (;;) {
        const bool has_next = S.next(ui + 1, nxt);
        const char* nA = has_next ? (const char*)g.A + (size_t)nxt.pm * tstep : cA; const char* nB = has_next ? PG8_BBASE(nxt) : cB;
        for (int t = 0; t < nt; t += 2) {
            const bool last = (t == nt - 2);
            const char* a1 = cA + (size_t)(t + 1) * kstep;
            const char* a2 = last ? nA : cA + (size_t)(t + 2) * kstep; const char* b2 = last ? nB : cB + (size_t)(t + 2) * kstep;
            const char* a3 = a2 + kstep; const char* b3 = b2 + kstep;
            PG8_LDB(B0, 0, 0); PG8_SCHED; PG8_LDA(At, 0, 0); PG8_STAGE(PG8_SA(1, 1), a1 + hstep, voffA);
            PG8_WAIT_L(8); PG8_BAR; PG8_WAIT_L(0); PG8_MMA(0, 0, At, B0); PG8_BAR; PG8_SCHED;
            PG8_LDB(B1, 0, 1); PG8_STAGE(PG8_SB(0, 0), b2, voffB);
            PG8_BAR; PG8_WAIT_L(0); PG8_MMA(0, 1, At, B1); PG8_BAR;
            PG8_LDA(At, 0, 1); PG8_STAGE(PG8_SA(0, 0), a2, voffA);
            PG8_BAR; PG8_WAIT_L(0); PG8_MMA(1, 0, At, B0); PG8_BAR; PG8_SCHED;
            PG8_STAGE(PG8_SB(0, 1), b2 + hstep, voffB);
            PG8_WAIT_V(6); PG8_BAR; PG8_MMA(1, 1, At, B1); PG8_BAR;
            PG8_LDB(B0, 1, 0); PG8_SCHED; PG8_LDA(At, 1, 0); PG8_STAGE(PG8_SA(0, 1), a2 + hstep, voffA);
            PG8_WAIT_L(8); PG8_BAR; PG8_WAIT_L(0); PG8_MMA(0, 0, At, B0); PG8_BAR; PG8_SCHED;
            PG8_LDB(B1, 1, 1); PG8_STAGE(PG8_SB(1, 0), b3, voffB);
            PG8_BAR; PG8_WAIT_L(0); PG8_MMA(0, 1, At, B1); PG8_BAR;
            PG8_LDA(At, 1, 1); PG8_STAGE(PG8_SA(1, 0), a3, voffA);
            PG8_BAR; PG8_WAIT_L(0); PG8_MMA(1, 0, At, B0); PG8_BAR; PG8_SCHED;
            PG8_STAGE(PG8_SB(1, 1), b3 + hstep, voffB);
            PG8_WAIT_V(6); PG8_BAR; PG8_MMA(1, 1, At, B1); PG8_BAR;
        }
        E(acc, cur, wr, wc, fr, fq);
        if (!has_next) break;
#pragma unroll
        for (int a = 0; a < 2; ++a)
#pragma unroll
            for (int b = 0; b < 2; ++b)
#pragma unroll
                for (int m = 0; m < 4; ++m)
#pragma unroll
                    for (int n = 0; n < 2; ++n) acc[a][b][m][n] = (f32x4){0.f, 0.f, 0.f, 0.f};
        cur = nxt; cA = nA; cB = nB; ++ui;
    }
    PG8_WAIT_V(0);
    if (wr == 0) PG8_BAR;
    PG8_BAR;
#undef PG8_SA
#undef PG8_SB
#undef PG8_STAGE
#undef PG8_LDA
#undef PG8_LDB
#undef PG8_MMA
#undef PG8_WAIT_V
#undef PG8_WAIT_L
#undef PG8_BAR
#undef PG8_SCHED
#undef PG8_BBASE
}
struct EpiBf16 {
    static constexpr bool PERM = true;
    bf16_t* O; int ldc;
    DEVM void operator()(const f32x4 (&acc)[2][2][4][2], const Unit& u, int wr, int wc, int fr, int fq) const {
        const int row0 = u.pm * BM + wr * 64 + fr, col0 = u.pn * BM + wc * 32 + 8 * fq;
#pragma unroll
        for (int ai = 0; ai < 2; ++ai)
#pragma unroll
            for (int m = 0; m < 4; ++m) { bf16_t* rowp = O + (size_t)(row0 + ai * HALF + m * 16) * ldc + col0;
#pragma unroll
                for (int bj = 0; bj < 2; ++bj) { const f32x4 v0 = acc[ai][bj][m][0], v1 = acc[ai][bj][m][1];
                    u32x4 w; w.x = pk2(v0[0], v0[1]); w.y = pk2(v0[2], v0[3]); w.z = pk2(v1[0], v1[1]); w.w = pk2(v1[2], v1[3]);
                    *(u32x4*)(rowp + bj * HALF) = w; } }
    }
};
struct EpiResF32 {
    static constexpr bool PERM = false;
    const float* res; float* out; int ldc;
    DEVM void operator()(const f32x4 (&acc)[2][2][4][2], const Unit& u, int wr, int wc, int fr, int fq) const {
        const int row0 = u.pm * BM + wr * 64 + fr, col0 = u.pn * BM + wc * 32 + 4 * fq;
#pragma unroll
        for (int ai = 0; ai < 2; ++ai)
#pragma unroll
            for (int m = 0; m < 4; ++m) { const size_t off = (size_t)(row0 + ai * HALF + m * 16) * ldc + col0;
#pragma unroll
                for (int bj = 0; bj < 2; ++bj)
#pragma unroll
                    for (int n = 0; n < 2; ++n) { const f32x4 r = *(const f32x4*)(res + off + bj * HALF + n * 16); *(f32x4*)(out + off + bj * HALF + n * 16) = r + acc[ai][bj][m][n]; } }
    }
};
struct EpiSwiGLU {
    static constexpr bool PERM = true;
    bf16_t* O; int ldc;
    DEVM void operator()(const f32x4 (&acc)[2][2][4][2], const Unit& u, int wr, int wc, int fr, int fq) const {
        const int row0 = u.pm * BM + wr * 64 + fr, col0 = u.pn * HALF + wc * 32 + 8 * fq;
#pragma unroll
        for (int ai = 0; ai < 2; ++ai)
#pragma unroll
            for (int m = 0; m < 4; ++m) { bf16_t* rowp = O + (size_t)(row0 + ai * HALF + m * 16) * ldc + col0;
                float h[8];
#pragma unroll
                for (int n = 0; n < 2; ++n)
#pragma unroll
                    for (int i = 0; i < 4; ++i) { const float gt = acc[ai][0][m][n][i], up = acc[ai][1][m][n][i]; h[n * 4 + i] = siluf_(gt) * up; }
                *(u32x4*)rowp = pack8(h); }
    }
};
struct EpiScaleBf16 {
    static constexpr bool PERM = true;
    bf16_t* O; int ldc; const float* rowscale;
    DEVM void operator()(const f32x4 (&acc)[2][2][4][2], const Unit& u, int wr, int wc, int fr, int fq) const {
        const int row0 = u.pm * BM + wr * 64 + fr, col0 = u.pn * BM + wc * 32 + 8 * fq;
#pragma unroll
        for (int ai = 0; ai < 2; ++ai)
#pragma unroll
            for (int m = 0; m < 4; ++m) { const int row = row0 + ai * HALF + m * 16; const float sc = rowscale[row]; bf16_t* rowp = O + (size_t)row * ldc + col0;
#pragma unroll
                for (int bj = 0; bj < 2; ++bj) { const f32x4 v0 = acc[ai][bj][m][0] * sc, v1 = acc[ai][bj][m][1] * sc;
                    u32x4 w; w.x = pk2(v0[0], v0[1]); w.y = pk2(v0[2], v0[3]); w.z = pk2(v1[0], v1[1]); w.w = pk2(v1[2], v1[3]);
                    *(u32x4*)(rowp + bj * HALF) = w; } }
    }
};
struct EpiPleGate {
    static constexpr bool PERM = false;
    float* x; const bf16_t* en; int ldc;
    DEVM void operator()(const f32x4 (&acc)[2][2][4][2], const Unit& u, int wr, int wc, int fr, int fq) const {
        const int row0 = u.pm * BM + wr * 64 + fr, col0 = u.pn * BM + wc * 32 + 4 * fq;
#pragma unroll
        for (int ai = 0; ai < 2; ++ai)
#pragma unroll
            for (int m = 0; m < 4; ++m) { const size_t off = (size_t)(row0 + ai * HALF + m * 16) * ldc + col0;
#pragma unroll
                for (int bj = 0; bj < 2; ++bj)
#pragma unroll
                    for (int n = 0; n < 2; ++n) { const size_t o = off + bj * HALF + n * 16; const f32x4 r = *(const f32x4*)(x + o); const u32x2 e2 = *(const u32x2*)(en + o); const f32x4 a = acc[ai][bj][m][n];
                        f32x4 w; w[0] = r[0] + lo16(e2.x) * sigmoidf_(a[0]); w[1] = r[1] + hi16(e2.x) * sigmoidf_(a[1]); w[2] = r[2] + lo16(e2.y) * sigmoidf_(a[2]); w[3] = r[3] + hi16(e2.y) * sigmoidf_(a[3]);
                        *(f32x4*)(x + o) = w; } }
    }
};
}

#ifndef HOST_EMU
#define XB_TMO      128
#define XB_XCNT(j)  (256  + 64 * (j))
#define XB_XSUB(j)  (1280 + 64 * (j))
#define XB_XGEN(j)  (2304 + 64 * (j))
#define XB_TOP      3328
#define XB_TOPGEN   3392
#define XCD_BAR_WORDS 3456
#define XB_SPIN_CAP (1u << 22)
__device__ __forceinline__ unsigned xb_ld(unsigned* p)              { return __hip_atomic_load(p, __ATOMIC_RELAXED, __HIP_MEMORY_SCOPE_AGENT); }
__device__ __forceinline__ unsigned xb_add(unsigned* p, unsigned v) { return __hip_atomic_fetch_add(p, v, __ATOMIC_RELAXED, __HIP_MEMORY_SCOPE_AGENT); }
__device__ __forceinline__ unsigned xb_xcc_id() { return (unsigned)__builtin_amdgcn_s_getreg((3 << 11) | 20) & 0xFu; }
#define XB_SPIN(cond, bar) do { unsigned _sp = 0; while (cond) { __builtin_amdgcn_s_sleep(1); \
    if ((++_sp & 255u) == 0u) { if (xb_ld(&(bar)[XB_TMO])) break; if (_sp > XB_SPIN_CAP) { atomicAdd(&(bar)[XB_TMO], 1u); break; } } } } while (0)
struct XcdBarrier { unsigned* bar; unsigned x; volatile LAS unsigned* st; };
__device__ __forceinline__ XcdBarrier xcd_barrier_post(unsigned* bar, volatile LAS unsigned* st) {
    XcdBarrier b; b.bar = bar; b.x = xb_xcc_id(); b.st = st;
    if (threadIdx.x == 0) (void)xb_add(&bar[XB_XCNT(b.x)], 1u);
    return b;
}
__device__ __forceinline__ void xcd_barrier_complete(unsigned* bar, unsigned x, unsigned& nloc, unsigned& nx) {
    const unsigned G = gridDim.x * gridDim.y * gridDim.z;
    unsigned sum, cnt, mine, sp = 0u;
    for (;;) {
        sum = 0u; cnt = 0u; mine = 0u;
#pragma unroll
        for (unsigned j = 0; j < 16; ++j) { const unsigned c = xb_ld(&bar[XB_XCNT(j)]); sum += c; cnt += (c > 0u) ? 1u : 0u; mine = (j == x) ? c : mine; }
        if (sum == G) break;
        __builtin_amdgcn_s_sleep(1);
        if ((++sp & 255u) == 0u) { if (xb_ld(&bar[XB_TMO])) break; if (sp > XB_SPIN_CAP) { atomicAdd(&bar[XB_TMO], 1u); break; } }
    }
    nloc = mine > 0u ? mine : 1u; nx = cnt > 0u ? cnt : 1u;
}
__device__ __forceinline__ void xcd_barrier(const XcdBarrier& b) {
    asm volatile("s_waitcnt vmcnt(0)" ::: "memory");
    __syncthreads();
    if (threadIdx.x == 0) {
        unsigned* bar = b.bar;
        __builtin_amdgcn_s_waitcnt(0);
        unsigned nloc = b.st[0], nx = b.st[1];
        if (nloc == 0u) { xcd_barrier_complete(bar, b.x, nloc, nx); b.st[0] = nloc; b.st[1] = nx; }
        const unsigned old = xb_add(&bar[XB_XSUB(b.x)], 1u);
        const unsigned gen = old / nloc;
        if (old + 1u == (gen + 1u) * nloc) {
            __builtin_amdgcn_fence(__ATOMIC_RELEASE, "agent");
            asm volatile("s_waitcnt vmcnt(0)" ::: "memory");
            const unsigned og = xb_add(&bar[XB_TOP], 1u);
            const unsigned tg = og / nx;
            if (og + 1u == (tg + 1u) * nx) xb_add(&bar[XB_TOPGEN], 1u);
            else XB_SPIN(xb_ld(&bar[XB_TOPGEN]) == tg, bar);
            __builtin_amdgcn_fence(__ATOMIC_ACQUIRE, "agent");
            xb_add(&bar[XB_XGEN(b.x)], 1u);
            asm volatile("s_waitcnt vmcnt(0)" ::: "memory");
        } else {
            XB_SPIN(xb_ld(&bar[XB_XGEN(b.x)]) == gen, bar);
            __builtin_amdgcn_fence(__ATOMIC_ACQUIRE, "agent");
            asm volatile("s_waitcnt vmcnt(0)" ::: "memory");
        }
    }
    __syncthreads();
}
#endif

constexpr int LDS_STAGE = 131072;
constexpr int LDS_MISC = 144384;
constexpr int LDS_BYTES = 147456;
struct Args { const void* in[25]; float* out; unsigned char* ws; int ph_lo, ph_hi; };
struct Frame {
    LAS unsigned char* lds;
    int tid, lane, wave, G, wg;
    const Args* a;
    DEVM const float* x() const { return (const float*)a->in[0]; }
    DEVM const float* p() const { return (const float*)a->in[1]; }
    DEVM const int* pos() const { return (const int*)a->in[2]; }
    DEVM const float* g_mix() const { return (const float*)a->in[3]; }
    DEVM const float* w_in() const { return (const float*)a->in[4]; }
    DEVM const float* ln_v_g() const { return (const float*)a->in[5]; }
    DEVM const float* ln_v_b() const { return (const float*)a->in[6]; }
    DEVM const float* w_s() const { return (const float*)a->in[7]; }
    DEVM const float* b_s() const { return (const float*)a->in[8]; }
    DEVM const float* q_norm_g() const { return (const float*)a->in[9]; }
    DEVM const float* k_norm_g() const { return (const float*)a->in[10]; }
    DEVM const float* conv_w() const { return (const float*)a->in[11]; }
    DEVM const float* a_log() const { return (const float*)a->in[12]; }
    DEVM const float* dt_bias() const { return (const float*)a->in[13]; }
    DEVM const float* o_norm_g() const { return (const float*)a->in[14]; }
    DEVM const float* w_out() const { return (const float*)a->in[15]; }
    DEVM const float* g_ffn() const { return (const float*)a->in[16]; }
    DEVM const float* w_router() const { return (const float*)a->in[17]; }
    DEVM const float* w_e_gate() const { return (const float*)a->in[18]; }
    DEVM const float* w_e_up() const { return (const float*)a->in[19]; }
    DEVM const float* w_e_down() const { return (const float*)a->in[20]; }
    DEVM const float* w_ple() const { return (const float*)a->in[21]; }
    DEVM const float* g_ple() const { return (const float*)a->in[22]; }
    DEVM const float* g_ple_gate() const { return (const float*)a->in[23]; }
    DEVM const float* w_ple_gate() const { return (const float*)a->in[24]; }
    DEVM float* out() const { return a->out; }
    DEVM unsigned char* ws() const { return a->ws; }
    DEVM float* ROPE() const { return (float*)(a->ws + WS_ROPE); }
    DEVM float* AFF() const { return (float*)(a->ws + WS_AFF); }
    DEVM float* GATEV() const { return (float*)(a->ws + WS_GATEV); }
    DEVM float* DEN() const { return (float*)(a->ws + WS_DEN); }
    DEVM int* IDX() const { return (int*)(a->ws + WS_IDX); }
    DEVM int* INV() const { return (int*)(a->ws + WS_INV); }
    DEVM bf16_t* PB() const { return (bf16_t*)(a->ws + WS_PB); }
    DEVM bf16_t* WS16() const { return (bf16_t*)(a->ws + WS_WS16); }
    DEVM bf16_t* WIN() const { return (bf16_t*)(a->ws + WS_WIN); }
    DEVM bf16_t* WOUT() const { return (bf16_t*)(a->ws + WS_WOUT); }
    DEVM bf16_t* WGU() const { return (bf16_t*)(a->ws + WS_WGU); }
    DEVM bf16_t* WD() const { return (bf16_t*)(a->ws + WS_WD); }
    DEVM bf16_t* WPLE() const { return (bf16_t*)(a->ws + WS_WPLE); }
    DEVM bf16_t* WPG() const { return (bf16_t*)(a->ws + WS_WPG); }
    DEVM bf16_t* ACT() const { return (bf16_t*)(a->ws + WS_ACT); }
    DEVM bf16_t* PROJ() const { return (bf16_t*)(a->ws + WS_PROJ); }
    DEVM bf16_t* QN() const { return (bf16_t*)(a->ws + WS_QN); }
    DEVM bf16_t* KN() const { return (bf16_t*)(a->ws + WS_KN); }
    DEVM bf16_t* NUM() const { return (bf16_t*)(a->ws + WS_NUM); }
    DEVM bf16_t* OFB() const { return (bf16_t*)(a->ws + WS_OF); }
    DEVM bf16_t* XE() const { return (bf16_t*)(a->ws + WS_XE); }
    DEVM bf16_t* HID() const { return (bf16_t*)(a->ws + WS_HID); }
    DEVM bf16_t* YE() const { return (bf16_t*)(a->ws + WS_YE); }
    DEVM bf16_t* ERAW() const { return (bf16_t*)(a->ws + WS_ERAW); }
    DEVM unsigned char* VT() const { return (unsigned char*)(a->ws + WS_VT); }
    DEVM unsigned char* REC() const { return (unsigned char*)(a->ws + WS_REC); }
};

DEV void phase_prologue(Frame& F) {
    for (int i = F.wg * NTHREADS + F.tid; i < M * 8; i += F.G * NTHREADS) {
        const int tok = i >> 3, k = i & 7;
        const float inv_freq = powf(500000.0f, -(float)k * 0.125f);
        const float ang = (float)F.pos()[tok] * inv_freq;
        F.ROPE()[tok * 16 + k] = cosf(ang); F.ROPE()[tok * 16 + 8 + k] = sinf(ang);
    }
}

DEV void tr_item(const float* W, int K, int N, bf16_t* WT, int ldk, int k0, int n0, int drow0, LAS float* scr, int lane) {
#pragma unroll 8
    for (int i = 0; i < 32; ++i) { const int kk = 2 * i + (lane >> 5); const int n = n0 + (lane & 31); scr[kk * 33 + (lane & 31)] = (n < N) ? W[(size_t)(k0 + kk) * N + n] : 0.f; }
    ASMV("s_waitcnt lgkmcnt(0)" ::: "memory"); wsync();
    const int c = lane & 7;
#pragma unroll
    for (int j = 0; j < 4; ++j) { const int n = (lane >> 3) + 8 * j; const LAS float* s = scr + (8 * c) * 33 + n;
        u32x4 o; o.x = pk2(s[0 * 33], s[1 * 33]); o.y = pk2(s[2 * 33], s[3 * 33]); o.z = pk2(s[4 * 33], s[5 * 33]); o.w = pk2(s[6 * 33], s[7 * 33]);
        *(u32x4*)(WT + (size_t)(drow0 + n) * ldk + k0 + 8 * c) = o; }
    ASMV("s_waitcnt lgkmcnt(0)" ::: "memory"); wsync();
}
DEV void phase_pw(Frame& F, int L) {
    LAS float* scr = (LAS float*)(F.lds + F.wave * 16384);
    const int gw = F.wg * NWAVES + F.wave, NGW = F.G * NWAVES;
    constexpr int I_IN = (DM / 64) * (INWP / 32), I_OUT = (DM / 64) * (DM / 32), I_G = (DM / 64) * (DE / 32), I_D = (DE / 64) * (DM / 32), I_PLE = (PLE / 64) * (DM / 32), I_PG = (DM / 64) * (DM / 32);
    constexpr int NIT = I_IN + I_OUT + NEXP * (2 * I_G + I_D) + I_PLE + I_PG;
    for (int it = gw; it < NIT; it += NGW) {
        int r = it;
        if (r < I_IN) { const int nb = INWP / 32, kb = r / nb, n0 = (r % nb) * 32; tr_item(F.w_in() + (size_t)L * DM * INW, DM, INW, F.WIN(), DM, kb * 64, n0, n0, scr, F.lane); continue; } r -= I_IN;
        if (r < I_OUT) { const int nb = DM / 32, kb = r / nb, n0 = (r % nb) * 32; tr_item(F.w_out() + (size_t)L * DM * DM, DM, DM, F.WOUT(), DM, kb * 64, n0, n0, scr, F.lane); continue; } r -= I_OUT;
        if (r < NEXP * (2 * I_G + I_D)) {
            const int e = r / (2 * I_G + I_D); int q = r % (2 * I_G + I_D);
            if (q < 2 * I_G) { const int which = q / I_G; q %= I_G; const int nb = DE / 32, kb = q / nb, n0 = (q % nb) * 32;
                const float* W = (which ? F.w_e_up() : F.w_e_gate()) + ((size_t)L * NEXP + e) * DM * DE;
                const int drow0 = 256 * (n0 / 128) + 128 * which + (n0 % 128) - n0;
                tr_item(W, DM, DE, F.WGU() + (size_t)e * 2 * DE * DM, DM, kb * 64, n0, drow0 + n0, scr, F.lane); }
            else { q -= 2 * I_G; const int nb = DM / 32, kb = q / nb, n0 = (q % nb) * 32;
                tr_item(F.w_e_down() + ((size_t)L * NEXP + e) * DE * DM, DE, DM, F.WD() + (size_t)e * DM * DE, DE, kb * 64, n0, n0, scr, F.lane); }
            continue; } r -= NEXP * (2 * I_G + I_D);
        if (r < I_PLE) { const int nb = DM / 32, kb = r / nb, n0 = (r % nb) * 32; tr_item(F.w_ple() + (size_t)L * PLE * DM, PLE, DM, F.WPLE(), PLE, kb * 64, n0, n0, scr, F.lane); continue; } r -= I_PLE;
        { const int nb = DM / 32, kb = r / nb, n0 = (r % nb) * 32; tr_item(F.w_ple_gate() + (size_t)L * DM * DM, DM, DM, F.WPG(), DM, kb * 64, n0, n0, scr, F.lane); }
    }
    for (int i = F.wg * NTHREADS + F.tid; i < GG * 128 * 128 / 4; i += F.G * NTHREADS) {
        const f32x4 v = *(const f32x4*)(F.w_s() + (size_t)L * GG * 128 * 128 + (size_t)i * 4);
        u32x2 o; o.x = pk2(v[0], v[1]); o.y = pk2(v[2], v[3]); *(u32x2*)(F.WS16() + (size_t)i * 4) = o;
    }
}

constexpr int NJ = DM / 256;
DEV void phase_norm1(Frame& F, int L) {
    const float* xin = (L == 0) ? F.x() : F.out();
    const int gw = F.wg * NWAVES + F.wave, NGW = F.G * NWAVES;
    for (int m = gw; m < M; m += NGW) {
        const f32x4* xr = (const f32x4*)(xin + (size_t)m * DM) + F.lane;
        f32x4 v[NJ]; float s = 0.f;
#pragma unroll
        for (int j = 0; j < NJ; ++j) { v[j] = xr[64 * j]; s += (v[j][0] * v[j][0] + v[j][1] * v[j][1]) + (v[j][2] * v[j][2] + v[j][3] * v[j][3]); }
        const float rstd = frsqrt(wave_sum(s) * (1.f / DM) + NORM_EPS);
        u32x2* o8 = (u32x2*)(F.ACT() + (size_t)m * DM) + F.lane;
#pragma unroll
        for (int j = 0; j < NJ; ++j) { const f32x4 g = *((const f32x4*)(F.g_mix() + (size_t)L * DM) + F.lane + 64 * j); u32x2 o; o.x = pk2(v[j][0] * rstd * g[0], v[j][1] * rstd * g[1]); o.y = pk2(v[j][2] * rstd * g[2], v[j][3] * rstd * g[3]); o8[64 * j] = o; }
    }
}

DEV void gmlp_units(Frame& F, int L) {
    LAS bf16_t* vnT = (LAS bf16_t*)F.lds;
    const int tid = F.tid, lane = F.lane, w = F.wave;
    for (int unit = F.wg; unit < (M / GCH) * GG; unit += F.G) {
        const int g = unit % GG, t0 = (unit / GG) * GCH;
        {
            const int j = tid >> 2, qd = tid & 3;
            const bf16_t* src = F.PROJ() + (size_t)(t0 + j) * INWP + O_AV + g * 64 + qd * 16;
            float v[16]; unpack8(*(const u32x4*)src, v); unpack8(*(const u32x4*)(src + 8), v + 8);
            float s = 0.f;
#pragma unroll
            for (int i = 0; i < 16; ++i) { v[i] = gelu_tanh(v[i]); s += v[i]; }
            s += shx(s, 1); s += shx(s, 2);
            const float mu = s * (1.f / 64.f); float q = 0.f;
#pragma unroll
            for (int i = 0; i < 16; ++i) { v[i] -= mu; q += v[i] * v[i]; }
            q += shx(q, 1); q += shx(q, 2);
            const float rstd = frsqrt(q * (1.f / 64.f) + NORM_EPS);
            const float* lg = F.ln_v_g() + ((size_t)L * GG + g) * 64 + qd * 16; const float* lb = F.ln_v_b() + ((size_t)L * GG + g) * 64 + qd * 16;
#pragma unroll
            for (int i = 0; i < 16; ++i) vnT[(qd * 16 + i) * 136 + j] = (bf16_t)f2bf(v[i] * rstd * lg[i] + lb[i]);
        }
        bsync();
        {
            const int mt = w & 1, nt = w >> 1, r = lane & 31, h = lane >> 5;
            f32x16 acc; for (int i = 0; i < 16; ++i) acc[i] = 0.f;
            const bf16_t* wrow = F.WS16() + ((size_t)g * 128 + nt * 32 + r) * 128;
#pragma unroll
            for (int s = 0; s < 8; ++s) {
                const bf16x8 a = *(const LAS bf16x8*)(vnT + (mt * 32 + r) * 136 + s * 16 + h * 8);
                const bf16x8 b = *(const bf16x8*)(wrow + s * 16 + h * 8);
                acc = mfma32(a, b, acc);
            }
            const int tok = t0 + nt * 32 + r;
            const float bias = F.b_s()[((size_t)L * GG + g) * 128 + nt * 32 + r];
#pragma unroll
            for (int rr = 0; rr < 4; ++rr) {
                const int d0 = mt * 32 + 8 * rr + 4 * h;
                const u32x2 u2 = *(const u32x2*)(F.PROJ() + (size_t)tok * INWP + O_AU + g * 64 + d0);
                const float u0 = gelu_tanh(lo16(u2.x)), u1 = gelu_tanh(hi16(u2.x)), u2f = gelu_tanh(lo16(u2.y)), u3 = gelu_tanh(hi16(u2.y));
                u32x2 o; o.x = pk2(u0 * (acc[4 * rr + 0] + bias), u1 * (acc[4 * rr + 1] + bias)); o.y = pk2(u2f * (acc[4 * rr + 2] + bias), u3 * (acc[4 * rr + 3] + bias));
                *(u32x2*)(F.ACT() + (size_t)tok * DM + g * 64 + d0) = o;
            }
        }
        bsync();
    }
}

DEV void attnprep_units(Frame& F, int L) {
    LAS bf16_t* vt = (LAS bf16_t*)F.lds;
    const int tid = F.tid;
    for (int unit = F.wg; unit < BATCH * BH * (SEQ / 256); unit += F.G) {
        const int blk = unit % (SEQ / 256), bh = unit / (SEQ / 256), h = bh % BH, b = bh / BH, tb = blk * 256;
#pragma unroll 1
        for (int pass = 0; pass < 4; ++pass) {
            const int which = pass >> 1, tl = (pass & 1) * 128 + (tid >> 2), qd = tid & 3, s = tb + tl, tok = b * SEQ + s;
            const bf16_t* src = F.PROJ() + (size_t)tok * INWP + (which ? O_BK : O_BQ) + h * 64 + qd * 16;
            float v[16]; unpack8(*(const u32x4*)src, v); unpack8(*(const u32x4*)(src + 8), v + 8);
            float ss = 0.f;
#pragma unroll
            for (int i = 0; i < 16; ++i) ss += v[i] * v[i];
            ss += shx(ss, 1); ss += shx(ss, 2);
            const float rstd = frsqrt(ss * (1.f / 64.f) + NORM_EPS);
            const float* gn = (which ? F.k_norm_g() : F.q_norm_g()) + (size_t)L * 64 + qd * 16;
#pragma unroll
            for (int i = 0; i < 16; ++i) v[i] = v[i] * rstd * gn[i];
            if (qd == 0) {
                const float* rp = F.ROPE() + (size_t)tok * 16;
#pragma unroll
                for (int i = 0; i < 8; ++i) { const float c = rp[i], sn = rp[8 + i], x1 = v[i], x2 = v[8 + i]; v[i] = x1 * c - x2 * sn; v[8 + i] = x2 * c + x1 * sn; }
            }
            if (which == 0) {
#pragma unroll
                for (int i = 0; i < 16; ++i) v[i] *= 0.125f;
            }
            bf16_t* dst = (which ? F.KN() : F.QN()) + ((size_t)bh * SEQ + s) * 64 + qd * 16;
            *(u32x4*)dst = pack8(v); *(u32x4*)(dst + 8) = pack8(v + 8);
        }
#pragma unroll
        for (int i = 0; i < 4; ++i) { const int id = tid + 512 * i, tl = id >> 3, dc = id & 7;
            const u32x4 r = *(const u32x4*)(F.PROJ() + (size_t)(b * SEQ + tb + tl) * INWP + O_BV + h * 64 + dc * 8);
            const unsigned ww[4] = {r.x, r.y, r.z, r.w};
#pragma unroll
            for (int e = 0; e < 4; ++e) { vt[(dc * 8 + 2 * e) * 264 + tl] = (bf16_t)(ww[e] & 0xffffu); vt[(dc * 8 + 2 * e + 1) * 264 + tl] = (bf16_t)(ww[e] >> 16); } }
        bsync();
#pragma unroll
        for (int p = 0; p < 3; ++p) {
            const int dil = (p == 0) ? 1 : (p == 1 ? 4 : 16), Lp = SEQ / dil, cpr = 32 / dil;
            bf16_t* VTp = (bf16_t*)(F.VT() + (size_t)p * VT_STRIDE);
#pragma unroll
            for (int i = 0; i < 4; ++i) { const int item = tid + 512 * i, d = item >> 5, rc = item & 31, r = rc / cpr, c = rc % cpr;
                unsigned short e8[8];
#pragma unroll
                for (int e = 0; e < 8; ++e) e8[e] = vt[d * 264 + r + dil * (8 * c + e)];
                u32x4 o; o.x = e8[0] | ((unsigned)e8[1] << 16); o.y = e8[2] | ((unsigned)e8[3] << 16); o.z = e8[4] | ((unsigned)e8[5] << 16); o.w = e8[6] | ((unsigned)e8[7] << 16);
                *(u32x4*)(VTp + (((size_t)bh * dil + r) * 64 + d) * Lp + tb / dil + 8 * c) = o; }
        }
        bsync();
    }
}

DEV int perm_pi(int sg) { return 32 * (sg >> 5) + 16 * ((sg & 7) >> 2) + 4 * ((sg >> 3) & 3) + (sg & 3); }
DEV int perm_inv(int a) { return 32 * (a >> 5) + 8 * ((a >> 2) & 3) + 4 * ((a >> 4) & 1) + (a & 3); }
constexpr int GL_QF = 0, GL_KF = 16640, GL_VF = 33280, GL_QB = 49920, GL_KB = 59136, GL_GM = 68352, GL_QKM = 84992, GL_LM = 101632, GL_GS = 134400;
DEV void gdnprep_units(Frame& F, int L) {
    LAS float* QF = (LAS float*)(F.lds + GL_QF); LAS float* KF = (LAS float*)(F.lds + GL_KF); LAS float* VF = (LAS float*)(F.lds + GL_VF);
    LAS bf16_t* QB = (LAS bf16_t*)(F.lds + GL_QB); LAS bf16_t* KB = (LAS bf16_t*)(F.lds + GL_KB);
    LAS float* GM = (LAS float*)(F.lds + GL_GM); LAS float* QKM = (LAS float*)(F.lds + GL_QKM); LAS float* LM = (LAS float*)(F.lds + GL_LM);
    LAS float* GRAW = (LAS float*)(F.lds + GL_GS); LAS float* BETA = GRAW + 128; LAS float* GC = GRAW + 256;
    const int tid = F.tid, lane = F.lane, w = F.wave;
    for (int unit = F.wg; unit < BATCH * CHN * NCH; unit += F.G) {
        const int n = unit % NCH, bhh = unit / NCH, h = bhh % CHN, b = bhh / CHN;
#pragma unroll 1
        for (int i = 0; i < 3; ++i) {
            const int item = tid + 512 * i, t = item / 24, cg = item % 24, which = cg >> 3, c8 = cg & 7, ch = which * CW + h * 64 + c8 * 8;
            float acc[8];
#pragma unroll
            for (int e = 0; e < 8; ++e) acc[e] = 0.f;
#pragma unroll
            for (int kk = 0; kk < 5; ++kk) {
                const int s = n * 64 + t + kk - 2;
                if (s >= 0 && s < SEQ) {
                    float xv[8]; unpack8(*(const u32x4*)(F.PROJ() + (size_t)(b * SEQ + s) * INWP + O_CQKV + ch), xv);
                    const float* wp = F.conv_w() + ((size_t)L * 5 + kk) * 3 * CW + ch;
                    const f32x4 w0 = *(const f32x4*)wp, w1 = *(const f32x4*)(wp + 4);
#pragma unroll
                    for (int e = 0; e < 4; ++e) { acc[e] += xv[e] * w0[e]; acc[4 + e] += xv[4 + e] * w1[e]; }
                }
            }
            LAS float* dst = (which == 0 ? QF : (which == 1 ? KF : VF)) + t * 65 + c8 * 8;
#pragma unroll
            for (int e = 0; e < 8; ++e) dst[e] = siluf_(acc[e]);
        }
        bsync();
        {
            const int row = tid >> 2, qd = tid & 3, t = row & 63; LAS float* X = (row < 64 ? QF : KF) + t * 65 + qd * 16;
            float ss = 0.f;
#pragma unroll
            for (int i = 0; i < 16; ++i) ss += X[i] * X[i];
            ss += shx(ss, 1); ss += shx(ss, 2);
            const float sc = frsqrt(ss + NORM_EPS) * (row < 64 ? 0.125f : 1.0f);
            LAS bf16_t* XB = (row < 64 ? QB : KB) + t * 72 + qd * 16;
#pragma unroll
            for (int i = 0; i < 16; ++i) { const float y = X[i] * sc; X[i] = y; XB[i] = (bf16_t)f2bf(y); }
            if (tid < 128) {
                const int dir = tid >> 6, tt = tid & 63; const size_t tok = (size_t)b * SEQ + n * 64 + tt;
                const float a = bf2f(F.PROJ()[tok * INWP + O_CA + dir * CHN + h]), bb = bf2f(F.PROJ()[tok * INWP + O_CB + dir * CHN + h]);
                GRAW[dir * 64 + tt] = -fexp(F.a_log()[((size_t)L * 2 + dir) * CHN + h]) * softplusf_(a + F.dt_bias()[((size_t)L * 2 + dir) * CHN + h]);
                BETA[dir * 64 + tt] = sigmoidf_(bb);
            }
        }
        bsync();
        if (tid < 2) { float a = 0.f; for (int tau = 0; tau < 64; ++tau) { const int t = tid ? 63 - tau : tau; a += GRAW[tid * 64 + t]; GC[tid * 64 + tau] = a; } }
        {
            const int mat = w >> 2, tt = w & 3, c = lane & 15, g4 = lane >> 4;
            const LAS bf16_t* XA = (mat ? QB : KB) + (tt * 16 + c) * 72 + g4 * 8;
            const bf16x8 a0 = *(const LAS bf16x8*)XA, a1 = *(const LAS bf16x8*)(XA + 32);
            LAS float* OUT = mat ? QKM : GM;
#pragma unroll
            for (int ct = 0; ct < 4; ++ct) {
                const LAS bf16_t* XBp = KB + (ct * 16 + c) * 72 + g4 * 8;
                f32x4 acc = {0.f, 0.f, 0.f, 0.f};
                acc = mfma16(a0, *(const LAS bf16x8*)XBp, acc); acc = mfma16(a1, *(const LAS bf16x8*)(XBp + 32), acc);
#pragma unroll
                for (int i = 0; i < 4; ++i) OUT[(tt * 16 + 4 * g4 + i) * 65 + ct * 16 + c] = acc[i];
            }
        }
        bsync();
#pragma unroll 1
        for (int i = 0; i < 16; ++i) {
            const int id = tid + 512 * i, dir = id >> 12, tau = (id >> 6) & 63, sg = id & 63;
            const int t = dir ? 63 - tau : tau, s = dir ? 63 - sg : sg;
            LM[id] = (sg < tau) ? BETA[dir * 64 + t] * GM[t * 65 + s] * fexp(GC[dir * 64 + tau] - GC[dir * 64 + sg]) : 0.f;
        }
        bsync();
        if (tid < 256) {
            const int dir = tid >> 7, c = tid & 127;
            const LAS float* Lm = LM + dir * 4096; const LAS float* SRC = (c < 64) ? (VF + c) : (KF + (c - 64));
            float x[64];
#pragma unroll
            for (int tau = 0; tau < 64; ++tau) {
                const int t = dir ? 63 - tau : tau;
                float a = SRC[t * 65] * BETA[dir * 64 + t] * ((c >= 64) ? fexp(GC[dir * 64 + tau]) : 1.0f);
#pragma unroll
                for (int sg = 0; sg < tau; ++sg) a -= Lm[tau * 64 + sg] * x[sg];
                ASMV("" : "+v"(a) :: "memory");
                x[tau] = a;
            }
            const int chain = (b * CHN + h) * 2 + dir, mm = dir ? NCH - 1 - n : n;
            unsigned char* rec = F.REC() + ((size_t)chain * NCH + mm) * RECB;
            if (c < 64) { float* U = (float*)(rec + 32768);
#pragma unroll
                for (int tau = 0; tau < 64; ++tau) U[tau * 64 + c] = x[tau]; }
            else { bf16_t* Wp = (bf16_t*)rec; const int sc = perm_inv(c - 64);
#pragma unroll
                for (int tau = 0; tau < 64; ++tau) Wp[tau * 64 + sc] = (bf16_t)f2bf(x[tau]); }
        } else {
            const int t2 = tid - 256;
#pragma unroll 1
            for (int i = 0; i < 12; ++i) {
                const int item = t2 + 256 * i, dir = item / 1536, rem = item % 1536, mat = rem / 512, row = (rem % 512) >> 3, chk = rem & 7;
                const int chain = (b * CHN + h) * 2 + dir, mm = dir ? NCH - 1 - n : n;
                unsigned char* rec = F.REC() + ((size_t)chain * NCH + mm) * RECB;
                float o[8];
#pragma unroll
                for (int e = 0; e < 8; ++e) {
                    const int pi = perm_pi(chk * 8 + e);
                    if (mat == 0) { const int t = dir ? 63 - row : row; o[e] = QF[t * 65 + pi] * fexp(GC[dir * 64 + row]); }
                    else if (mat == 1) { const int t = dir ? 63 - row : row, s = dir ? 63 - pi : pi; o[e] = (pi <= row) ? QKM[t * 65 + s] * fexp(GC[dir * 64 + row] - GC[dir * 64 + pi]) : 0.f; }
                    else { const int s = dir ? 63 - pi : pi; o[e] = KF[s * 65 + row] * fexp(GC[dir * 64 + 63] - GC[dir * 64 + pi]); }
                }
                *(u32x4*)(rec + 8192 + mat * 8192 + row * 128 + chk * 16) = pack8(o);
            }
            if (t2 < 2) { const int chain = (b * CHN + h) * 2 + t2, mm = t2 ? NCH - 1 - n : n; *(float*)(F.REC() + ((size_t)chain * NCH + mm) * RECB + 49152) = fexp(GC[t2 * 64 + 63]); }
        }
        bsync();
    }
}

DEV void attn_units(Frame& F, int L, int wave_id, int n_waves) {
    const int lane = F.lane, r31 = lane & 31, hh = lane >> 5;
    const float gq = wave_max(fabsf(F.q_norm_g()[(size_t)L * 64 + lane])), gk = wave_max(fabsf(F.k_norm_g()[(size_t)L * 64 + lane]));
    const float Cb = 8.0f * gq * gk;
    constexpr int QT = SEQ / 32;
    for (int unit = wave_id; unit < 3 * BATCH * BH * QT; unit += n_waves) {
        const int qt = unit % QT, pbh = unit / QT, bh = pbh % (BATCH * BH), p = pbh / (BATCH * BH);
        const int dil = (p == 0) ? 1 : (p == 1 ? 4 : 16), Lp = SEQ / dil, tpr = Lp / 32, r = qt / tpr, jq = (qt % tpr) * 32;
        const bf16_t* Qb = F.QN() + (size_t)bh * SEQ * 64; const bf16_t* Kb = F.KN() + (size_t)bh * SEQ * 64;
        const bf16_t* VTp = (const bf16_t*)(F.VT() + (size_t)p * VT_STRIDE) + ((size_t)bh * dil + r) * 64 * Lp;
        bf16x8 qf[4];
        { const bf16_t* qp = Qb + (size_t)(r + dil * (jq + r31)) * 64 + 8 * hh;
#pragma unroll
          for (int s = 0; s < 4; ++s) qf[s] = *(const bf16x8*)(qp + 16 * s); }
        f32x16 o0, o1; for (int i = 0; i < 16; ++i) { o0[i] = 0.f; o1[i] = 0.f; }
        float lsum = 0.f;
#pragma unroll 1
        for (int kt = 0; kt < 5; ++kt) {
            const int jk = jq - 64 + 32 * kt;
            if (jk + 31 < 0 || jk >= Lp) continue;
            f32x16 sc; for (int i = 0; i < 16; ++i) sc[i] = 0.f;
            { const bf16_t* kp = Kb + (size_t)(r + dil * (jk + r31)) * 64 + 8 * hh;
#pragma unroll
              for (int s = 0; s < 4; ++s) sc = mfma32(*(const bf16x8*)(kp + 16 * s), qf[s], sc); }
            float pv[16];
#pragma unroll
            for (int i = 0; i < 16; ++i) { const int kj = jk + (i & 3) + 8 * (i >> 2) + 4 * hh, dlt = kj - (jq + r31);
                const float e = fexp(sc[i] - Cb); pv[i] = (dlt <= 64 && dlt >= -64) ? e : 0.f; lsum += pv[i]; }
            const bf16x8 p0 = __builtin_bit_cast(bf16x8, pack8(pv)), p1 = __builtin_bit_cast(bf16x8, pack8(pv + 8));
#pragma unroll
            for (int dt = 0; dt < 2; ++dt) {
                const bf16_t* vp = VTp + (size_t)(dt * 32 + r31) * Lp + jk + 4 * hh;
                u32x4 a0, a1; { const u32x2 x0 = *(const u32x2*)vp, x1 = *(const u32x2*)(vp + 8), x2 = *(const u32x2*)(vp + 16), x3 = *(const u32x2*)(vp + 24);
                    a0.x = x0.x; a0.y = x0.y; a0.z = x1.x; a0.w = x1.y; a1.x = x2.x; a1.y = x2.y; a1.z = x3.x; a1.w = x3.y; }
                if (dt == 0) { o0 = mfma32(__builtin_bit_cast(bf16x8, a0), p0, o0); o0 = mfma32(__builtin_bit_cast(bf16x8, a1), p1, o0); }
                else { o1 = mfma32(__builtin_bit_cast(bf16x8, a0), p0, o1); o1 = mfma32(__builtin_bit_cast(bf16x8, a1), p1, o1); }
            }
        }
        lsum += shx(lsum, 32);
        const int b = bh / BH, h = bh % BH; const size_t tok = (size_t)b * SEQ + r + dil * (jq + r31);
        bf16_t* np = F.NUM() + (size_t)p * (VT_STRIDE / 2) + tok * BW + h * 64;
#pragma unroll
        for (int g4 = 0; g4 < 4; ++g4) {
            u32x2 w0; w0.x = pk2(o0[4 * g4], o0[4 * g4 + 1]); w0.y = pk2(o0[4 * g4 + 2], o0[4 * g4 + 3]); *(u32x2*)(np + 8 * g4 + 4 * hh) = w0;
            u32x2 w1; w1.x = pk2(o1[4 * g4], o1[4 * g4 + 1]); w1.y = pk2(o1[4 * g4 + 2], o1[4 * g4 + 3]); *(u32x2*)(np + 32 + 8 * g4 + 4 * hh) = w1;
        }
        if (hh == 0) F.DEN()[((size_t)p * M + tok) * BH + h] = lsum;
    }
}

DEV void scan_chains(Frame& F, int slot, int nslots) {
    const int tid = F.tid, lane = F.lane, w = F.wave, c = lane & 15, g4 = lane >> 4;
    for (int chain = slot; chain < NCHAIN; chain += nslots) {
        const int dir = chain & 1, bhh = chain >> 1, h = bhh % CHN, b = bhh / CHN;
        const unsigned char* recs = F.REC() + (size_t)chain * NCH * RECB;
        for (int i = tid; i < RECB / 16; i += NTHREADS) *(LAS u32x4*)(F.lds + i * 16) = *(const u32x4*)(recs + (size_t)i * 16);
        bsync();
        f32x4 S[4];
#pragma unroll
        for (int i = 0; i < 4; ++i) S[i] = (f32x4){0.f, 0.f, 0.f, 0.f};
        bf16_t* Ob = F.OFB() + (size_t)dir * M * CW;
#pragma unroll 1
        for (int m = 0; m < NCH; ++m) {
            LAS unsigned char* buf = F.lds + (m & 1) * RECB;
            if (w >= 4) {
                if (m + 1 < NCH) { const unsigned char* src = recs + (size_t)(m + 1) * RECB; LAS unsigned char* dst = F.lds + ((m + 1) & 1) * RECB;
                    for (int i = tid - 256; i < RECB / 16; i += 256) *(LAS u32x4*)(dst + i * 16) = *(const u32x4*)(src + (size_t)i * 16); }
            } else {
                const LAS unsigned char* Wp = buf; const LAS unsigned char* Qp = buf + 8192; const LAS unsigned char* QKp = buf + 16384; const LAS unsigned char* Ktp = buf + 24576;
                const LAS float* U = (const LAS float*)(buf + 32768); const float gamma = *(const LAS float*)(buf + 49152);
                const int aoff = c * 128 + g4 * 16;
                bf16x8 Sb[2];
#pragma unroll
                for (int ks = 0; ks < 2; ++ks) { u32x4 t; t.x = pk2(S[2 * ks][0], S[2 * ks][1]); t.y = pk2(S[2 * ks][2], S[2 * ks][3]); t.z = pk2(S[2 * ks + 1][0], S[2 * ks + 1][1]); t.w = pk2(S[2 * ks + 1][2], S[2 * ks + 1][3]); Sb[ks] = __builtin_bit_cast(bf16x8, t); }
                f32x4 VN[4];
#pragma unroll
                for (int tt = 0; tt < 4; ++tt) {
                    f32x4 a = {0.f, 0.f, 0.f, 0.f};
#pragma unroll
                    for (int ks = 0; ks < 2; ++ks) a = mfma16(*(const LAS bf16x8*)(Wp + tt * 2048 + aoff + ks * 64), Sb[ks], a);
#pragma unroll
                    for (int i = 0; i < 4; ++i) VN[tt][i] = U[(16 * tt + 4 * g4 + i) * 64 + 16 * w + c] - a[i];
                }
                bf16x8 VNb[2];
#pragma unroll
                for (int ks = 0; ks < 2; ++ks) { u32x4 t; t.x = pk2(VN[2 * ks][0], VN[2 * ks][1]); t.y = pk2(VN[2 * ks][2], VN[2 * ks][3]); t.z = pk2(VN[2 * ks + 1][0], VN[2 * ks + 1][1]); t.w = pk2(VN[2 * ks + 1][2], VN[2 * ks + 1][3]); VNb[ks] = __builtin_bit_cast(bf16x8, t); }
                const int nchunk = dir ? NCH - 1 - m : m;
#pragma unroll
                for (int tt = 0; tt < 4; ++tt) {
                    f32x4 o = {0.f, 0.f, 0.f, 0.f};
#pragma unroll
                    for (int ks = 0; ks < 2; ++ks) o = mfma16(*(const LAS bf16x8*)(Qp + tt * 2048 + aoff + ks * 64), Sb[ks], o);
#pragma unroll
                    for (int ks = 0; ks < 2; ++ks) o = mfma16(*(const LAS bf16x8*)(QKp + tt * 2048 + aoff + ks * 64), VNb[ks], o);
#pragma unroll
                    for (int i = 0; i < 4; ++i) { const int tau = 16 * tt + 4 * g4 + i, s = nchunk * 64 + (dir ? 63 - tau : tau);
                        Ob[((size_t)b * SEQ + s) * CW + h * 64 + 16 * w + c] = (bf16_t)f2bf(o[i]); }
                }
#pragma unroll
                for (int rt = 0; rt < 4; ++rt) {
                    f32x4 a = S[rt] * gamma;
#pragma unroll
                    for (int ks = 0; ks < 2; ++ks) a = mfma16(*(const LAS bf16x8*)(Ktp + rt * 2048 + aoff + ks * 64), VNb[ks], a);
                    S[rt] = a;
                }
            }
            bsync();
        }
    }
}

DEV void phase_assemble(Frame& F, int L) {
    const int nitems = M * (BH + CHN) * 4;
    const int stride = F.G * NTHREADS;
    for (int it0 = F.wg * NTHREADS; it0 < nitems; it0 += stride) {
        const int it = it0 + F.tid; const bool live = it < nitems;
        const int qd = it & 3, hd = live ? (it >> 2) % (BH + CHN) : 0, tok = live ? (it >> 2) / (BH + CHN) : 0;
        float v[16]; float ss = 0.f; bf16_t* dst;
        if (hd < BH) {
#pragma unroll
            for (int i = 0; i < 16; ++i) v[i] = 0.f;
            float den = 0.f;
#pragma unroll
            for (int p = 0; p < 3; ++p) { const bf16_t* np = F.NUM() + (size_t)p * (VT_STRIDE / 2) + (size_t)tok * BW + hd * 64 + qd * 16; float t[16]; unpack8(*(const u32x4*)np, t); unpack8(*(const u32x4*)(np + 8), t + 8);
#pragma unroll
                for (int i = 0; i < 16; ++i) v[i] += t[i];
                den += F.DEN()[((size_t)p * M + tok) * BH + hd]; }
            const float inv = 1.0f / den;
#pragma unroll
            for (int i = 0; i < 16; ++i) v[i] *= inv;
            dst = F.ACT() + (size_t)tok * DM + GW + hd * 64 + qd * 16;
        } else {
            const int hc = hd - BH; float bb[16], gt[16];
            const bf16_t* of = F.OFB() + (size_t)tok * CW + hc * 64 + qd * 16; const bf16_t* ob = of + (size_t)M * CW;
            unpack8(*(const u32x4*)of, v); unpack8(*(const u32x4*)(of + 8), v + 8); unpack8(*(const u32x4*)ob, bb); unpack8(*(const u32x4*)(ob + 8), bb + 8);
            const bf16_t* gp = F.PROJ() + (size_t)tok * INWP + O_CG + hc * 64 + qd * 16; unpack8(*(const u32x4*)gp, gt); unpack8(*(const u32x4*)(gp + 8), gt + 8);
            const float* og = F.o_norm_g() + (size_t)L * 64 + qd * 16;
#pragma unroll
            for (int i = 0; i < 16; ++i) { v[i] += bb[i]; ss += v[i] * v[i]; v[i] *= og[i] * siluf_(gt[i]); }
            dst = F.ACT() + (size_t)tok * DM + GW + BW + hc * 64 + qd * 16;
        }
        ss += shx(ss, 1); ss += shx(ss, 2);
        const float rstd = (hd < BH) ? 1.0f : frsqrt(ss * (1.f / 64.f) + NORM_EPS);
#pragma unroll
        for (int i = 0; i < 16; ++i) v[i] *= rstd;
        if (live) { *(u32x4*)dst = pack8(v); *(u32x4*)(dst + 8) = pack8(v + 8); }
    }
}

DEV void phase_router(Frame& F, int L) {
    LAS float* WRT = (LAS float*)F.lds;
    for (int i = F.tid; i < DM * NEXP; i += NTHREADS) { const int d = i / NEXP, e = i % NEXP; WRT[e * DM + d] = F.w_router()[(size_t)L * DM * NEXP + i]; }
    bsync();
    const int gw = F.wg * NWAVES + F.wave, NGW = F.G * NWAVES, lane = F.lane;
    for (int m = gw; m < M; m += NGW) {
        const f32x4* xr = (const f32x4*)(F.out() + (size_t)m * DM) + lane;
        f32x4 v[NJ]; float s = 0.f;
#pragma unroll
        for (int j = 0; j < NJ; ++j) { v[j] = xr[64 * j]; s += (v[j][0] * v[j][0] + v[j][1] * v[j][1]) + (v[j][2] * v[j][2] + v[j][3] * v[j][3]); }
        const float rstd = frsqrt(wave_sum(s) * (1.f / DM) + NORM_EPS);
        u32x2* o8 = (u32x2*)(F.ACT() + (size_t)m * DM) + lane;
#pragma unroll
        for (int j = 0; j < NJ; ++j) { const f32x4 g = *((const f32x4*)(F.g_ffn() + (size_t)L * DM) + lane + 64 * j); v[j] = v[j] * rstd * g; u32x2 o; o.x = pk2(v[j][0], v[j][1]); o.y = pk2(v[j][2], v[j][3]); o8[64 * j] = o; }
        float mine = -3.0e38f;
#pragma unroll 1
        for (int e = 0; e < NEXP; ++e) { float a = 0.f;
#pragma unroll
            for (int j = 0; j < NJ; ++j) { const f32x4 wv = *((const LAS f32x4*)(WRT + e * DM) + lane + 64 * j); a += (v[j][0] * wv[0] + v[j][1] * wv[1]) + (v[j][2] * wv[2] + v[j][3] * wv[3]); }
            a = wave_sum(a); mine = (lane == e) ? a : mine; }
        const float mx = wave_max(mine);
        const float ex = (lane < NEXP) ? expf(mine - mx) : 0.f;
        mine = ex / wave_sum(ex);
        const int b = m / SEQ, sq = m % SEQ;
        if (lane < NEXP) F.AFF()[((size_t)b * NEXP + lane) * SEQ + sq] = mine;
    }
}

constexpr int KPT = (SEQ + NTHREADS - 1) / NTHREADS;
DEV unsigned block_sum_u(Frame& F, unsigned v, int parity) {
    LAS unsigned* red = (LAS unsigned*)(F.lds + 1024) + parity * 8;
    float f = (float)v; f = wave_sum(f);
    if (F.lane == 0) red[F.wave] = (unsigned)f;
    bsync();
    unsigned t = 0;
#pragma unroll
    for (int i = 0; i < NWAVES; ++i) t += red[i];
    return t;
}
DEV void phase_topk(Frame& F) {
    const int tid = F.tid, lane = F.lane;
    for (int pair = F.wg; pair < BATCH * NEXP; pair += F.G) {
        const int b = pair / NEXP, e = pair % NEXP;
        const float* aff = F.AFF() + (size_t)pair * SEQ;
        unsigned key[KPT];
#pragma unroll
        for (int i = 0; i < KPT; ++i) { const int s = tid * KPT + i; key[i] = (s < SEQ) ? __builtin_bit_cast(unsigned, aff[s]) : 0u; }
        unsigned prefix = 0u; int par = 0;
#pragma unroll 1
        for (int bit = 30; bit >= 0; --bit) {
            const unsigned cand = prefix | (1u << bit); unsigned cnt = 0;
#pragma unroll
            for (int i = 0; i < KPT; ++i) cnt += (key[i] >= cand) ? 1u : 0u;
            const unsigned tot = block_sum_u(F, cnt, par); par ^= 1;
            if (tot >= (unsigned)CAP) prefix = cand;
        }
        unsigned cgt = 0, ceq = 0;
#pragma unroll
        for (int i = 0; i < KPT; ++i) { cgt += (key[i] > prefix) ? 1u : 0u; ceq += (key[i] == prefix) ? 1u : 0u; }
        const unsigned ngt = block_sum_u(F, cgt, par); par ^= 1;
        const unsigned rr = (unsigned)CAP - ngt;
        unsigned v = cgt | (ceq << 16), inc = v;
#pragma unroll
        for (int d = 1; d < 64; d <<= 1) { const unsigned t = shup(inc, d); if (lane >= d) inc += t; }
        LAS unsigned* wt = (LAS unsigned*)(F.lds + 2048);
        if (lane == 63) wt[F.wave] = inc;
        bsync();
        unsigned base = 0;
#pragma unroll
        for (int i = 0; i < NWAVES; ++i) base += (i < F.wave) ? wt[i] : 0u;
        unsigned excl = base + inc - v; unsigned gtb = excl & 0xffffu, eqb = excl >> 16;
#pragma unroll
        for (int i = 0; i < KPT; ++i) { const int s = tid * KPT + i; if (s < SEQ) {
            const bool isgt = key[i] > prefix, iseq = key[i] == prefix; const bool sel = isgt || (iseq && eqb < rr);
            const unsigned slot = gtb + (eqb < rr ? eqb : rr);
            if (sel) { const size_t row = ((size_t)e * BATCH + b) * CAP + slot; F.IDX()[row] = s; F.GATEV()[row] = __builtin_bit_cast(float, key[i]); }
            F.INV()[((size_t)b * SEQ + s) * NEXP + e] = sel ? (int)slot : -1;
            gtb += isgt ? 1u : 0u; eqb += iseq ? 1u : 0u; } }
        bsync();
    }
}

DEV void phase_gather(Frame& F, int L) {
    const int gw = F.wg * NWAVES + F.wave, NGW = F.G * NWAVES, lane = F.lane;
    for (int row = gw; row < MR; row += NGW) {
        const int b = (row / CAP) % BATCH; const int s = F.IDX()[row];
        const u32x4* src = (const u32x4*)(F.ACT() + ((size_t)b * SEQ + s) * DM); u32x4* dst = (u32x4*)(F.XE() + (size_t)row * DM);
#pragma unroll
        for (int j = 0; j < DM / 512; ++j) dst[lane + 64 * j] = src[lane + 64 * j];
    }
    for (int m = gw; m < M; m += NGW) {
        const f32x4 v = *((const f32x4*)(F.p() + ((size_t)L * M + m) * PLE) + lane);
        u32x2 o; o.x = pk2(v[0], v[1]); o.y = pk2(v[2], v[3]); *((u32x2*)(F.PB() + (size_t)m * PLE) + lane) = o;
    }
}

DEV void phase_combine(Frame& F, int L) {
    const int gw = F.wg * NWAVES + F.wave, NGW = F.G * NWAVES, lane = F.lane;
    for (int m = gw; m < M; m += NGW) {
        const int b = m / SEQ;
        f32x4* xr = (f32x4*)(F.out() + (size_t)m * DM) + lane;
        f32x4 v[NJ];
#pragma unroll
        for (int j = 0; j < NJ; ++j) v[j] = xr[64 * j];
#pragma unroll 1
        for (int e = 0; e < NEXP; ++e) {
            const int slot = F.INV()[(size_t)m * NEXP + e];
            if (slot >= 0) { const u32x2* yr = (const u32x2*)(F.YE() + (((size_t)e * BATCH + b) * CAP + slot) * DM) + lane;
#pragma unroll
                for (int j = 0; j < NJ; ++j) { const u32x2 y = yr[64 * j]; v[j][0] += lo16(y.x); v[j][1] += hi16(y.x); v[j][2] += lo16(y.y); v[j][3] += hi16(y.y); } }
        }
        float s = 0.f;
#pragma unroll
        for (int j = 0; j < NJ; ++j) { xr[64 * j] = v[j]; s += (v[j][0] * v[j][0] + v[j][1] * v[j][1]) + (v[j][2] * v[j][2] + v[j][3] * v[j][3]); }
        const float rstd = frsqrt(wave_sum(s) * (1.f / DM) + NORM_EPS);
        u32x2* o8 = (u32x2*)(F.ACT() + (size_t)m * DM) + lane;
#pragma unroll
        for (int j = 0; j < NJ; ++j) { const f32x4 g = *((const f32x4*)(F.g_ple_gate() + (size_t)L * DM) + lane + 64 * j); u32x2 o; o.x = pk2(v[j][0] * rstd * g[0], v[j][1] * rstd * g[1]); o.y = pk2(v[j][2] * rstd * g[2], v[j][3] * rstd * g[3]); o8[64 * j] = o; }
        u32x2* er = (u32x2*)(F.ERAW() + (size_t)m * DM) + lane; f32x4 ev[NJ]; float es = 0.f;
#pragma unroll
        for (int j = 0; j < NJ; ++j) { const u32x2 y = er[64 * j]; ev[j] = (f32x4){lo16(y.x), hi16(y.x), lo16(y.y), hi16(y.y)}; es += (ev[j][0] * ev[j][0] + ev[j][1] * ev[j][1]) + (ev[j][2] * ev[j][2] + ev[j][3] * ev[j][3]); }
        const float ers = frsqrt(wave_sum(es) * (1.f / DM) + NORM_EPS);
#pragma unroll
        for (int j = 0; j < NJ; ++j) { const f32x4 g = *((const f32x4*)(F.g_ple() + (size_t)L * DM) + lane + 64 * j); u32x2 o; o.x = pk2(ev[j][0] * ers * g[0], ev[j][1] * ers * g[1]); o.y = pk2(ev[j][2] * ers * g[2], ev[j][3] * ers * g[3]); er[64 * j] = o; }
    }
}

__global__ void __launch_bounds__(NTHREADS, 2) mega_fwd(Args args) {
#ifndef HOST_EMU
    extern __shared__ __attribute__((aligned(16))) unsigned char lds_raw[];
    LAS unsigned char* lds = (LAS unsigned char*)lds_raw;
#else
    unsigned char* lds = emu::g_lds;
#endif
    Frame F;
    F.lds = lds; F.tid = threadIdx.x; F.lane = F.tid & 63; F.wave = rfl(F.tid >> 6); F.G = gridDim.x; F.wg = blockIdx.x; F.a = &args;
    unsigned char* ws = args.ws;
    const int lo = args.ph_lo, hi = args.ph_hi;
#ifndef HOST_EMU
    volatile LAS unsigned* MISC = (volatile LAS unsigned*)(lds + LDS_MISC);
    if (F.tid < 64) MISC[F.tid] = 0u;
    __syncthreads();
    XcdBarrier bar; bar.bar = (unsigned*)(ws + WS_CTL) + 4096; bar.x = 0; bar.st = MISC;
    if (hi - lo > 1) bar = xcd_barrier_post((unsigned*)(ws + WS_CTL) + 4096, MISC);
#define SEAM(k) do { if ((k) + 1 < hi) xcd_barrier(bar); } while (0)
#else
#define SEAM(k) do {} while (0)
#endif
#ifndef PH_MASK
#define PH_MASK 0xFFFFFFFFu
#endif
#define IN(k) (((PH_MASK >> (((k) == 0) ? 0 : (((k) - 1) % NPH) + 1)) & 1u) && lo <= (k) && (k) < hi)
    if (IN(0)) { phase_prologue(F); SEAM(0); }
#pragma unroll 1
    for (int L = 0; L < DEPTH; ++L) {
        const int pb = 1 + L * NPH;
        ASMV("" : "+v"(F.tid)); ASMV("" : "+s"(F.wg), "+s"(F.G)); F.lane = F.tid & 63; F.wave = rfl(F.tid >> 6);
        if (IN(pb + 0)) { phase_pw(F, L); SEAM(pb + 0); }
        if (IN(pb + 1)) { phase_norm1(F, L); SEAM(pb + 1); }
        if (IN(pb + 2)) {
            pg8::Gemm g{F.ACT(), F.WIN(), M, INWP, DM, 0, 0}; pg8::StaticOrder S; S.init(M, INWP, F.G, F.wg);
            pg8::EpiBf16 E{F.PROJ(), INWP}; pg8::gemm_phase(lds, g, S, E, F.tid); SEAM(pb + 2);
        }
        if (IN(pb + 3)) { gmlp_units(F, L); attnprep_units(F, L); gdnprep_units(F, L); SEAM(pb + 3); }
        if (IN(pb + 4)) {
            int nsc = NCHAIN < (F.G * 3) / 4 ? NCHAIN : (F.G * 3) / 4; if (nsc < 1) nsc = 1;
            if (F.G == 1) { scan_chains(F, 0, 1); attn_units(F, L, F.wave, NWAVES); }
            else if (F.wg < nsc) scan_chains(F, F.wg, nsc);
            else attn_units(F, L, (F.wg - nsc) * NWAVES + F.wave, (F.G - nsc) * NWAVES);
            SEAM(pb + 4);
        }
        if (IN(pb + 5)) { phase_assemble(F, L); SEAM(pb + 5); }
        if (IN(pb + 6)) {
            pg8::Gemm g{F.ACT(), F.WOUT(), M, DM, DM, 0, 0}; pg8::StaticOrder S; S.init(M, DM, F.G, F.wg);
            pg8::EpiResF32 E{(L == 0) ? F.x() : F.out(), F.out(), DM}; pg8::gemm_phase(lds, g, S, E, F.tid); SEAM(pb + 6);
        }
        if (IN(pb + 7)) { phase_router(F, L); SEAM(pb + 7); }
        if (IN(pb + 8)) { phase_topk(F); SEAM(pb + 8); }
        if (IN(pb + 9)) { phase_gather(F, L); SEAM(pb + 9); }
        if (IN(pb + 10)) {
            pg8::Gemm g{F.XE(), F.WGU(), MR, 2 * DE, DM, ROWS_E / 256, (size_t)2 * DE * DM * 2}; pg8::StaticOrder S; S.init(MR, 2 * DE, F.G, F.wg);
            pg8::EpiSwiGLU E{F.HID(), DE}; pg8::gemm_phase(lds, g, S, E, F.tid); SEAM(pb + 10);
        }
        if (IN(pb + 11)) {
            { pg8::Gemm g{F.HID(), F.WD(), MR, DM, DE, ROWS_E / 256, (size_t)DM * DE * 2}; pg8::StaticOrder S; S.init(MR, DM, F.G, F.wg);
              pg8::EpiScaleBf16 E{F.YE(), DM, F.GATEV()}; pg8::gemm_phase(lds, g, S, E, F.tid); }
            { pg8::Gemm g{F.PB(), F.WPLE(), M, DM, PLE, 0, 0}; pg8::StaticOrder S; S.init(M, DM, F.G, F.wg);
              pg8::EpiBf16 E{F.ERAW(), DM}; pg8::gemm_phase(lds, g, S, E, F.tid); }
            SEAM(pb + 11);
        }
        if (IN(pb + 12)) { phase_combine(F, L); SEAM(pb + 12); }
        if (IN(pb + 13)) {
            pg8::Gemm g{F.ACT(), F.WPG(), M, DM, DM, 0, 0}; pg8::StaticOrder S; S.init(M, DM, F.G, F.wg);
            pg8::EpiPleGate E{F.out(), F.ERAW(), DM}; pg8::gemm_phase(lds, g, S, E, F.tid); SEAM(pb + 13);
        }
    }
#undef IN
#undef SEAM
}

#ifndef N_LAUNCH_MODE
#define N_LAUNCH_MODE 0
#endif
extern "C" void kernel_launch(void* const* d_in, const int* in_sizes, int n_in, void* d_out, int out_size, void* d_ws, size_t ws_size, hipStream_t stream) {
    Args a;
    memset(&a, 0, sizeof(a));
    for (int i = 0; i < 25; ++i) a.in[i] = d_in[i];
    a.out = (float*)d_out; a.ws = (unsigned char*)d_ws;
#ifndef HOST_EMU
    static int grid = 0;
    if (grid == 0) {
        int dev = 0, cus = 0;
        if (n_in != 25 || out_size != M * DM || ws_size < WS_END) { fprintf(stderr, "kernel_launch: unexpected shapes (n_in %d out %d ws %zu need %zu)\n", n_in, out_size, ws_size, (size_t)WS_END); grid = -1; return; }
        if (hipGetDevice(&dev) != hipSuccess || hipDeviceGetAttribute(&cus, hipDeviceAttributeMultiprocessorCount, dev) != hipSuccess) { grid = -1; return; }
        if (hipFuncSetAttribute((const void*)mega_fwd, hipFuncAttributeMaxDynamicSharedMemorySize, LDS_BYTES) != hipSuccess) { fprintf(stderr, "kernel_launch: hipFuncSetAttribute failed\n"); grid = -1; return; }
        int per_cu = 0;
        if (hipOccupancyMaxActiveBlocksPerMultiprocessor(&per_cu, (const void*)mega_fwd, NTHREADS, LDS_BYTES) != hipSuccess || per_cu < 1) fprintf(stderr, "kernel_launch: occupancy query says %d\n", per_cu);
        (void)hipGetLastError();
        grid = cus;
    }
    if (grid < 0) return;
    (void)hipMemsetAsync((char*)d_ws + WS_CTL, 0, CTL_BYTES, stream);
    if (N_LAUNCH_MODE == 1) { a.ph_lo = 0; a.ph_hi = NPHASES; hipLaunchKernelGGL(mega_fwd, dim3(grid), dim3(NTHREADS), LDS_BYTES, stream, a); }
    else for (int ph = 0; ph < NPHASES; ++ph) { a.ph_lo = ph; a.ph_hi = ph + 1; hipLaunchKernelGGL(mega_fwd, dim3(grid), dim3(NTHREADS), LDS_BYTES, stream, a); }
#else
    (void)in_sizes; (void)n_in; (void)out_size; (void)ws_size; (void)stream;
    for (int ph = emu_ph_lo; ph < emu_ph_hi && ph < NPHASES; ++ph) { a.ph_lo = ph; a.ph_hi = ph + 1; Args aa = a; emu::launch([aa]() { mega_fwd(aa); }, emu_grid, NTHREADS, LDS_BYTES); fprintf(stderr, "phase %d done\n", ph); }
#endif
}
```

```cpp
#ifndef HOST_EMU
#include <hip/hip_runtime.h>
#include <cstdio>
#include <cstdint>
#include <cstring>
#define DEV __device__ __forceinline__
#define DEVM __device__ __forceinline__
#define LAS __attribute__((address_space(3)))
#define ASMV(...) asm volatile(__VA_ARGS__)
#else
#define DEV static inline
#define DEVM inline
#define LAS
#define ASMV(...) do {} while (0)
#define __global__
#define __launch_bounds__(...)
#endif

typedef unsigned short bf16_t;
typedef short bf16x8 __attribute__((ext_vector_type(8)));
typedef float f32x4 __attribute__((ext_vector_type(4)));
typedef float f32x16 __attribute__((ext_vector_type(16)));
typedef unsigned u32x4 __attribute__((ext_vector_type(4)));
typedef unsigned u32x2 __attribute__((ext_vector_type(2)));

#ifdef CFG_SMALL
constexpr int BATCH = 2, SEQ = 512, DM = 512, DEPTH = 2, NEXP = 4;
#else
constexpr int BATCH = 8, SEQ = 4096, DM = 1024, DEPTH = 4, NEXP = 16;
#endif
constexpr int PLE = 256, HD = 64;
constexpr int GW = DM / 4, GG = GW / HD, GCH = 128;
constexpr int BW = 3 * DM / 8, BH = BW / HD;
constexpr int CW = DM - GW - BW, CHN = CW / HD;
constexpr int CAP = 2 * SEQ / NEXP, DE = DM;
constexpr int M = BATCH * SEQ;
constexpr int O_AU = 0, O_AV = GW, O_BQ = 2 * GW, O_BK = O_BQ + BW, O_BV = O_BK + BW, O_CQKV = O_BV + BW, O_CG = O_CQKV + 3 * CW, O_CA = O_CG + CW, O_CB = O_CA + 2 * CHN, INW = O_CB + 2 * CHN;
constexpr int INWP = (INW + 255) / 256 * 256;
constexpr int ROWS_E = BATCH * CAP, MR = NEXP * ROWS_E;
constexpr int NCH = SEQ / 64;
constexpr int NCHAIN = BATCH * CHN * 2;
constexpr int RECB = 40960;
constexpr float NORM_EPS = 1e-6f;
constexpr int NPH = 14, NPHASES = 1 + NPH * DEPTH;
constexpr int NTHREADS = 512, NWAVES = 8;
static_assert(M % 256 == 0 && ROWS_E % 256 == 0 && DM % 256 == 0 && SEQ % 256 == 0, "shape");

constexpr size_t al4k(size_t x) { return (x + 4095) & ~(size_t)4095; }
constexpr size_t WS_CTL = 0, CTL_BYTES = 1u << 20;
constexpr size_t WS_ROPE = WS_CTL + CTL_BYTES;
constexpr size_t WS_AFF = WS_ROPE + al4k((size_t)M * 16 * 4);
constexpr size_t WS_IDX = WS_AFF + al4k((size_t)BATCH * NEXP * SEQ * 4);
constexpr size_t WS_GATEV = WS_IDX + al4k((size_t)MR * 4);
constexpr size_t WS_INV = WS_GATEV + al4k((size_t)MR * 4);
constexpr size_t WS_DEN = WS_INV + al4k((size_t)M * NEXP * 4);
constexpr size_t WS_GAM = WS_DEN + al4k((size_t)3 * M * BH * 4);
constexpr size_t WS_XPART = WS_GAM + al4k((size_t)NCHAIN * NCH * 4);
constexpr size_t WS_EPART = WS_XPART + al4k((size_t)M * 16 * 4);
constexpr size_t WS_RSTD = WS_EPART + al4k((size_t)M * 16 * 4);
constexpr size_t WS_RSROW = WS_RSTD + al4k((size_t)2 * M * 4);
constexpr size_t WS_PB = WS_RSROW + al4k((size_t)MR * 4);
constexpr size_t WS_WS16 = WS_PB + al4k((size_t)M * PLE * 2);
constexpr size_t WS_WIN = WS_WS16 + al4k((size_t)GG * 128 * 128 * 2);
constexpr size_t WS_WOUT = WS_WIN + al4k((size_t)INWP * DM * 2);
constexpr size_t WS_WGU = WS_WOUT + al4k((size_t)DM * DM * 2);
constexpr size_t WS_WD = WS_WGU + al4k((size_t)NEXP * 2 * DE * DM * 2);
constexpr size_t WS_WPLE = WS_WD + al4k((size_t)NEXP * DM * DE * 2);
constexpr size_t WS_WPG = WS_WPLE + al4k((size_t)DM * PLE * 2);
constexpr size_t WS_XB = WS_WPG + 2 * al4k((size_t)DM * DM * 2);
constexpr size_t WS_ACT = WS_XB + 2 * al4k((size_t)M * DM * 2);
constexpr size_t WS_BIG = WS_ACT + al4k((size_t)M * DM * 2);
constexpr size_t WS_PROJ = WS_BIG;
constexpr size_t WS_QN = WS_PROJ + al4k((size_t)M * INWP * 2);
constexpr size_t WS_KN = WS_QN + al4k((size_t)M * BW * 2);
constexpr size_t WS_VT = WS_KN + al4k((size_t)M * BW * 2);
constexpr size_t VT_STRIDE = al4k((size_t)M * BW * 2);
constexpr size_t WS_NUM = WS_VT + 3 * VT_STRIDE;
constexpr size_t WS_REC = WS_NUM + 3 * VT_STRIDE;
constexpr size_t WS_OF = WS_REC + al4k((size_t)NCHAIN * NCH * RECB);
constexpr size_t WS_MIXEND = WS_OF + al4k((size_t)2 * M * CW * 2);
constexpr size_t WS_XE = WS_BIG;
constexpr size_t WS_HID = WS_XE + al4k((size_t)MR * DM * 2);
constexpr size_t WS_YE = WS_HID + al4k((size_t)MR * DE * 2);
constexpr size_t WS_ERAW = WS_YE + al4k((size_t)MR * DM * 2);
constexpr size_t WS_MOEEND = WS_ERAW + al4k((size_t)M * DM * 2);
constexpr size_t WS_END = WS_MIXEND > WS_MOEEND ? WS_MIXEND : WS_MOEEND;
#ifndef CFG_SMALL
static_assert(WS_END <= ((size_t)1 << 30), "workspace must fit 1 GiB");
#endif

DEV float bf2f(bf16_t b) { unsigned u = ((unsigned)b) << 16; return __builtin_bit_cast(float, u); }
#ifndef HOST_EMU
typedef __bf16 hwbf16x2 __attribute__((ext_vector_type(2)));
typedef float hwf32x2 __attribute__((ext_vector_type(2)));
DEV unsigned pk2(float lo, float hi) { return __builtin_bit_cast(unsigned, __builtin_convertvector((hwf32x2){lo, hi}, hwbf16x2)); }
DEV unsigned f2bf(float f) { return (unsigned)__builtin_bit_cast(unsigned short, (__bf16)f); }
#else
DEV unsigned f2bf(float f) { unsigned u = __builtin_bit_cast(unsigned, f); return (u + 0x7fffu + ((u >> 16) & 1u)) >> 16; }
DEV unsigned pk2(float lo, float hi) { return f2bf(lo) | (f2bf(hi) << 16); }
#endif
DEV float lo16(unsigned w) { return __builtin_bit_cast(float, w << 16); }
DEV float hi16(unsigned w) { return __builtin_bit_cast(float, w & 0xffff0000u); }
#ifndef HOST_EMU
DEV f32x4 mfma16(bf16x8 a, bf16x8 b, f32x4 c) { return __builtin_amdgcn_mfma_f32_16x16x32_bf16(a, b, c, 0, 0, 0); }
DEV f32x16 mfma32(bf16x8 a, bf16x8 b, f32x16 c) { return __builtin_amdgcn_mfma_f32_32x32x16_bf16(a, b, c, 0, 0, 0); }
DEV float shx(float v, int m) { return __shfl_xor(v, m); }
DEV unsigned shup(unsigned v, int d) { return __shfl_up(v, d); }
DEV int shfl_i(int v, int src) { return __shfl(v, src); }
DEV unsigned long long ballot_(bool p) { return __ballot(p); }
DEV void bsync() { __syncthreads(); }
DEV void wsync() { __builtin_amdgcn_wave_barrier(); }
DEV void rawbar() { __builtin_amdgcn_s_barrier(); }
DEV void glds16(const void* g, LAS void* l) { __builtin_amdgcn_global_load_lds((const unsigned*)g, (LAS unsigned*)l, 16, 0, 0); }
DEV float fexp(float x) { return __expf(x); }
DEV float flog(float x) { return __logf(x); }
DEV float frsqrt(float x) { return rsqrtf(x); }
DEV float frcp(float x) { return __builtin_amdgcn_rcpf(x); }
DEV int rfl(int v) { return __builtin_amdgcn_readfirstlane(v); }
#define SETPRIO(n) __builtin_amdgcn_s_setprio(n)
#define SCHEDB() __builtin_amdgcn_sched_barrier(0)
#else
DEV f32x4 mfma16(bf16x8 a, bf16x8 b, f32x4 c) { return emu_mfma16(a, b, c); }
DEV f32x16 mfma32(bf16x8 a, bf16x8 b, f32x16 c) { return emu_mfma32(a, b, c); }
DEV float shx(float v, int m) { return emu_shfl_xor(v, m); }
DEV unsigned shup(unsigned v, int d) { return emu_shfl_up(v, d); }
DEV int shfl_i(int v, int src) { return emu_shfl(v, src); }
DEV unsigned long long ballot_(bool p) { return emu_ballot(p ? 1 : 0); }
DEV void bsync() { emu::block_barrier(); }
DEV void wsync() { int d = 0, all[64]; emu::wave_all(d, all); }
DEV void rawbar() { emu::block_barrier(); }
DEV void glds16(const void* g, void* l) { memcpy((char*)l + (threadIdx.x & 63) * 16, g, 16); }
DEV float fexp(float x) { return expf(x); }
DEV float flog(float x) { return logf(x); }
DEV float frsqrt(float x) { return 1.0f / sqrtf(x); }
DEV float frcp(float x) { return 1.0f / x; }
DEV int rfl(int v) { return v; }
#define SETPRIO(n) do {} while (0)
#define SCHEDB() do {} while (0)
#endif
DEV float wave_sum(float v) {
#pragma unroll
    for (int o = 1; o < 64; o <<= 1) v += shx(v, o);
    return v;
}
DEV float wave_max(float v) {
#pragma unroll
    for (int o = 1; o < 64; o <<= 1) v = fmaxf(v, shx(v, o));
    return v;
}
DEV float gelu_tanh(float x) { const float y = 0.7978845608028654f * (x + 0.044715f * x * x * x); const float e = fexp(2.0f * y); return 0.5f * x * (2.0f - 2.0f * frcp(e + 1.0f)); }
DEV float sigmoidf_(float x) { return frcp(1.0f + fexp(-x)); }
DEV float siluf_(float x) { return x * sigmoidf_(x); }
DEV float softplusf_(float x) { return x > 20.f ? x : flog(1.0f + fexp(x)); }
DEV void unpack8(u32x4 r, float* v) { v[0] = lo16(r.x); v[1] = hi16(r.x); v[2] = lo16(r.y); v[3] = hi16(r.y); v[4] = lo16(r.z); v[5] = hi16(r.z); v[6] = lo16(r.w); v[7] = hi16(r.w); }
DEV u32x4 pack8(const float* v) { u32x4 r; r.x = pk2(v[0], v[1]); r.y = pk2(v[2], v[3]); r.z = pk2(v[4], v[5]); r.w = pk2(v[6], v[7]); return r; }

namespace pg8 {
constexpr int BM = 256, BK = 64, HALF = 128, HTB = HALF * BK * 2, STAGE_BYTES = 8 * HTB, NXCD = 8, WGM = 8;
DEV int lds_byte(int r, int c) { const int st = (r >> 4) * 2 + (c >> 5), rr = r & 15, cc = c & 31, ob = rr * 64 + cc * 2; return st * 1024 + (ob ^ (((ob >> 9) & 1) << 5)); }
DEV void stage_rc(int b, int& R, int& C) { const int st = b / 1024, sb = b % 1024, swz = sb ^ (((sb >> 9) & 1) << 5); R = (st >> 1) * 16 + swz / 64; C = (st & 1) * 32 + (swz % 64) / 2; }
DEV int perm32(int rho) { const int n = rho >> 4, i = rho & 15; return 8 * (i >> 2) + 4 * n + (i & 3); }
struct Unit { int pm, pn; };
struct Gemm { const bf16_t* A; const bf16_t* Bt; int M, N, K; int grp_tiles; size_t grp_stride; const int* gidx; };
struct StaticOrder {
    int nM, nN, nwg, G, c;
    DEVM void init(int M_, int N_, int G_, int c_) { nM = M_ / BM; nN = N_ / BM; nwg = nM * nN; G = G_; c = c_; }
    DEVM bool next(int i, Unit& u) const {
        const long L = (long)i * G + c; if (L >= nwg) return false;
        int wgid = (int)L; { const int q = nwg / NXCD, r = nwg % NXCD, xcd = wgid % NXCD, off = wgid / NXCD; wgid = (xcd < r ? xcd * (q + 1) : r * (q + 1) + (xcd - r) * q) + off; }
        const int nig = WGM * nN, gid = wgid / nig, fm = gid * WGM, gsz = (nM - fm) < WGM ? (nM - fm) : WGM;
        u.pm = fm + ((wgid % nig) % gsz); u.pn = (wgid % nig) / gsz; return true;
    }
};
template <class Epi, bool GATHER = false>
DEV void gemm_phase(LAS unsigned char* lds, const Gemm g, const StaticOrder& S, const Epi& E, const int tid) {
    const int wid = rfl(tid >> 6), lane = tid & 63, wr = wid >> 2, wc = wid & 3, fr = lane & 15, fq = lane >> 4;
    const int K = g.K, nt = K / BK;
    unsigned voffA[2], voffB[2]; int rowA[2], colA2[2];
#pragma unroll
    for (int i = 0; i < 2; ++i) { int R, C; stage_rc(tid * 16 + i * 8192, R, C); const int Rb = Epi::PERM ? ((R & ~31) + perm32(R & 31)) : R;
        voffA[i] = (unsigned)(R * K + C) * 2u; voffB[i] = (unsigned)(Rb * K + C) * 2u; rowA[i] = R; colA2[i] = C * 2; }
    unsigned cro[2][2], nro[2][2];
#define PG8_ROFF(dst, u) do { _Pragma("unroll") for (int _h = 0; _h < 2; ++_h) _Pragma("unroll") for (int _i = 0; _i < 2; ++_i) { const int _r = (u).pm * BM + _h * HALF + rowA[_i]; \
        dst[_h][_i] = (unsigned)(((_r / CAP) % BATCH) * SEQ + g.gidx[_r]) * (unsigned)(K * 2) + (unsigned)colA2[_i]; } } while (0)
    const size_t kstep = (size_t)(BK * 2);
    const size_t hstep = (size_t)HALF * K * 2;
    const size_t tstep = 2 * hstep;
    const unsigned ldsw = (unsigned)wid * 1024u;
    const int aoff = lds_byte(wr * 64 + fr, fq * 8), boff = lds_byte(wc * 32 + fr, fq * 8);
#define PG8_SA(b, h) (((b) * 2 + (h)) * HTB)
#define PG8_SB(b, h) ((4 + (b) * 2 + (h)) * HTB)
#define PG8_STAGE(bufoff, gbase, voff) do { _Pragma("unroll") for (int _i = 0; _i < 2; ++_i) \
        glds16((const char*)(gbase) + (voff)[_i], lds + (bufoff) + ldsw + _i * 8192); } while (0)
#define PG8_STAGE_A(bufoff, ubase, kofs, h, ro) do { if (GATHER) { PG8_STAGE(bufoff, (const char*)g.A + (kofs), (ro)[h]); } else { PG8_STAGE(bufoff, (ubase) + (h) * hstep + (kofs), voffA); } } while (0)
#define PG8_LDA(dst, b, h) do { _Pragma("unroll") for (int m = 0; m < 4; ++m) _Pragma("unroll") for (int k = 0; k < 2; ++k) dst[m][k] = *(const LAS bf16x8*)(lds + PG8_SA(b, h) + aoff + m * 2048 + k * 1024); } while (0)
#define PG8_LDB(dst, b, h) do { _Pragma("unroll") for (int n = 0; n < 2; ++n) _Pragma("unroll") for (int k = 0; k < 2; ++k) dst[n][k] = *(const LAS bf16x8*)(lds + PG8_SB(b, h) + boff + n * 2048 + k * 1024); } while (0)
#define PG8_MMA(ai, bj, At, Bt) do { SETPRIO(1); _Pragma("unroll") for (int m = 0; m < 4; ++m) _Pragma("unroll") for (int n = 0; n < 2; ++n) _Pragma("unroll") for (int k = 0; k < 2; ++k) \
        acc[ai][bj][m][n] = mfma16(Bt[n][k], At[m][k], acc[ai][bj][m][n]); SETPRIO(0); } while (0)
#define PG8_WAIT_V(n) ASMV("s_waitcnt vmcnt(" #n ")" ::: "memory")
#define PG8_WAIT_L(n) ASMV("s_waitcnt lgkmcnt(" #n ")" ::: "memory")
#define PG8_BAR rawbar()
#define PG8_SCHED SCHEDB()
#define PG8_BBASE(u) ((const char*)g.Bt + (g.grp_tiles ? (size_t)((u).pm / g.grp_tiles) * g.grp_stride : (size_t)0) + (size_t)(u).pn * tstep)
    Unit cur, nxt; int ui = 0;
    if (!S.next(0, cur)) return;
    f32x4 acc[2][2][4][2];
#pragma unroll
    for (int a = 0; a < 2; ++a)
#pragma unroll
        for (int b = 0; b < 2; ++b)
#pragma unroll
            for (int m = 0; m < 4; ++m)
#pragma unroll
                for (int n = 0; n < 2; ++n) acc[a][b][m][n] = (f32x4){0.f, 0.f, 0.f, 0.f};
    bf16x8 At[4][2], B0[2][2], B1[2][2];
    const char* cA = (const char*)g.A + (size_t)cur.pm * tstep; const char* cB = PG8_BBASE(cur);
    if (GATHER) { PG8_ROFF(cro, cur); PG8_ROFF(nro, cur); }
    const int krot = (2 * (S.c & 7)) & (nt - 1);
#define PG8_KO(kt) ((size_t)(((kt) + krot) & (nt - 1)) * kstep)
    const size_t kb0 = PG8_KO(0);
    PG8_STAGE(PG8_SB(0, 0), cB + kb0, voffB); PG8_STAGE(PG8_SB(0, 1), cB + hstep + kb0, voffB); PG8_STAGE_A(PG8_SA(0, 0), cA, kb0, 0, cro); PG8_STAGE_A(PG8_SA(0, 1), cA, kb0, 1, cro);
    if (wr == 1) PG8_BAR;
    PG8_WAIT_V(2); PG8_BAR;
    PG8_STAGE(PG8_SB(1, 0), cB + kb0 + kstep, voffB); PG8_STAGE_A(PG8_SA(1, 0), cA, kb0 + kstep, 0, cro); PG8_STAGE(PG8_SB(1, 1), cB + hstep + kb0 + kstep, voffB);
    PG8_WAIT_V(6); PG8_BAR;
    for (;;) {
        const bool has_next = S.next(ui + 1, nxt);
        const char* nA = has_next ? (const char*)g.A + (size_t)nxt.pm * tstep : cA; const char* nB = has_next ? PG8_BBASE(nxt) : cB;
        if (GATHER && has_next) PG8_ROFF(nro, nxt);
        for (int t = 0; t < nt; t += 2) {
            const bool last = (t == nt - 2);
            const size_t k1 = PG8_KO(t) + kstep, k2 = PG8_KO(last ? 0 : t + 2), k3 = k2 + kstep;
            const char* a2u = last ? nA : cA; const char* b2 = (last ? nB : cB) + k2;
            const char* b3 = b2 + kstep;
            unsigned ro2[2][2];
#pragma unroll
            for (int _h = 0; _h < 2; ++_h)
#pragma unroll
                for (int _i = 0; _i < 2; ++_i) ro2[_h][_i] = last ? nro[_h][_i] : cro[_h][_i];
            PG8_LDB(B0, 0, 0); PG8_LDB(B1, 0, 1); PG8_SCHED; PG8_LDA(At, 0, 0); PG8_STAGE_A(PG8_SA(1, 1), cA, k1, 1, cro);
            PG8_WAIT_V(8); PG8_WAIT_L(0); PG8_BAR; PG8_MMA(0, 0, At, B0); PG8_MMA(0, 1, At, B1); PG8_BAR; PG8_SCHED;
            PG8_LDA(At, 0, 1); PG8_STAGE(PG8_SB(0, 0), b2, voffB); PG8_STAGE(PG8_SB(0, 1), b2 + hstep, voffB); PG8_STAGE_A(PG8_SA(0, 0), a2u, k2, 0, ro2);
            PG8_WAIT_V(8); PG8_WAIT_L(0); PG8_BAR; PG8_MMA(1, 0, At, B0); PG8_MMA(1, 1, At, B1); PG8_BAR; PG8_SCHED;
            PG8_LDB(B0, 1, 0); PG8_LDB(B1, 1, 1); PG8_SCHED; PG8_LDA(At, 1, 0); PG8_STAGE_A(PG8_SA(0, 1), a2u, k2, 1, ro2);
            PG8_WAIT_V(8); PG8_WAIT_L(0); PG8_BAR; PG8_MMA(0, 0, At, B0); PG8_MMA(0, 1, At, B1); PG8_BAR; PG8_SCHED;
            PG8_LDA(At, 1, 1); PG8_STAGE(PG8_SB(1, 0), b3, voffB); PG8_STAGE(PG8_SB(1, 1), b3 + hstep, voffB); PG8_STAGE_A(PG8_SA(1, 0), a2u, k3, 0, ro2);
            PG8_WAIT_V(8); PG8_WAIT_L(0); PG8_BAR; PG8_MMA(1, 0, At, B0); PG8_MMA(1, 1, At, B1); PG8_BAR; PG8_SCHED;
        }
        if (wr == 0) PG8_BAR;
        E(acc, cur, wr, wc, fr, fq);
        if (!has_next) break;
#pragma unroll
        for (int a = 0; a < 2; ++a)
#pragma unroll
            for (int b = 0; b < 2; ++b)
#pragma unroll
                for (int m = 0; m < 4; ++m)
#pragma unroll
                    for (int n = 0; n < 2; ++n) acc[a][b][m][n] = (f32x4){0.f, 0.f, 0.f, 0.f};
        cur = nxt; cA = nA; cB = nB; ++ui;
        if (wr == 1) PG8_BAR;
        if (GATHER) {
#pragma unroll
            for (int _h = 0; _h < 2; ++_h)
#pragma unroll
                for (int _i = 0; _i < 2; ++_i) cro[_h][_i] = nro[_h][_i]; }
    }
    PG8_WAIT_V(0);
    PG8_BAR;
#undef PG8_SA
#undef PG8_SB
#undef PG8_STAGE
#undef PG8_STAGE_A
#undef PG8_ROFF
#undef PG8_LDA
#undef PG8_LDB
#undef PG8_MMA
#undef PG8_WAIT_V
#undef PG8_WAIT_L
#undef PG8_BAR
#undef PG8_SCHED
#undef PG8_BBASE
#undef PG8_KO
}
constexpr int NPART = 16;
DEV float part_rstd(const float* part, int row, float inv_n, int fq) {
    const f32x4 a = *((const f32x4*)(part + (size_t)row * NPART) + fq);
    float s = (a[0] + a[1]) + (a[2] + a[3]);
    s += shx(s, 16); s += shx(s, 32);
    return frsqrt(s * inv_n + NORM_EPS);
}
struct EpiBf16 {
    static constexpr bool PERM = true;
    bf16_t* O; int ldc; const float* rs_part; float rs_inv_n; float* out_part;
    DEVM void operator()(const f32x4 (&acc)[2][2][4][2], const Unit& u, int wr, int wc, int fr, int fq) const {
        const int row0 = u.pm * BM + wr * 64 + fr, col0 = u.pn * BM + wc * 32 + 8 * fq;
#pragma unroll
        for (int ai = 0; ai < 2; ++ai)
#pragma unroll
            for (int m = 0; m < 4; ++m) { const int row = row0 + ai * HALF + m * 16; bf16_t* rowp = O + (size_t)row * ldc + col0;
                const float rs = rs_part ? part_rstd(rs_part, row, rs_inv_n, fq) : 1.0f; float ss = 0.f;
#pragma unroll
                for (int bj = 0; bj < 2; ++bj) { const f32x4 v0 = acc[ai][bj][m][0] * rs, v1 = acc[ai][bj][m][1] * rs;
                    ss += ((v0[0] * v0[0] + v0[1] * v0[1]) + (v0[2] * v0[2] + v0[3] * v0[3])) + ((v1[0] * v1[0] + v1[1] * v1[1]) + (v1[2] * v1[2] + v1[3] * v1[3]));
                    u32x4 w; w.x = pk2(v0[0], v0[1]); w.y = pk2(v0[2], v0[3]); w.z = pk2(v1[0], v1[1]); w.w = pk2(v1[2], v1[3]);
                    *(u32x4*)(rowp + bj * HALF) = w; }
                if (out_part) { ss += shx(ss, 16); ss += shx(ss, 32); if (fq == 0) out_part[(size_t)row * NPART + u.pn * 4 + wc] = ss; } }
    }
};
struct EpiResB {
    static constexpr bool PERM = false;
    const bf16_t* res; bf16_t* out; int ldc;
    DEVM void operator()(const f32x4 (&acc)[2][2][4][2], const Unit& u, int wr, int wc, int fr, int fq) const {
        const int row0 = u.pm * BM + wr * 64 + fr, col0 = u.pn * BM + wc * 32 + 4 * fq;
#pragma unroll
        for (int ai = 0; ai < 2; ++ai) {
            u32x2 r[4][2][2];
#pragma unroll
            for (int m = 0; m < 4; ++m) { const size_t off = (size_t)(row0 + ai * HALF + m * 16) * ldc + col0;
#pragma unroll
                for (int bj = 0; bj < 2; ++bj)
#pragma unroll
                    for (int n = 0; n < 2; ++n) r[m][bj][n] = *(const u32x2*)(res + off + bj * HALF + n * 16); }
#pragma unroll
            for (int m = 0; m < 4; ++m) { const size_t off = (size_t)(row0 + ai * HALF + m * 16) * ldc + col0;
#pragma unroll
                for (int bj = 0; bj < 2; ++bj)
#pragma unroll
                    for (int n = 0; n < 2; ++n) { const f32x4 a = acc[ai][bj][m][n]; const u32x2 y = r[m][bj][n];
                        u32x2 o; o.x = pk2(lo16(y.x) + a[0], hi16(y.x) + a[1]); o.y = pk2(lo16(y.y) + a[2], hi16(y.y) + a[3]); *(u32x2*)(out + off + bj * HALF + n * 16) = o; } }
        }
    }
};
struct EpiSwiGLU {
    static constexpr bool PERM = true;
    bf16_t* O; int ldc; const float* rstd;
    DEVM void operator()(const f32x4 (&acc)[2][2][4][2], const Unit& u, int wr, int wc, int fr, int fq) const {
        const int row0 = u.pm * BM + wr * 64 + fr, col0 = u.pn * HALF + wc * 32 + 8 * fq;
        float rs[2][4];
#pragma unroll
        for (int ai = 0; ai < 2; ++ai)
#pragma unroll
            for (int m = 0; m < 4; ++m) rs[ai][m] = 1.0f;
#pragma unroll
        for (int ai = 0; ai < 2; ++ai)
#pragma unroll
            for (int m = 0; m < 4; ++m) { bf16_t* rowp = O + (size_t)(row0 + ai * HALF + m * 16) * ldc + col0;
                float h[8];
#pragma unroll
                for (int n = 0; n < 2; ++n)
#pragma unroll
                    for (int i = 0; i < 4; ++i) { const float gt = acc[ai][0][m][n][i] * rs[ai][m], up = acc[ai][1][m][n][i] * rs[ai][m]; h[n * 4 + i] = siluf_(gt) * up; }
                *(u32x4*)rowp = pack8(h); }
    }
};
struct EpiScaleBf16 {
    static constexpr bool PERM = true;
    bf16_t* O; int ldc; const float* rowscale;
    DEVM void operator()(const f32x4 (&acc)[2][2][4][2], const Unit& u, int wr, int wc, int fr, int fq) const {
        const int row0 = u.pm * BM + wr * 64 + fr, col0 = u.pn * BM + wc * 32 + 8 * fq;
#pragma unroll
        for (int ai = 0; ai < 2; ++ai)
#pragma unroll
            for (int m = 0; m < 4; ++m) { const int row = row0 + ai * HALF + m * 16; const float sc = rowscale[row]; bf16_t* rowp = O + (size_t)row * ldc + col0;
#pragma unroll
                for (int bj = 0; bj < 2; ++bj) { const f32x4 v0 = acc[ai][bj][m][0] * sc, v1 = acc[ai][bj][m][1] * sc;
                    u32x4 w; w.x = pk2(v0[0], v0[1]); w.y = pk2(v0[2], v0[3]); w.z = pk2(v1[0], v1[1]); w.w = pk2(v1[2], v1[3]);
                    *(u32x4*)(rowp + bj * HALF) = w; } }
    }
};
struct EpiPleGate {
    static constexpr bool PERM = false;
    const bf16_t* x; bf16_t* xo; const bf16_t* eraw; const float* epart; const float* gple; float* xpart; float* outf; int ldc; const float* rstd;
    DEVM void operator()(const f32x4 (&acc)[2][2][4][2], const Unit& u, int wr, int wc, int fr, int fq) const {
        const int row0 = u.pm * BM + wr * 64 + fr, col0 = u.pn * BM + wc * 32 + 4 * fq;
        f32x4 gp[2][2];
#pragma unroll
        for (int bj = 0; bj < 2; ++bj)
#pragma unroll
            for (int n = 0; n < 2; ++n) gp[bj][n] = *(const f32x4*)(gple + col0 + bj * HALF + n * 16);
#pragma unroll
        for (int ai = 0; ai < 2; ++ai)
#pragma unroll
            for (int mp = 0; mp < 2; ++mp) {
                u32x2 r[2][2][2], e2[2][2][2]; float ers[2], xrs[2];
#pragma unroll
                for (int mm = 0; mm < 2; ++mm) { const int row = row0 + ai * HALF + (2 * mp + mm) * 16; const size_t off = (size_t)row * ldc + col0;
                    ers[mm] = part_rstd(epart, row, 1.0f / DM, fq); xrs[mm] = rstd[row];
#pragma unroll
                    for (int bj = 0; bj < 2; ++bj)
#pragma unroll
                        for (int n = 0; n < 2; ++n) { r[mm][bj][n] = *(const u32x2*)(x + off + bj * HALF + n * 16); e2[mm][bj][n] = *(const u32x2*)(eraw + off + bj * HALF + n * 16); } }
                f32x4 wv[2][2][2];
#pragma unroll
                for (int mm = 0; mm < 2; ++mm) { float ss = 0.f; const int row = row0 + ai * HALF + (2 * mp + mm) * 16;
#pragma unroll
                    for (int bj = 0; bj < 2; ++bj)
#pragma unroll
                        for (int n = 0; n < 2; ++n) { const f32x4 a = acc[ai][bj][2 * mp + mm][n] * xrs[mm]; const u32x2 rr = r[mm][bj][n], ee = e2[mm][bj][n]; const f32x4 g = gp[bj][n] * ers[mm];
                            f32x4 w; w[0] = lo16(rr.x) + lo16(ee.x) * g[0] * sigmoidf_(a[0]); w[1] = hi16(rr.x) + hi16(ee.x) * g[1] * sigmoidf_(a[1]); w[2] = lo16(rr.y) + lo16(ee.y) * g[2] * sigmoidf_(a[2]); w[3] = hi16(rr.y) + hi16(ee.y) * g[3] * sigmoidf_(a[3]);
                            ss += (w[0] * w[0] + w[1] * w[1]) + (w[2] * w[2] + w[3] * w[3]); wv[mm][bj][n] = w; }
                    ss += shx(ss, 16); ss += shx(ss, 32); if (!outf && fq == 0) xpart[(size_t)row * NPART + u.pn * 4 + wc] = ss; }
                if (outf) {
#pragma unroll
                    for (int mm = 0; mm < 2; ++mm) { const size_t off = (size_t)(row0 + ai * HALF + (2 * mp + mm) * 16) * ldc + col0;
#pragma unroll
                        for (int bj = 0; bj < 2; ++bj)
#pragma unroll
                            for (int n = 0; n < 2; ++n) *(f32x4*)(outf + off + bj * HALF + n * 16) = wv[mm][bj][n]; }
                } else {
#pragma unroll
                    for (int mm = 0; mm < 2; ++mm) { const size_t off = (size_t)(row0 + ai * HALF + (2 * mp + mm) * 16) * ldc + col0;
#pragma unroll
                        for (int bj = 0; bj < 2; ++bj)
#pragma unroll
                            for (int n = 0; n < 2; ++n) { const f32x4 w = wv[mm][bj][n]; u32x2 o; o.x = pk2(w[0], w[1]); o.y = pk2(w[2], w[3]); *(u32x2*)(xo + off + bj * HALF + n * 16) = o; } }
                }
            }
    }
};
}

#ifndef HOST_EMU
#define XB_TMO      128
#define XB_XCNT(j)  (256  + 64 * (j))
#define XB_XSUB(j)  (1280 + 64 * (j))
#define XB_XGEN(j)  (2304 + 64 * (j))
#define XB_TOP      3328
#define XB_TOPGEN   3392
#define XCD_BAR_WORDS 3456
#define XB_SPIN_CAP (1u << 22)
__device__ __forceinline__ unsigned xb_ld(unsigned* p)              { return __hip_atomic_load(p, __ATOMIC_RELAXED, __HIP_MEMORY_SCOPE_AGENT); }
__device__ __forceinline__ unsigned xb_add(unsigned* p, unsigned v) { return __hip_atomic_fetch_add(p, v, __ATOMIC_RELAXED, __HIP_MEMORY_SCOPE_AGENT); }
__device__ __forceinline__ unsigned xb_xcc_id() { return (unsigned)__builtin_amdgcn_s_getreg((3 << 11) | 20) & 0xFu; }
#define XB_SPIN(cond, bar) do { unsigned _sp = 0; while (cond) { __builtin_amdgcn_s_sleep(1); \
    if ((++_sp & 255u) == 0u) { if (xb_ld(&(bar)[XB_TMO])) break; if (_sp > XB_SPIN_CAP) { atomicAdd(&(bar)[XB_TMO], 1u); break; } } } } while (0)
struct XcdBarrier { unsigned* bar; unsigned x; volatile LAS unsigned* st; };
__device__ __forceinline__ XcdBarrier xcd_barrier_post(unsigned* bar, volatile LAS unsigned* st) {
    XcdBarrier b; b.bar = bar; b.x = xb_xcc_id(); b.st = st;
    if (threadIdx.x == 0) (void)xb_add(&bar[XB_XCNT(b.x)], 1u);
    return b;
}
__device__ __forceinline__ void xcd_barrier_complete(unsigned* bar, unsigned x, unsigned& nloc, unsigned& nx) {
    const unsigned G = gridDim.x * gridDim.y * gridDim.z;
    unsigned sum, cnt, mine, sp = 0u;
    for (;;) {
        sum = 0u; cnt = 0u; mine = 0u;
#pragma unroll
        for (unsigned j = 0; j < 16; ++j) { const unsigned c = xb_ld(&bar[XB_XCNT(j)]); sum += c; cnt += (c > 0u) ? 1u : 0u; mine = (j == x) ? c : mine; }
        if (sum == G) break;
        __builtin_amdgcn_s_sleep(1);
        if ((++sp & 255u) == 0u) { if (xb_ld(&bar[XB_TMO])) break; if (sp > XB_SPIN_CAP) { atomicAdd(&bar[XB_TMO], 1u); break; } }
    }
    nloc = mine > 0u ? mine : 1u; nx = cnt > 0u ? cnt : 1u;
}
__device__ __forceinline__ void xcd_barrier(const XcdBarrier& b) {
    asm volatile("s_waitcnt vmcnt(0)" ::: "memory");
    __syncthreads();
    if (threadIdx.x == 0) {
        unsigned* bar = b.bar;
        __builtin_amdgcn_s_waitcnt(0);
        unsigned nloc = b.st[0], nx = b.st[1];
        if (nloc == 0u) { xcd_barrier_complete(bar, b.x, nloc, nx); b.st[0] = nloc; b.st[1] = nx; }
        const unsigned old = xb_add(&bar[XB_XSUB(b.x)], 1u);
        const unsigned gen = old / nloc;
        if (old + 1u == (gen + 1u) * nloc) {
            __builtin_amdgcn_fence(__ATOMIC_RELEASE, "agent");
            asm volatile("s_waitcnt vmcnt(0)" ::: "memory");
            const unsigned og = xb_add(&bar[XB_TOP], 1u);
            const unsigned tg = og / nx;
            if (og + 1u == (tg + 1u) * nx) xb_add(&bar[XB_TOPGEN], 1u);
            else XB_SPIN(xb_ld(&bar[XB_TOPGEN]) == tg, bar);
            __builtin_amdgcn_fence(__ATOMIC_ACQUIRE, "agent");
            xb_add(&bar[XB_XGEN(b.x)], 1u);
            asm volatile("s_waitcnt vmcnt(0)" ::: "memory");
        } else {
            XB_SPIN(xb_ld(&bar[XB_XGEN(b.x)]) == gen, bar);
            __builtin_amdgcn_fence(__ATOMIC_ACQUIRE, "agent");
            asm volatile("s_waitcnt vmcnt(0)" ::: "memory");
        }
    }
    __syncthreads();
}
#endif

constexpr int LDS_STAGE = 131072;
constexpr int LDS_MISC = 144384;
constexpr int LDS_BYTES = 147456;
struct Args { const void* in[25]; float* out; unsigned char* ws; int ph_lo, ph_hi; };
struct Frame {
    LAS unsigned char* lds;
    int tid, lane, wave, G, wg;
    const Args* a;
    DEVM const float* x() const { return (const float*)a->in[0]; }
    DEVM const float* p() const { return (const float*)a->in[1]; }
    DEVM const int* pos() const { return (const int*)a->in[2]; }
    DEVM const float* g_mix() const { return (const float*)a->in[3]; }
    DEVM const float* w_in() const { return (const float*)a->in[4]; }
    DEVM const float* ln_v_g() const { return (const float*)a->in[5]; }
    DEVM const float* ln_v_b() const { return (const float*)a->in[6]; }
    DEVM const float* w_s() const { return (const float*)a->in[7]; }
    DEVM const float* b_s() const { return (const float*)a->in[8]; }
    DEVM const float* q_norm_g() const { return (const float*)a->in[9]; }
    DEVM const float* k_norm_g() const { return (const float*)a->in[10]; }
    DEVM const float* conv_w() const { return (const float*)a->in[11]; }
    DEVM const float* a_log() const { return (const float*)a->in[12]; }
    DEVM const float* dt_bias() const { return (const float*)a->in[13]; }
    DEVM const float* o_norm_g() const { return (const float*)a->in[14]; }
    DEVM const float* w_out() const { return (const float*)a->in[15]; }
    DEVM const float* g_ffn() const { return (const float*)a->in[16]; }
    DEVM const float* w_router() const { return (const float*)a->in[17]; }
    DEVM const float* w_e_gate() const { return (const float*)a->in[18]; }
    DEVM const float* w_e_up() const { return (const float*)a->in[19]; }
    DEVM const float* w_e_down() const { return (const float*)a->in[20]; }
    DEVM const float* w_ple() const { return (const float*)a->in[21]; }
    DEVM const float* g_ple() const { return (const float*)a->in[22]; }
    DEVM const float* g_ple_gate() const { return (const float*)a->in[23]; }
    DEVM const float* w_ple_gate() const { return (const float*)a->in[24]; }
    DEVM float* out() const { return a->out; }
    DEVM unsigned char* ws() const { return a->ws; }
    DEVM float* ROPE() const { return (float*)(a->ws + WS_ROPE); }
    DEVM float* AFF() const { return (float*)(a->ws + WS_AFF); }
    DEVM float* GATEV() const { return (float*)(a->ws + WS_GATEV); }
    DEVM float* DEN() const { return (float*)(a->ws + WS_DEN); }
    DEVM float* GAM() const { return (float*)(a->ws + WS_GAM); }
    DEVM float* XPART() const { return (float*)(a->ws + WS_XPART); }
    DEVM float* EPART() const { return (float*)(a->ws + WS_EPART); }
    DEVM float* RSTD() const { return (float*)(a->ws + WS_RSTD); }
    DEVM float* RSROW() const { return (float*)(a->ws + WS_RSROW); }
    DEVM int* IDX() const { return (int*)(a->ws + WS_IDX); }
    DEVM int* INV() const { return (int*)(a->ws + WS_INV); }
    DEVM bf16_t* PB() const { return (bf16_t*)(a->ws + WS_PB); }
    DEVM bf16_t* WS16() const { return (bf16_t*)(a->ws + WS_WS16); }
    DEVM bf16_t* WIN() const { return (bf16_t*)(a->ws + WS_WIN); }
    DEVM bf16_t* WOUT() const { return (bf16_t*)(a->ws + WS_WOUT); }
    DEVM bf16_t* WGU() const { return (bf16_t*)(a->ws + WS_WGU); }
    DEVM bf16_t* WD() const { return (bf16_t*)(a->ws + WS_WD); }
    DEVM bf16_t* WPLE() const { return (bf16_t*)(a->ws + WS_WPLE); }
    DEVM bf16_t* WPG(int L) const { return (bf16_t*)(a->ws + WS_WPG + (size_t)(L & 1) * al4k((size_t)DM * DM * 2)); }
    DEVM bf16_t* ACT() const { return (bf16_t*)(a->ws + WS_ACT); }
    DEVM bf16_t* XB(int L) const { return (bf16_t*)(a->ws + WS_XB + (size_t)(L & 1) * al4k((size_t)M * DM * 2)); }
    DEVM bf16_t* PROJ() const { return (bf16_t*)(a->ws + WS_PROJ); }
    DEVM bf16_t* QN() const { return (bf16_t*)(a->ws + WS_QN); }
    DEVM bf16_t* KN() const { return (bf16_t*)(a->ws + WS_KN); }
    DEVM bf16_t* NUM() const { return (bf16_t*)(a->ws + WS_NUM); }
    DEVM bf16_t* OFB() const { return (bf16_t*)(a->ws + WS_OF); }
    DEVM bf16_t* XE() const { return (bf16_t*)(a->ws + WS_XE); }
    DEVM bf16_t* HID() const { return (bf16_t*)(a->ws + WS_HID); }
    DEVM bf16_t* YE() const { return (bf16_t*)(a->ws + WS_YE); }
    DEVM bf16_t* ERAW() const { return (bf16_t*)(a->ws + WS_ERAW); }
    DEVM unsigned char* VT() const { return (unsigned char*)(a->ws + WS_VT); }
    DEVM unsigned char* REC() const { return (unsigned char*)(a->ws + WS_REC); }
};

constexpr int NJ = DM / 256;
DEV void phase_prologue(Frame& F) {
    { const int gw = F.wg * NWAVES + F.wave, NGW = F.G * NWAVES;
      for (int m0 = gw * 4; m0 < M; m0 += NGW * 4) {
        f32x4 v[4][NJ];
#pragma unroll
        for (int r = 0; r < 4; ++r)
#pragma unroll
            for (int j = 0; j < NJ; ++j) v[r][j] = *((const f32x4*)(F.x() + (size_t)(m0 + r) * DM) + F.lane + 64 * j);
#pragma unroll
        for (int r = 0; r < 4; ++r)
#pragma unroll
            for (int j = 0; j < NJ; ++j) { u32x2 o; o.x = pk2(v[r][j][0], v[r][j][1]); o.y = pk2(v[r][j][2], v[r][j][3]); *((u32x2*)(F.XB(0) + (size_t)(m0 + r) * DM) + F.lane + 64 * j) = o; }
#pragma unroll
        for (int r = 0; r < 4; ++r) { float ss = 0.f;
#pragma unroll
            for (int j = 0; j < NJ; ++j) ss += (v[r][j][0] * v[r][j][0] + v[r][j][1] * v[r][j][1]) + (v[r][j][2] * v[r][j][2] + v[r][j][3] * v[r][j][3]);
            ss = wave_sum(ss); if (F.lane < pg8::NPART) F.XPART()[(size_t)(m0 + r) * pg8::NPART + F.lane] = (F.lane == 0) ? ss : 0.f; }
      } }
    for (int i = F.wg * NTHREADS + F.tid; i < M * pg8::NPART; i += F.G * NTHREADS) F.EPART()[i] = 0.f;
    for (int i = F.wg * NTHREADS + F.tid; i < M * 8; i += F.G * NTHREADS) {
        const int tok = i >> 3, k = i & 7;
        const float inv_freq = powf(500000.0f, -(float)k * 0.125f);
        const float ang = (float)F.pos()[tok] * inv_freq;
        F.ROPE()[tok * 16 + k] = cosf(ang); F.ROPE()[tok * 16 + 8 + k] = sinf(ang);
    }
}

DEV void tr_item(const float* W, int K, int N, bf16_t* WT, int ldk, int k0, int n0, int drow0, LAS float* scr, int lane, const float* rowgain = nullptr) {
#pragma unroll 8
    for (int i = 0; i < 32; ++i) { const int kk = 2 * i + (lane >> 5); const int n = n0 + (lane & 31); const float gk = rowgain ? rowgain[k0 + kk] : 1.0f; scr[kk * 33 + (lane & 31)] = (n < N) ? W[(size_t)(k0 + kk) * N + n] * gk : 0.f; }
    ASMV("s_waitcnt lgkmcnt(0)" ::: "memory"); wsync();
    const int c = lane & 7;
#pragma unroll
    for (int j = 0; j < 4; ++j) { const int n = (lane >> 3) + 8 * j; const LAS float* s = scr + (8 * c) * 33 + n;
        u32x4 o; o.x = pk2(s[0 * 33], s[1 * 33]); o.y = pk2(s[2 * 33], s[3 * 33]); o.z = pk2(s[4 * 33], s[5 * 33]); o.w = pk2(s[6 * 33], s[7 * 33]);
        *(u32x4*)(WT + (size_t)(drow0 + n) * ldk + k0 + 8 * c) = o; }
    ASMV("s_waitcnt lgkmcnt(0)" ::: "memory"); wsync();
}
constexpr int PW_I_IN = (DM / 64) * (INWP / 32), PW_I_OUT = (DM / 64) * (DM / 32), PW_I_G = (DM / 64) * (DE / 32), PW_I_D = (DE / 64) * (DM / 32), PW_I_PLE = (PLE / 64) * (DM / 32), PW_I_PG = (DM / 64) * (DM / 32);
DEV void phase_pw(Frame& F, int L, int slot, int nslots) {
    LAS float* scr = (LAS float*)(F.lds + F.wave * 16384);
    const int gw = slot * NWAVES + F.wave, NGW = nslots * NWAVES;
    constexpr int NIT = PW_I_IN + PW_I_OUT + PW_I_PLE + PW_I_PG;
    for (int it = gw; it < NIT; it += NGW) {
        int r = it;
        if (r < PW_I_IN) { const int nb = INWP / 32, kb = r / nb, n0 = (r % nb) * 32; tr_item(F.w_in() + (size_t)L * DM * INW, DM, INW, F.WIN(), DM, kb * 64, n0, n0, scr, F.lane, F.g_mix() + (size_t)L * DM); continue; } r -= PW_I_IN;
        if (r < PW_I_OUT) { const int nb = DM / 32, kb = r / nb, n0 = (r % nb) * 32; tr_item(F.w_out() + (size_t)L * DM * DM, DM, DM, F.WOUT(), DM, kb * 64, n0, n0, scr, F.lane); continue; } r -= PW_I_OUT;
        if (r < PW_I_PLE) { const int nb = DM / 32, kb = r / nb, n0 = (r % nb) * 32; tr_item(F.w_ple() + (size_t)L * PLE * DM, PLE, DM, F.WPLE(), PLE, kb * 64, n0, n0, scr, F.lane); continue; } r -= PW_I_PLE;
        { const int nb = DM / 32, kb = r / nb, n0 = (r % nb) * 32; tr_item(F.w_ple_gate() + (size_t)L * DM * DM, DM, DM, F.WPG(L), DM, kb * 64, n0, n0, scr, F.lane, F.g_ple_gate() + (size_t)L * DM); }
    }
    for (int i = slot * NTHREADS + F.tid; i < GG * 128 * 128 / 4; i += nslots * NTHREADS) {
        const f32x4 v = *(const f32x4*)(F.w_s() + (size_t)L * GG * 128 * 128 + (size_t)i * 4);
        u32x2 o; o.x = pk2(v[0], v[1]); o.y = pk2(v[2], v[3]); *(u32x2*)(F.WS16() + (size_t)i * 4) = o;
    }
}
DEV void pw_experts(Frame& F, int L, int slot_wave, int n_waves) {
    LAS float* scr = (LAS float*)(F.lds + F.wave * 16384);
    constexpr int PER_E = 2 * PW_I_G + PW_I_D;
    for (int it = slot_wave; it < NEXP * PER_E; it += n_waves) {
        const int e = it / PER_E; int q = it % PER_E;
        if (q < 2 * PW_I_G) { const int which = q / PW_I_G; q %= PW_I_G; const int nb = DE / 32, kb = q / nb, n0 = (q % nb) * 32;
            const float* W = (which ? F.w_e_up() : F.w_e_gate()) + ((size_t)L * NEXP + e) * DM * DE;
            tr_item(W, DM, DE, F.WGU() + (size_t)e * 2 * DE * DM, DM, kb * 64, n0, 256 * (n0 / 128) + 128 * which + (n0 % 128), scr, F.lane); }
        else { q -= 2 * PW_I_G; const int nb = DM / 32, kb = q / nb, n0 = (q % nb) * 32;
            tr_item(F.w_e_down() + ((size_t)L * NEXP + e) * DE * DM, DE, DM, F.WD() + (size_t)e * DM * DE, DE, kb * 64, n0, n0, scr, F.lane); }
    }
}

DEV void phase_norm1(Frame& F, int L) {
    const int gw = F.wg * NWAVES + F.wave, NGW = F.G * NWAVES;
    constexpr int R = 4;
    for (int m0 = gw * R; m0 < M; m0 += NGW * R) {
        f32x4 v[R][NJ];
#pragma unroll
        for (int r = 0; r < R; ++r)
#pragma unroll
            for (int j = 0; j < NJ; ++j) { const u32x2 y = *((const u32x2*)(F.XB(L) + (size_t)(m0 + r) * DM) + F.lane + 64 * j); v[r][j] = (f32x4){lo16(y.x), hi16(y.x), lo16(y.y), hi16(y.y)}; }
#pragma unroll
        for (int r = 0; r < R; ++r) {
            float s = 0.f;
#pragma unroll
            for (int j = 0; j < NJ; ++j) s += (v[r][j][0] * v[r][j][0] + v[r][j][1] * v[r][j][1]) + (v[r][j][2] * v[r][j][2] + v[r][j][3] * v[r][j][3]);
            const float rstd = frsqrt(wave_sum(s) * (1.f / DM) + NORM_EPS);
            u32x2* o8 = (u32x2*)(F.ACT() + (size_t)(m0 + r) * DM) + F.lane;
#pragma unroll
            for (int j = 0; j < NJ; ++j) { const f32x4 g = *((const f32x4*)(F.g_mix() + (size_t)L * DM) + F.lane + 64 * j); u32x2 o; o.x = pk2(v[r][j][0] * rstd * g[0], v[r][j][1] * rstd * g[1]); o.y = pk2(v[r][j][2] * rstd * g[2], v[r][j][3] * rstd * g[3]); o8[64 * j] = o; }
        }
    }
}

DEV void gmlp_units(Frame& F, int L) {
    LAS bf16_t* vnT = (LAS bf16_t*)F.lds;
    const int tid = F.tid, lane = F.lane, w = F.wave;
    for (int unit = F.wg; unit < (M / GCH) * GG; unit += F.G) {
        const int g = unit % GG, t0 = (unit / GG) * GCH;
        {
            const int j = tid >> 2, qd = tid & 3;
            const bf16_t* src = F.PROJ() + (size_t)(t0 + j) * INWP + O_AV + g * 64 + qd * 16;
            float v[16]; unpack8(*(const u32x4*)src, v); unpack8(*(const u32x4*)(src + 8), v + 8);
            float s = 0.f;
#pragma unroll
            for (int i = 0; i < 16; ++i) { v[i] = gelu_tanh(v[i]); s += v[i]; }
            s += shx(s, 1); s += shx(s, 2);
            const float mu = s * (1.f / 64.f); float q = 0.f;
#pragma unroll
            for (int i = 0; i < 16; ++i) { v[i] -= mu; q += v[i] * v[i]; }
            q += shx(q, 1); q += shx(q, 2);
            const float rstd = frsqrt(q * (1.f / 64.f) + NORM_EPS);
            const float* lg = F.ln_v_g() + ((size_t)L * GG + g) * 64 + qd * 16; const float* lb = F.ln_v_b() + ((size_t)L * GG + g) * 64 + qd * 16;
#pragma unroll
            for (int i = 0; i < 16; ++i) vnT[(qd * 16 + i) * 136 + j] = (bf16_t)f2bf(v[i] * rstd * lg[i] + lb[i]);
        }
        const int mt = w & 1, nt = w >> 1, r = lane & 31, h = lane >> 5, tok = t0 + nt * 32 + r;
        bf16x8 bw[8]; u32x2 uu[4];
        { const bf16_t* wrow = F.WS16() + ((size_t)g * 128 + nt * 32 + r) * 128;
#pragma unroll
          for (int s = 0; s < 8; ++s) bw[s] = *(const bf16x8*)(wrow + s * 16 + h * 8);
#pragma unroll
          for (int rr = 0; rr < 4; ++rr) uu[rr] = *(const u32x2*)(F.PROJ() + (size_t)tok * INWP + O_AU + g * 64 + mt * 32 + 8 * rr + 4 * h); }
        const float bias = F.b_s()[((size_t)L * GG + g) * 128 + nt * 32 + r];
        bsync();
        {
            f32x16 acc; for (int i = 0; i < 16; ++i) acc[i] = 0.f;
#pragma unroll
            for (int s = 0; s < 8; ++s) {
                const bf16x8 a = *(const LAS bf16x8*)(vnT + (mt * 32 + r) * 136 + s * 16 + h * 8);
                acc = mfma32(a, bw[s], acc);
            }
#pragma unroll
            for (int rr = 0; rr < 4; ++rr) {
                const int d0 = mt * 32 + 8 * rr + 4 * h;
                const u32x2 u2 = uu[rr];
                const float u0 = gelu_tanh(lo16(u2.x)), u1 = gelu_tanh(hi16(u2.x)), u2f = gelu_tanh(lo16(u2.y)), u3 = gelu_tanh(hi16(u2.y));
                u32x2 o; o.x = pk2(u0 * (acc[4 * rr + 0] + bias), u1 * (acc[4 * rr + 1] + bias)); o.y = pk2(u2f * (acc[4 * rr + 2] + bias), u3 * (acc[4 * rr + 3] + bias));
                *(u32x2*)(F.ACT() + (size_t)tok * DM + g * 64 + d0) = o;
            }
        }
        bsync();
    }
}

DEV void attnprep_units(Frame& F, int L) {
    LAS bf16_t* vt = (LAS bf16_t*)F.lds;
    const int tid = F.tid;
    for (int unit = F.wg; unit < BATCH * BH * (SEQ / 256); unit += F.G) {
        const int blk = unit % (SEQ / 256), bh = unit / (SEQ / 256), h = bh % BH, b = bh / BH, tb = blk * 256;
#pragma unroll
        for (int pass = 0; pass < 4; ++pass) {
            const int which = pass >> 1, tl = (pass & 1) * 128 + (tid >> 2), qd = tid & 3, s = tb + tl, tok = b * SEQ + s;
            const bf16_t* src = F.PROJ() + (size_t)tok * INWP + (which ? O_BK : O_BQ) + h * 64 + qd * 16;
            float v[16]; unpack8(*(const u32x4*)src, v); unpack8(*(const u32x4*)(src + 8), v + 8);
            float ss = 0.f;
#pragma unroll
            for (int i = 0; i < 16; ++i) ss += v[i] * v[i];
            ss += shx(ss, 1); ss += shx(ss, 2);
            const float rstd = frsqrt(ss * (1.f / 64.f) + NORM_EPS);
            const float* gn = (which ? F.k_norm_g() : F.q_norm_g()) + (size_t)L * 64 + qd * 16;
#pragma unroll
            for (int i = 0; i < 16; ++i) v[i] = v[i] * rstd * gn[i];
            if (qd == 0) {
                const float* rp = F.ROPE() + (size_t)tok * 16;
#pragma unroll
                for (int i = 0; i < 8; ++i) { const float c = rp[i], sn = rp[8 + i], x1 = v[i], x2 = v[8 + i]; v[i] = x1 * c - x2 * sn; v[8 + i] = x2 * c + x1 * sn; }
            }
            if (which == 0) {
#pragma unroll
                for (int i = 0; i < 16; ++i) v[i] *= 0.125f;
            }
            bf16_t* dst = (which ? F.KN() : F.QN()) + ((size_t)bh * SEQ + s) * 64 + qd * 16;
            *(u32x4*)dst = pack8(v); *(u32x4*)(dst + 8) = pack8(v + 8);
        }
#pragma unroll
        for (int i = 0; i < 4; ++i) { const int id = tid + 512 * i, tl = id >> 3, dc = id & 7;
            const u32x4 r = *(const u32x4*)(F.PROJ() + (size_t)(b * SEQ + tb + tl) * INWP + O_BV + h * 64 + dc * 8);
            const unsigned ww[4] = {r.x, r.y, r.z, r.w};
#pragma unroll
            for (int e = 0; e < 4; ++e) { vt[(dc * 8 + 2 * e) * 264 + tl] = (bf16_t)(ww[e] & 0xffffu); vt[(dc * 8 + 2 * e + 1) * 264 + tl] = (bf16_t)(ww[e] >> 16); } }
        bsync();
#pragma unroll
        for (int p = 0; p < 3; ++p) {
            const int dil = (p == 0) ? 1 : (p == 1 ? 4 : 16), Lp = SEQ / dil, cpr = 32 / dil;
            bf16_t* VTp = (bf16_t*)(F.VT() + (size_t)p * VT_STRIDE);
#pragma unroll
            for (int i = 0; i < 4; ++i) { const int item = tid + 512 * i, d = item >> 5, rc = item & 31, r = rc / cpr, c = rc % cpr;
                unsigned short e8[8];
#pragma unroll
                for (int e = 0; e < 8; ++e) e8[e] = vt[d * 264 + r + dil * (8 * c + e)];
                u32x4 o; o.x = e8[0] | ((unsigned)e8[1] << 16); o.y = e8[2] | ((unsigned)e8[3] << 16); o.z = e8[4] | ((unsigned)e8[5] << 16); o.w = e8[6] | ((unsigned)e8[7] << 16);
                *(u32x4*)(VTp + (((size_t)bh * dil + r) * 64 + d) * Lp + tb / dil + 8 * c) = o; }
        }
        bsync();
    }
}

DEV int perm_pi(int sg) { return 32 * (sg >> 5) + 16 * ((sg & 7) >> 2) + 4 * ((sg >> 3) & 3) + (sg & 3); }
DEV int perm_inv(int a) { return 32 * (a >> 5) + 8 * ((a >> 2) & 3) + 4 * ((a >> 4) & 1) + (a & 3); }
constexpr int G3_QB = 0, G3_KB = 9216, G3_VB = 18432, G3_LM = 27648, G3_TM = 62464, G3_XS = 72704, G3_VEC = 134144;
constexpr int LMP = 68, LMD = 64 * LMP, TMP = 20, TMB = 16 * TMP;
constexpr int G3_CW = 121856;
static_assert(G3_CW + 5 * 3 * CW * 2 <= G3_VEC, "LDS map");
DEV void gdnprep_units(Frame& F, int L) {
    LAS bf16_t* QB = (LAS bf16_t*)(F.lds + G3_QB); LAS bf16_t* KB = (LAS bf16_t*)(F.lds + G3_KB); LAS bf16_t* VB = (LAS bf16_t*)(F.lds + G3_VB);
    LAS float* LM = (LAS float*)(F.lds + G3_LM); LAS float* TMx = (LAS float*)(F.lds + G3_TM); LAS unsigned char* XS = F.lds + G3_XS;
    LAS float* BT = (LAS float*)(F.lds + G3_VEC); LAS float* GC = BT + 128; LAS float* EQ = BT + 256; LAS float* EK = BT + 384; LAS float* BEQ = BT + 512;
    const int tid = F.tid, lane = F.lane, w = F.wave;
    LAS bf16_t* CWL = (LAS bf16_t*)(F.lds + G3_CW);
    for (int i = tid; i < 5 * 3 * CW / 8; i += NTHREADS) { const float* wp = F.conv_w() + (size_t)L * 5 * 3 * CW + (size_t)i * 8; const f32x4 w0 = *(const f32x4*)wp, w1 = *(const f32x4*)(wp + 4);
        float t8[8] = {w0[0], w0[1], w0[2], w0[3], w1[0], w1[1], w1[2], w1[3]}; *(LAS u32x4*)(CWL + (size_t)i * 8) = pack8(t8); }
    bsync();
    for (int unit = F.wg; unit < BATCH * CHN * NCH; unit += F.G) {
        const int n = unit % NCH, bhh = unit / NCH, h = bhh % CHN, b = bhh / CHN;
        {
        float g_t = 0.f, b_t = 0.f;
        if (tid < 128) { const int dir = tid >> 6, tt = tid & 63; const size_t tok = (size_t)b * SEQ + n * 64 + tt;
            const float a = bf2f(F.PROJ()[tok * INWP + O_CA + dir * CHN + h]), bb = bf2f(F.PROJ()[tok * INWP + O_CB + dir * CHN + h]);
            g_t = -fexp(F.a_log()[((size_t)L * 2 + dir) * CHN + h]) * softplusf_(a + F.dt_bias()[((size_t)L * 2 + dir) * CHN + h]); b_t = sigmoidf_(bb); }
#pragma unroll
        for (int i = 0; i < 3; ++i) {
            const int item = tid + 512 * i, t = item / 24, cg = item % 24, which = cg >> 3, c8 = cg & 7, ch = which * CW + h * 64 + c8 * 8;
            float acc[8];
#pragma unroll
            for (int e = 0; e < 8; ++e) acc[e] = 0.f;
            u32x4 xr[5]; float okf[5];
#pragma unroll
            for (int kk = 0; kk < 5; ++kk) { const int sq = n * 64 + t + kk - 2; const bool ok = sq >= 0 && sq < SEQ; const int sqc = sq < 0 ? 0 : (sq >= SEQ ? SEQ - 1 : sq);
                okf[kk] = ok ? 1.f : 0.f; xr[kk] = *(const u32x4*)(F.PROJ() + (size_t)(b * SEQ + sqc) * INWP + O_CQKV + ch); }
#pragma unroll
            for (int kk = 0; kk < 5; ++kk) { float xv[8], wv[8]; unpack8(xr[kk], xv); unpack8(*(const LAS u32x4*)(CWL + (kk * 3 * CW + ch)), wv);
#pragma unroll
                for (int e = 0; e < 8; ++e) acc[e] += xv[e] * (wv[e] * okf[kk]); }
            float ss = 0.f;
#pragma unroll
            for (int e = 0; e < 8; ++e) { acc[e] = siluf_(acc[e]); ss += acc[e] * acc[e]; }
            ss += shx(ss, 1); ss += shx(ss, 2); ss += shx(ss, 4);
            const float sc = (which == 2) ? 1.0f : frsqrt(ss + NORM_EPS) * (which == 0 ? 0.125f : 1.0f);
#pragma unroll
            for (int e = 0; e < 8; ++e) acc[e] *= sc;
            *(LAS u32x4*)((which == 0 ? QB : (which == 1 ? KB : VB)) + t * 72 + c8 * 8) = pack8(acc);
        }
        if (w < 2) {
            const int dir = w;
            float g = dir ? __builtin_bit_cast(float, shfl_i(__builtin_bit_cast(int, g_t), 63 - lane)) : g_t;
            const float bt = dir ? __builtin_bit_cast(float, shfl_i(__builtin_bit_cast(int, b_t), 63 - lane)) : b_t;
#pragma unroll
            for (int d = 1; d < 64; d <<= 1) { const float o = __builtin_bit_cast(float, shup(__builtin_bit_cast(unsigned, g), d)); if (lane >= d) g += o; }
            const float last = __builtin_bit_cast(float, shfl_i(__builtin_bit_cast(int, g), 63)), eq = fexp(g);
            BT[dir * 64 + lane] = bt; GC[dir * 64 + lane] = g; EQ[dir * 64 + lane] = eq; EK[dir * 64 + lane] = fexp(last - g); BEQ[dir * 64 + lane] = bt * eq;
            if (lane == 63) { const int chain = (b * CHN + h) * 2 + dir, mm = dir ? NCH - 1 - n : n; F.GAM()[(size_t)chain * NCH + mm] = eq; }
        }
        bsync();
        }
        {
        {
            const int mat = w >> 2, tt = w & 3, c = lane & 15, g4 = lane >> 4;
            const LAS bf16_t* XA = (mat ? QB : KB) + (tt * 16 + c) * 72 + g4 * 8;
            const bf16x8 a0 = *(const LAS bf16x8*)XA, a1 = *(const LAS bf16x8*)(XA + 32);
            f32x4 acc[4];
#pragma unroll
            for (int ct = 0; ct < 4; ++ct) { const LAS bf16_t* XBp = KB + (ct * 16 + c) * 72 + g4 * 8;
                f32x4 a = {0.f, 0.f, 0.f, 0.f}; a = mfma16(a0, *(const LAS bf16x8*)XBp, a); a = mfma16(a1, *(const LAS bf16x8*)(XBp + 32), a); acc[ct] = a; }
            if (mat == 0) {
#pragma unroll 1
                for (int dir = 0; dir < 2; ++dir) {
                    float gct[4], btv[4], gcs[4];
#pragma unroll
                    for (int i = 0; i < 4; ++i) { const int t = 16 * tt + 4 * g4 + i, tau = dir ? 63 - t : t; gct[i] = GC[dir * 64 + tau]; btv[i] = BT[dir * 64 + tau]; }
#pragma unroll
                    for (int ct = 0; ct < 4; ++ct) { const int sq = 16 * ct + c, sg = dir ? 63 - sq : sq; gcs[ct] = GC[dir * 64 + sg]; }
#pragma unroll
                    for (int i = 0; i < 4; ++i) { const int t = 16 * tt + 4 * g4 + i, tau = dir ? 63 - t : t;
#pragma unroll
                        for (int ct = 0; ct < 4; ++ct) { const int sq = 16 * ct + c, sg = dir ? 63 - sq : sq;
                            LM[dir * LMD + tau * LMP + sg] = (sg < tau) ? btv[i] * acc[ct][i] * fexp(gct[i] - gcs[ct]) : 0.f; } }
                }
            } else {
#pragma unroll 1
                for (int dir = 0; dir < 2; ++dir) {
                    float gct[4], gcs[4]; int pcol[4];
#pragma unroll
                    for (int i = 0; i < 4; ++i) { const int t = 16 * tt + 4 * g4 + i, tau = dir ? 63 - t : t; gct[i] = GC[dir * 64 + tau]; }
#pragma unroll
                    for (int ct = 0; ct < 4; ++ct) { const int sq = 16 * ct + c, sg = dir ? 63 - sq : sq; gcs[ct] = GC[dir * 64 + sg]; pcol[ct] = perm_inv(sg); }
                    LAS bf16_t* QKI = (LAS bf16_t*)(XS + dir * 24576 + 16384);
#pragma unroll
                    for (int i = 0; i < 4; ++i) { const int t = 16 * tt + 4 * g4 + i, tau = dir ? 63 - t : t;
#pragma unroll
                        for (int ct = 0; ct < 4; ++ct) { const int sq = 16 * ct + c, sg = dir ? 63 - sq : sq;
                            QKI[tau * 64 + pcol[ct]] = (bf16_t)f2bf((sg <= tau) ? acc[ct][i] * fexp(gct[i] - gcs[ct]) : 0.f); } }
                }
            }
            if (mat == 0) {
                wsync();
                if (lane < 32) { const int dir = lane >> 4, blk = dir ? 3 - tt : tt;
                    const LAS float* Lb = LM + dir * LMD + (blk * 16) * LMP + blk * 16;
                    float tv[16];
#pragma unroll
                    for (int r = 0; r < 16; ++r) { float a = (r == c) ? 1.f : 0.f;
#pragma unroll
                        for (int s2 = 0; s2 < r; ++s2) a -= Lb[r * LMP + s2] * tv[s2];
                        tv[r] = a; }
                    LAS float* Tb = TMx + (dir * 4 + blk) * TMB;
#pragma unroll
                    for (int r = 0; r < 16; ++r) Tb[r * TMP + c] = tv[r]; }
            } else {
                const int t2 = tid - 256;
#pragma unroll 1
                for (int i = 0; i < 8; ++i) {
                    const int item = t2 + 256 * i, dir = item >> 10, mat2 = (item >> 9) & 1, row = (item >> 3) & 63, chk = item & 7;
                    const int chain = (b * CHN + h) * 2 + dir, mm = dir ? NCH - 1 - n : n;
                    unsigned char* rec = F.REC() + ((size_t)chain * NCH + mm) * RECB;
                    const int pi0 = 32 * (chk >> 2) + 4 * (chk & 3);
                    float o[8];
                    if (mat2 == 0) { const int t = dir ? 63 - row : row; const float eq = EQ[dir * 64 + row];
                        const u32x2 lo2 = *(const LAS u32x2*)(QB + t * 72 + pi0), hi2 = *(const LAS u32x2*)(QB + t * 72 + pi0 + 16);
                        o[0] = lo16(lo2.x) * eq; o[1] = hi16(lo2.x) * eq; o[2] = lo16(lo2.y) * eq; o[3] = hi16(lo2.y) * eq; o[4] = lo16(hi2.x) * eq; o[5] = hi16(hi2.x) * eq; o[6] = lo16(hi2.y) * eq; o[7] = hi16(hi2.y) * eq; }
                    else {
#pragma unroll
                        for (int e = 0; e < 8; ++e) { const int pi = pi0 + 16 * (e >> 2) + (e & 3), sq = dir ? 63 - pi : pi; o[e] = bf2f(KB[sq * 72 + row]) * EK[dir * 64 + pi]; } }
                    *(u32x4*)(rec + (mat2 ? 24576 : 8192) + row * 128 + chk * 16) = pack8(o);
                }
            }
        }
        bsync();
        }
        {
        {
            const int dir = w >> 2, c = lane & 15, g4 = lane >> 4;
            const LAS float* Lm = LM + dir * LMD; const LAS float* Tm = TMx + dir * 4 * TMB;
            bf16x8 AT[4], AL1, AL2, AL3a, AL3b;
#pragma unroll
            for (int i = 0; i < 4; ++i) { const f32x4 v = *(const LAS f32x4*)(Tm + i * TMB + c * TMP + 4 * g4); u32x4 t; t.x = pk2(v[0], v[1]); t.y = pk2(v[2], v[3]); t.z = 0u; t.w = 0u; AT[i] = __builtin_bit_cast(bf16x8, t); }
            { const f32x4 v = *(const LAS f32x4*)(Lm + (16 + c) * LMP + 4 * g4); u32x4 t; t.x = pk2(v[0], v[1]); t.y = pk2(v[2], v[3]); t.z = 0u; t.w = 0u; AL1 = __builtin_bit_cast(bf16x8, t); }
            { const f32x4 v = *(const LAS f32x4*)(Lm + (32 + c) * LMP + 4 * g4), v2 = *(const LAS f32x4*)(Lm + (32 + c) * LMP + 16 + 4 * g4); u32x4 t; t.x = pk2(v[0], v[1]); t.y = pk2(v[2], v[3]); t.z = pk2(v2[0], v2[1]); t.w = pk2(v2[2], v2[3]); AL2 = __builtin_bit_cast(bf16x8, t); }
            { const f32x4 v = *(const LAS f32x4*)(Lm + (48 + c) * LMP + 4 * g4), v2 = *(const LAS f32x4*)(Lm + (48 + c) * LMP + 16 + 4 * g4); u32x4 t; t.x = pk2(v[0], v[1]); t.y = pk2(v[2], v[3]); t.z = pk2(v2[0], v2[1]); t.w = pk2(v2[2], v2[3]); AL3a = __builtin_bit_cast(bf16x8, t); }
            { const f32x4 v = *(const LAS f32x4*)(Lm + (48 + c) * LMP + 32 + 4 * g4); u32x4 t; t.x = pk2(v[0], v[1]); t.y = pk2(v[2], v[3]); t.z = 0u; t.w = 0u; AL3b = __builtin_bit_cast(bf16x8, t); }
#pragma unroll 1
            for (int cti = 0; cti < 2; ++cti) {
                const int ct = 2 * (w & 3) + cti, col = 16 * ct + c;
                f32x4 R[4];
                const LAS bf16_t* rsrc = (ct < 4) ? VB + col : KB + (col - 64);
                const LAS float* rscl = ((ct < 4) ? BT : BEQ) + dir * 64;
#pragma unroll
                for (int i = 0; i < 4; ++i)
#pragma unroll
                    for (int e = 0; e < 4; ++e) { const int tau = 16 * i + 4 * g4 + e, t = dir ? 63 - tau : tau;
                        R[i][e] = bf2f(rsrc[t * 72]) * rscl[tau]; }
                const f32x4 z4 = {0.f, 0.f, 0.f, 0.f};
#define PKX(a, b2) __builtin_bit_cast(bf16x8, (u32x4){pk2((a)[0], (a)[1]), pk2((a)[2], (a)[3]), pk2((b2)[0], (b2)[1]), pk2((b2)[2], (b2)[3])})
                const f32x4 X0 = mfma16(AT[0], PKX(R[0], z4), z4);
                const f32x4 Y1 = R[1] - mfma16(AL1, PKX(X0, z4), z4);
                const f32x4 X1 = mfma16(AT[1], PKX(Y1, z4), z4);
                const bf16x8 X01 = PKX(X0, X1);
                const f32x4 Y2 = R[2] - mfma16(AL2, X01, z4);
                const f32x4 X2 = mfma16(AT[2], PKX(Y2, z4), z4);
                const f32x4 Y3 = R[3] - mfma16(AL3b, PKX(X2, z4), mfma16(AL3a, X01, z4));
                const f32x4 X3 = mfma16(AT[3], PKX(Y3, z4), z4);
#undef PKX
                const f32x4 X[4] = {X0, X1, X2, X3};
                if (ct < 4) { LAS bf16_t* U = (LAS bf16_t*)(XS + dir * 24576);
#pragma unroll
                    for (int i = 0; i < 4; ++i)
#pragma unroll
                        for (int e = 0; e < 4; ++e) U[(16 * i + 4 * g4 + e) * 64 + col] = (bf16_t)f2bf(X[i][e]); }
                else { LAS bf16_t* Wp = (LAS bf16_t*)(XS + dir * 24576 + 8192); const int sc = perm_inv(col - 64);
#pragma unroll
                    for (int i = 0; i < 4; ++i)
#pragma unroll
                        for (int e = 0; e < 4; ++e) Wp[(16 * i + 4 * g4 + e) * 64 + sc] = (bf16_t)f2bf(X[i][e]); }
            }
        }
        bsync();
        }
        {
#pragma unroll
        for (int k = 0; k < 6; ++k) { const int off = (tid + 512 * k) * 16, dir = off / 24576, oi = off % 24576;
            const int chain = (b * CHN + h) * 2 + dir, mm = dir ? NCH - 1 - n : n;
            unsigned char* rec = F.REC() + ((size_t)chain * NCH + mm) * RECB;
            *(u32x4*)(rec + (oi < 8192 ? 32768 + oi : (oi < 16384 ? oi - 8192 : oi))) = *(const LAS u32x4*)(XS + off); }
        }
    }
    bsync();
}

constexpr int ATT_KROWS = 384;
constexpr int ATT_VPITCH = 776;
constexpr int ATT_LDS_V = ATT_KROWS * 128;
struct AttUnit { int p, dil, Lp, QB, bh, r, jq0; };
DEV int att_qb(int Lp) { return Lp < 256 ? Lp : 256; }
DEV int att_units_total() { int t = 0; for (int p = 0; p < 3; ++p) { const int dil = (p == 0) ? 1 : (p == 1 ? 4 : 16); t += BATCH * BH * (SEQ / att_qb(SEQ / dil)); } return t; }
DEV bool att_decode(int u, AttUnit& a) {
    for (int p = 0; p < 3; ++p) { const int dil = (p == 0) ? 1 : (p == 1 ? 4 : 16), Lp = SEQ / dil, QB = att_qb(Lp), n = BATCH * BH * (SEQ / QB);
        if (u < n) { const int nb = Lp / QB, per_bh = dil * nb; a.p = p; a.dil = dil; a.Lp = Lp; a.QB = QB; a.bh = u / per_bh; const int q = u % per_bh; a.r = q / nb; a.jq0 = (q % nb) * QB; return true; }
        u -= n; }
    return false;
}
struct AttRegs { u32x4 kv[12]; };
DEV void att_load(Frame& F, const AttUnit& a, AttRegs& R) {
    const int tid = F.tid;
    const int nkeys = a.QB + 128, kbase = a.jq0 - 64;
    const bf16_t* Kb = F.KN() + (size_t)a.bh * SEQ * 64;
    const bf16_t* VTp = (const bf16_t*)(F.VT() + (size_t)a.p * VT_STRIDE) + ((size_t)a.bh * a.dil + a.r) * 64 * a.Lp;
#pragma unroll
    for (int i = 0; i < 6; ++i) {
        const int id = tid + 512 * i, row = id >> 3, cp = id & 7, j = kbase + row;
        u32x4 v = {0u, 0u, 0u, 0u};
        if (row < nkeys && j >= 0 && j < a.Lp) v = *(const u32x4*)(Kb + (size_t)(a.r + a.dil * j) * 64 + ((cp ^ (row & 7)) * 8));
        R.kv[i] = v;
    }
#pragma unroll
    for (int i = 0; i < 6; ++i) {
        const int id = tid + 512 * i, d = id / 48, ck = id % 48, j = kbase + ck * 8;
        u32x4 v = {0u, 0u, 0u, 0u};
        if (ck * 8 < nkeys && j >= 0 && j < a.Lp) v = *(const u32x4*)(VTp + (size_t)d * a.Lp + j);
        R.kv[6 + i] = v;
    }
}
DEV void att_store_lds(Frame& F, const AttRegs& R) {
    const int tid = F.tid;
#pragma unroll
    for (int i = 0; i < 6; ++i) { const int id = tid + 512 * i; *(LAS u32x4*)(F.lds + id * 16) = R.kv[i]; }
#pragma unroll
    for (int i = 0; i < 6; ++i) { const int id = tid + 512 * i, d = id / 48, ck = id % 48; LAS unsigned char* p = F.lds + ATT_LDS_V + d * ATT_VPITCH + ck * 16;
        u32x2 lo2, hi2; lo2.x = R.kv[6 + i].x; lo2.y = R.kv[6 + i].y; hi2.x = R.kv[6 + i].z; hi2.y = R.kv[6 + i].w; *(LAS u32x2*)p = lo2; *(LAS u32x2*)(p + 8) = hi2; }
}
DEV void att_loadq(Frame& F, const AttUnit& a, bf16x8 (&qf)[4]) {
    const int lane = F.lane, w = F.wave, r31 = lane & 31, hh = lane >> 5;
    if (w * 32 < a.QB) { const bf16_t* qp = F.QN() + ((size_t)a.bh * SEQ + a.r + a.dil * (a.jq0 + w * 32 + r31)) * 64 + 8 * hh;
#pragma unroll
        for (int s = 0; s < 4; ++s) qf[s] = *(const bf16x8*)(qp + 16 * s); }
}
DEV void att_compute(Frame& F, const AttUnit& a, const bf16x8 (&qf)[4], float Cb) {
    const int lane = F.lane, w = F.wave, r31 = lane & 31, hh = lane >> 5;
    if (w * 32 >= a.QB) return;
    const int jq = a.jq0 + w * 32;
    f32x16 o0, o1; for (int i = 0; i < 16; ++i) { o0[i] = 0.f; o1[i] = 0.f; }
    float lsum = 0.f;
#pragma unroll
    for (int kt = 0; kt < 5; ++kt) {
        const int jk = jq - 64 + 32 * kt, kl = 32 * w + 32 * kt;
        if (jk < 0 || jk >= a.Lp) continue;
        f32x16 sc; for (int i = 0; i < 16; ++i) sc[i] = 0.f;
        { const int row = kl + r31; const LAS unsigned char* kp = F.lds + row * 128;
#pragma unroll
          for (int s = 0; s < 4; ++s) sc = mfma32(*(const LAS bf16x8*)(kp + (((2 * s + hh) ^ (row & 7)) * 16)), qf[s], sc); }
        float pv[16];
#pragma unroll
        for (int i = 0; i < 16; ++i) { const int dlt = jk + (i & 3) + 8 * (i >> 2) + 4 * hh - (jq + r31);
            const float e = fexp(sc[i] - Cb); pv[i] = (dlt <= 64 && dlt >= -64) ? e : 0.f; lsum += pv[i]; }
        const bf16x8 p0 = __builtin_bit_cast(bf16x8, pack8(pv)), p1 = __builtin_bit_cast(bf16x8, pack8(pv + 8));
#pragma unroll
        for (int dt = 0; dt < 2; ++dt) {
            ASMV("" ::: "memory");
            const LAS unsigned char* vp = F.lds + ATT_LDS_V + (dt * 32 + r31) * ATT_VPITCH + (kl + 4 * hh) * 2;
            const u32x2 x0 = *(const LAS u32x2*)vp, x1 = *(const LAS u32x2*)(vp + 16), x2 = *(const LAS u32x2*)(vp + 32), x3 = *(const LAS u32x2*)(vp + 48);
            u32x4 a0, a1; a0.x = x0.x; a0.y = x0.y; a0.z = x1.x; a0.w = x1.y; a1.x = x2.x; a1.y = x2.y; a1.z = x3.x; a1.w = x3.y;
            if (dt == 0) { o0 = mfma32(__builtin_bit_cast(bf16x8, a0), p0, o0); o0 = mfma32(__builtin_bit_cast(bf16x8, a1), p1, o0); }
            else { o1 = mfma32(__builtin_bit_cast(bf16x8, a0), p0, o1); o1 = mfma32(__builtin_bit_cast(bf16x8, a1), p1, o1); }
        }
    }
    lsum += shx(lsum, 32);
    const int b = a.bh / BH, h = a.bh % BH; const size_t tok = (size_t)b * SEQ + a.r + a.dil * (jq + r31);
    bf16_t* np = F.NUM() + (size_t)a.p * (VT_STRIDE / 2) + tok * BW + h * 64;
#pragma unroll
    for (int g4 = 0; g4 < 4; ++g4) {
        u32x2 w0; w0.x = pk2(o0[4 * g4], o0[4 * g4 + 1]); w0.y = pk2(o0[4 * g4 + 2], o0[4 * g4 + 3]); *(u32x2*)(np + 8 * g4 + 4 * hh) = w0;
        u32x2 w1; w1.x = pk2(o1[4 * g4], o1[4 * g4 + 1]); w1.y = pk2(o1[4 * g4 + 2], o1[4 * g4 + 3]); *(u32x2*)(np + 32 + 8 * g4 + 4 * hh) = w1;
    }
    if (hh == 0) F.DEN()[((size_t)a.p * M + tok) * BH + h] = lsum;
}
DEV void attn_units(Frame& F, int L, int slot, int nslots) {
    const int lane = F.lane;
    const float gq = wave_max(fabsf(F.q_norm_g()[(size_t)L * 64 + lane])), gk = wave_max(fabsf(F.k_norm_g()[(size_t)L * 64 + lane]));
    const float Cb = 8.0f * gq * gk;
    const int total = att_units_total();
    for (int u = slot; u < total; u += nslots) {
        AttUnit cur; att_decode(u, cur);
        bf16x8 qf[4];
#pragma unroll
        for (int s = 0; s < 4; ++s) qf[s] = (bf16x8){0, 0, 0, 0, 0, 0, 0, 0};
        { AttRegs R; att_load(F, cur, R); att_loadq(F, cur, qf); att_store_lds(F, R); }
        bsync();
        att_compute(F, cur, qf, Cb);
        bsync();
    }
}

DEV void scan_store_o(Frame& F, bf16_t* Ob, int b, int h, int dir, int m) {
    const int t2 = F.tid - 256, nchunk = dir ? NCH - 1 - m : m;
    const LAS unsigned char* tile = F.lds + 3 * RECB + (m & 1) * 8192;
#pragma unroll
    for (int k = 0; k < 2; ++k) { const int id = t2 + 256 * k, tau = id >> 3, ck = id & 7, sq = nchunk * 64 + (dir ? 63 - tau : tau);
        *(u32x4*)(Ob + ((size_t)b * SEQ + sq) * CW + h * 64 + ck * 8) = *(const LAS u32x4*)(tile + tau * 128 + ck * 16); }
}
DEV void scan_chains(Frame& F, int slot, int nslots) {
    const int lane = F.lane, w = F.wave, c = lane & 15, g4 = lane >> 4;
    constexpr int NDMA = RECB / 4096;
    static_assert(NDMA == 10 && RECB % 8192 == 0, "the counted waits below assume 10 DMAs per loader wave per record");
    for (int chain = slot; chain < NCHAIN; chain += nslots) {
        const int dir = chain & 1, bhh = chain >> 1, h = bhh % CHN, b = bhh / CHN;
        const unsigned char* recs = F.REC() + (size_t)chain * NCH * RECB;
        const float* gam = F.GAM() + (size_t)chain * NCH;
#pragma unroll
        for (int it = 0; it < 2 * RECB / 8192; ++it) glds16(recs + it * 8192 + w * 1024 + lane * 16, F.lds + it * 8192 + w * 1024);
        ASMV("s_waitcnt vmcnt(0)" ::: "memory"); rawbar(); ASMV("" ::: "memory");
        f32x4 S[4];
#pragma unroll
        for (int i = 0; i < 4; ++i) S[i] = (f32x4){0.f, 0.f, 0.f, 0.f};
        bf16_t* Ob = F.OFB() + (size_t)dir * M * CW;
        int bi = 0;
#pragma unroll 1
        for (int m = 0; m < NCH; ++m) {
            LAS unsigned char* buf = F.lds + bi * RECB;
            if (w >= 4) {
                if (m + 2 < NCH) { const int bn = bi == 0 ? 2 : bi - 1;
                    const unsigned char* src = recs + (size_t)(m + 2) * RECB + (w - 4) * 1024 + lane * 16; LAS unsigned char* dst = F.lds + bn * RECB + (w - 4) * 1024;
#pragma unroll
                    for (int it = 0; it < NDMA; ++it) glds16(src + it * 4096, dst + it * 4096);
                    if (m > 0) scan_store_o(F, Ob, b, h, dir, m - 1);
                    ASMV("s_waitcnt vmcnt(12)" ::: "memory");
                } else { if (m > 0) scan_store_o(F, Ob, b, h, dir, m - 1); ASMV("s_waitcnt vmcnt(2)" ::: "memory"); }
            } else {
                const float gamma = gam[m];
                const LAS unsigned char* Wp = buf; const LAS unsigned char* Qp = buf + 8192; const LAS unsigned char* QKp = buf + 16384; const LAS unsigned char* Ktp = buf + 24576;
                const LAS bf16_t* U = (const LAS bf16_t*)(buf + 32768);
                const int aoff = c * 128 + g4 * 16;
                bf16x8 Sb[2];
#pragma unroll
                for (int ks = 0; ks < 2; ++ks) { u32x4 t; t.x = pk2(S[2 * ks][0], S[2 * ks][1]); t.y = pk2(S[2 * ks][2], S[2 * ks][3]); t.z = pk2(S[2 * ks + 1][0], S[2 * ks + 1][1]); t.w = pk2(S[2 * ks + 1][2], S[2 * ks + 1][3]); Sb[ks] = __builtin_bit_cast(bf16x8, t); }
                f32x4 VN[4];
#pragma unroll
                for (int tt = 0; tt < 4; ++tt) {
                    f32x4 a = {0.f, 0.f, 0.f, 0.f};
#pragma unroll
                    for (int ks = 0; ks < 2; ++ks) a = mfma16(*(const LAS bf16x8*)(Wp + tt * 2048 + aoff + ks * 64), Sb[ks], a);
#pragma unroll
                    for (int i = 0; i < 4; ++i) VN[tt][i] = bf2f(U[(16 * tt + 4 * g4 + i) * 64 + 16 * w + c]) - a[i];
                }
                bf16x8 VNb[2];
#pragma unroll
                for (int ks = 0; ks < 2; ++ks) { u32x4 t; t.x = pk2(VN[2 * ks][0], VN[2 * ks][1]); t.y = pk2(VN[2 * ks][2], VN[2 * ks][3]); t.z = pk2(VN[2 * ks + 1][0], VN[2 * ks + 1][1]); t.w = pk2(VN[2 * ks + 1][2], VN[2 * ks + 1][3]); VNb[ks] = __builtin_bit_cast(bf16x8, t); }
#pragma unroll
                for (int tt = 0; tt < 4; ++tt) {
                    ASMV("" ::: "memory");
                    f32x4 o = {0.f, 0.f, 0.f, 0.f};
#pragma unroll
                    for (int ks = 0; ks < 2; ++ks) o = mfma16(*(const LAS bf16x8*)(Qp + tt * 2048 + aoff + ks * 64), Sb[ks], o);
#pragma unroll
                    for (int ks = 0; ks < 2; ++ks) o = mfma16(*(const LAS bf16x8*)(QKp + tt * 2048 + aoff + ks * 64), VNb[ks], o);
#pragma unroll
                    for (int i = 0; i < 4; ++i) ((LAS bf16_t*)(F.lds + 3 * RECB + (m & 1) * 8192))[(16 * tt + 4 * g4 + i) * 64 + 16 * w + c] = (bf16_t)f2bf(o[i]);
                }
#pragma unroll
                for (int rt = 0; rt < 4; ++rt) {
                    ASMV("" ::: "memory");
                    f32x4 a = S[rt] * gamma;
#pragma unroll
                    for (int ks = 0; ks < 2; ++ks) a = mfma16(*(const LAS bf16x8*)(Ktp + rt * 2048 + aoff + ks * 64), VNb[ks], a);
                    S[rt] = a;
                }
                ASMV("s_waitcnt lgkmcnt(0)" ::: "memory");
            }
            rawbar(); ASMV("" ::: "memory");
            bi = bi == 2 ? 0 : bi + 1;
        }
        if (w >= 4) scan_store_o(F, Ob, b, h, dir, NCH - 1);
        ASMV("s_waitcnt vmcnt(0)" ::: "memory");
        rawbar();
    }
}

DEV void phase_assemble(Frame& F, int L) {
    const int nitems = M * (BH + CHN) * 4;
    const int stride = F.G * NTHREADS;
    for (int it0 = F.wg * NTHREADS; it0 < nitems; it0 += stride) {
        const int it = it0 + F.tid; const bool live = it < nitems;
        const int qd = it & 3, hd = live ? (it >> 2) % (BH + CHN) : 0, tok = live ? (it >> 2) / (BH + CHN) : 0;
        float v[16]; float ss = 0.f; bf16_t* dst;
        if (hd < BH) {
#pragma unroll
            for (int i = 0; i < 16; ++i) v[i] = 0.f;
            float den = 0.f;
#pragma unroll
            for (int p = 0; p < 3; ++p) { const bf16_t* np = F.NUM() + (size_t)p * (VT_STRIDE / 2) + (size_t)tok * BW + hd * 64 + qd * 16; float t[16]; unpack8(*(const u32x4*)np, t); unpack8(*(const u32x4*)(np + 8), t + 8);
#pragma unroll
                for (int i = 0; i < 16; ++i) v[i] += t[i];
                den += F.DEN()[((size_t)p * M + tok) * BH + hd]; }
            const float inv = 1.0f / den;
#pragma unroll
            for (int i = 0; i < 16; ++i) v[i] *= inv;
            dst = F.ACT() + (size_t)tok * DM + GW + hd * 64 + qd * 16;
        } else {
            const int hc = hd - BH; float bb[16], gt[16];
            const bf16_t* of = F.OFB() + (size_t)tok * CW + hc * 64 + qd * 16; const bf16_t* ob = of + (size_t)M * CW;
            unpack8(*(const u32x4*)of, v); unpack8(*(const u32x4*)(of + 8), v + 8); unpack8(*(const u32x4*)ob, bb); unpack8(*(const u32x4*)(ob + 8), bb + 8);
            const bf16_t* gp = F.PROJ() + (size_t)tok * INWP + O_CG + hc * 64 + qd * 16; unpack8(*(const u32x4*)gp, gt); unpack8(*(const u32x4*)(gp + 8), gt + 8);
            const float* og = F.o_norm_g() + (size_t)L * 64 + qd * 16;
#pragma unroll
            for (int i = 0; i < 16; ++i) { v[i] += bb[i]; ss += v[i] * v[i]; v[i] *= og[i] * siluf_(gt[i]); }
            dst = F.ACT() + (size_t)tok * DM + GW + BW + hc * 64 + qd * 16;
        }
        ss += shx(ss, 1); ss += shx(ss, 2);
        const float rstd = (hd < BH) ? 1.0f : frsqrt(ss * (1.f / 64.f) + NORM_EPS);
#pragma unroll
        for (int i = 0; i < 16; ++i) v[i] *= rstd;
        if (live) { *(u32x4*)dst = pack8(v); *(u32x4*)(dst + 8) = pack8(v + 8); }
    }
}

constexpr int RT_PITCH = DM + 8;
constexpr int RT_HI = 0, RT_LO = 16 * RT_PITCH * 2, RT_G = 2 * RT_LO;
DEV void phase_router(Frame& F, int L) {
    LAS bf16_t* WH = (LAS bf16_t*)(F.lds + RT_HI); LAS bf16_t* WL = (LAS bf16_t*)(F.lds + RT_LO); LAS float* GF = (LAS float*)(F.lds + RT_G);
    for (int i = F.tid; i < DM; i += NTHREADS) GF[i] = F.g_ffn()[(size_t)L * DM + i];
    { constexpr int NF = (DM * 16 + NTHREADS - 1) / NTHREADS;
#pragma unroll 4
      for (int i = 0; i < NF; ++i) { const int id = F.tid + NTHREADS * i; if (id < DM * 16) { const int d = id >> 4, e = id & 15;
          const float w = (e < NEXP) ? F.w_router()[(size_t)L * DM * NEXP + (size_t)d * NEXP + e] * F.g_ffn()[(size_t)L * DM + d] : 0.f;
          const unsigned hi = f2bf(w); const float lo = w - __builtin_bit_cast(float, hi << 16);
          WH[e * RT_PITCH + d] = (bf16_t)hi; WL[e * RT_PITCH + d] = (bf16_t)f2bf(lo); } } }
    bsync();
    const int gw = F.wg * NWAVES + F.wave, NGW = F.G * NWAVES, lane = F.lane, c = lane & 15, g4 = lane >> 4;
    constexpr int NKS = DM / 32;
    for (int rb = gw; rb < M / 16; rb += NGW) {
        const int row = rb * 16 + c;
        u32x4 xv[NKS];
        const u32x4* xp = (const u32x4*)(F.XB(L) + (size_t)row * DM + 8 * g4);
        u32x4* hp = (u32x4*)(F.ACT() + (size_t)row * DM + 8 * g4);
        const LAS bf16_t* whp = WH + c * RT_PITCH + 8 * g4; const LAS bf16_t* wlp = WL + c * RT_PITCH + 8 * g4; const LAS float* gfp = GF + 8 * g4;
#pragma unroll
        for (int ks = 0; ks < NKS; ++ks) xv[ks] = xp[4 * ks];
        f32x4 acc = {0.f, 0.f, 0.f, 0.f}; float ss = 0.f;
#pragma unroll
        for (int ks = 0; ks < NKS; ++ks) {
            const bf16x8 a = __builtin_bit_cast(bf16x8, xv[ks]);
            acc = mfma16(a, *(const LAS bf16x8*)(whp + 32 * ks), acc);
            acc = mfma16(a, *(const LAS bf16x8*)(wlp + 32 * ks), acc);
            float t[8]; unpack8(xv[ks], t);
#pragma unroll
            for (int e = 0; e < 8; ++e) ss += t[e] * t[e];
            if ((ks & 1) == 1) ASMV("" : "+v"(acc), "+v"(ss) :: "memory");
        }
        ss += shx(ss, 16); ss += shx(ss, 32);
        const float rstd = frsqrt(ss * (1.f / DM) + NORM_EPS);
#pragma unroll
        for (int ks = 0; ks < NKS; ++ks) { ASMV("" : "+v"(xv[ks]));
            float t[8]; unpack8(xv[ks], t);
            const f32x4 g0 = *(const LAS f32x4*)(gfp + 32 * ks), g1 = *(const LAS f32x4*)(gfp + 32 * ks + 4);
#pragma unroll
            for (int e = 0; e < 4; ++e) { t[e] *= rstd * g0[e]; t[4 + e] *= rstd * g1[e]; }
            hp[4 * ks] = pack8(t);
            ASMV("" ::: "memory"); }
#pragma unroll
        for (int i = 0; i < 4; ++i) {
            const float rs = __builtin_bit_cast(float, shfl_i(__builtin_bit_cast(int, rstd), 4 * g4 + i));
            float lg = (c < NEXP) ? acc[i] * rs : -3.0e38f;
            float mx = lg;
#pragma unroll
            for (int o = 1; o < 16; o <<= 1) mx = fmaxf(mx, shx(mx, o));
            const float ex = (c < NEXP) ? expf(lg - mx) : 0.f; float sm = ex;
#pragma unroll
            for (int o = 1; o < 16; o <<= 1) sm += shx(sm, o);
            const int m = rb * 16 + 4 * g4 + i, b = m / SEQ, sq = m % SEQ;
            if (c < NEXP) F.AFF()[((size_t)b * NEXP + c) * SEQ + sq] = ex / sm;
        }
    }
}

constexpr int KPT = (SEQ + NTHREADS - 1) / NTHREADS;
DEV unsigned block_sum_u(Frame& F, unsigned v, int parity) {
    LAS unsigned* red = (LAS unsigned*)(F.lds + 1024) + parity * 8;
    float f = (float)v; f = wave_sum(f);
    if (F.lane == 0) red[F.wave] = (unsigned)f;
    bsync();
    unsigned t = 0;
#pragma unroll
    for (int i = 0; i < NWAVES; ++i) t += red[i];
    return t;
}
DEV void phase_topk(Frame& F) {
    const int tid = F.tid, lane = F.lane;
    for (int pair = F.wg; pair < BATCH * NEXP; pair += F.G) {
        const int b = pair / NEXP, e = pair % NEXP;
        const float* aff = F.AFF() + (size_t)pair * SEQ;
        unsigned key[KPT];
#pragma unroll
        for (int i = 0; i < KPT; ++i) { const int s = tid * KPT + i; key[i] = (s < SEQ) ? __builtin_bit_cast(unsigned, aff[s]) : 0u; }
        unsigned prefix = 0u; int par = 0;
#pragma unroll 1
        for (int bit = 30; bit >= 0; --bit) {
            const unsigned cand = prefix | (1u << bit); unsigned cnt = 0;
#pragma unroll
            for (int i = 0; i < KPT; ++i) cnt += (key[i] >= cand) ? 1u : 0u;
            const unsigned tot = block_sum_u(F, cnt, par); par ^= 1;
            if (tot >= (unsigned)CAP) prefix = cand;
        }
        unsigned cgt = 0, ceq = 0;
#pragma unroll
        for (int i = 0; i < KPT; ++i) { cgt += (key[i] > prefix) ? 1u : 0u; ceq += (key[i] == prefix) ? 1u : 0u; }
        const unsigned ngt = block_sum_u(F, cgt, par); par ^= 1;
        const unsigned rr = (unsigned)CAP - ngt;
        unsigned v = cgt | (ceq << 16), inc = v;
#pragma unroll
        for (int d = 1; d < 64; d <<= 1) { const unsigned t = shup(inc, d); if (lane >= d) inc += t; }
        LAS unsigned* wt = (LAS unsigned*)(F.lds + 2048);
        if (lane == 63) wt[F.wave] = inc;
        bsync();
        unsigned base = 0;
#pragma unroll
        for (int i = 0; i < NWAVES; ++i) base += (i < F.wave) ? wt[i] : 0u;
        unsigned excl = base + inc - v; unsigned gtb = excl & 0xffffu, eqb = excl >> 16;
#pragma unroll
        for (int i = 0; i < KPT; ++i) { const int s = tid * KPT + i; if (s < SEQ) {
            const bool isgt = key[i] > prefix, iseq = key[i] == prefix; const bool sel = isgt || (iseq && eqb < rr);
            const unsigned slot = gtb + (eqb < rr ? eqb : rr);
            if (sel) { const size_t row = ((size_t)e * BATCH + b) * CAP + slot; F.IDX()[row] = s; F.GATEV()[row] = __builtin_bit_cast(float, key[i]); }
            F.INV()[((size_t)b * SEQ + s) * NEXP + e] = sel ? (int)slot : -1;
            gtb += isgt ? 1u : 0u; eqb += iseq ? 1u : 0u; } }
        bsync();
    }
}

DEV void phase_pconv(Frame& F, int L) {
    const int gw = F.wg * NWAVES + F.wave, NGW = F.G * NWAVES, lane = F.lane;
    for (int m0 = gw * 4; m0 < M; m0 += NGW * 4) {
        f32x4 v[4];
#pragma unroll
        for (int r = 0; r < 4; ++r) v[r] = *((const f32x4*)(F.p() + ((size_t)L * M + m0 + r) * PLE) + lane);
#pragma unroll
        for (int r = 0; r < 4; ++r) { u32x2 o; o.x = pk2(v[r][0], v[r][1]); o.y = pk2(v[r][2], v[r][3]); *((u32x2*)(F.PB() + (size_t)(m0 + r) * PLE) + lane) = o; }
    }
}

template <bool DRY> DEV void phase_combine(Frame& F, int L) {
    const int gw = F.wg * NWAVES + F.wave, NGW = F.G * NWAVES, lane = F.lane;
    constexpr int R = 2;
    for (int m0 = gw * R; m0 < M; m0 += NGW * R) {
        f32x4 v[R][NJ]; int inv[R];
#pragma unroll
        for (int r = 0; r < R; ++r) {
            inv[r] = (lane < NEXP) ? F.INV()[(size_t)(m0 + r) * NEXP + lane] : -1;
#pragma unroll
            for (int j = 0; j < NJ; ++j) { { const u32x2 y = *((const u32x2*)(F.XB(L) + (size_t)(m0 + r) * DM) + lane + 64 * j); v[r][j] = (f32x4){lo16(y.x), hi16(y.x), lo16(y.y), hi16(y.y)}; } }
        }
#pragma unroll
        for (int r = 0; r < R; ++r) {
            const int b = (m0 + r) / SEQ;
            unsigned long long mask = ballot_(inv[r] >= 0);
            while (mask) {
                const int e0 = __builtin_ctzll(mask); mask &= mask - 1;
                const bool two = mask != 0ull; const int e1 = two ? __builtin_ctzll(mask) : e0; if (two) mask &= mask - 1;
                const int s0 = shfl_i(inv[r], e0), s1 = shfl_i(inv[r], e1);
                const u32x2* y0 = (const u32x2*)(F.YE() + (((size_t)e0 * BATCH + b) * CAP + s0) * DM) + lane;
                const u32x2* y1 = (const u32x2*)(F.YE() + (((size_t)e1 * BATCH + b) * CAP + s1) * DM) + lane;
                u32x2 a0[NJ], a1[NJ];
#pragma unroll
                for (int j = 0; j < NJ; ++j) { a0[j] = y0[64 * j]; a1[j] = y1[64 * j]; }
#pragma unroll
                for (int j = 0; j < NJ; ++j) { v[r][j][0] += lo16(a0[j].x); v[r][j][1] += hi16(a0[j].x); v[r][j][2] += lo16(a0[j].y); v[r][j][3] += hi16(a0[j].y);
                    if (two) { v[r][j][0] += lo16(a1[j].x); v[r][j][1] += hi16(a1[j].x); v[r][j][2] += lo16(a1[j].y); v[r][j][3] += hi16(a1[j].y); } }
            }
        }
#pragma unroll
        for (int r = 0; r < R; ++r) {
            const int m = m0 + r;
            u32x2* xr = (u32x2*)((DRY ? F.XE() : F.XB(L)) + (size_t)m * DM) + lane;
            float s = 0.f;
#pragma unroll
            for (int j = 0; j < NJ; ++j) { u32x2 xo; xo.x = pk2(v[r][j][0], v[r][j][1]); xo.y = pk2(v[r][j][2], v[r][j][3]); xr[64 * j] = xo; s += (v[r][j][0] * v[r][j][0] + v[r][j][1] * v[r][j][1]) + (v[r][j][2] * v[r][j][2] + v[r][j][3] * v[r][j][3]); }
            const float rstd = frsqrt(wave_sum(s) * (1.f / DM) + NORM_EPS);
            if (lane == 0 && !DRY) F.RSTD()[M + m] = rstd;
        }
    }
}

__global__ void __launch_bounds__(NTHREADS, 2) mega_fwd(Args args) {
#ifndef HOST_EMU
    extern __shared__ __attribute__((aligned(16))) unsigned char lds_raw[];
    LAS unsigned char* lds = (LAS unsigned char*)lds_raw;
#else
    unsigned char* lds = emu::g_lds;
#endif
    Frame F;
    F.lds = lds; F.tid = threadIdx.x; F.lane = F.tid & 63; F.wave = rfl(F.tid >> 6); F.G = gridDim.x; F.wg = blockIdx.x; F.a = &args;
    unsigned char* ws = args.ws;
    const int lo = args.ph_lo, hi = args.ph_hi;
#ifndef HOST_EMU
    volatile LAS unsigned* MISC = (volatile LAS unsigned*)(lds + LDS_MISC);
    if (F.tid < 64) MISC[F.tid] = 0u;
    __syncthreads();
    XcdBarrier bar; bar.bar = (unsigned*)(ws + WS_CTL) + 4096; bar.x = 0; bar.st = MISC;
    if (hi - lo > 1) bar = xcd_barrier_post((unsigned*)(ws + WS_CTL) + 4096, MISC);
#define SEAM(k) do { if ((k) + 1 < hi) xcd_barrier(bar); } while (0)
#else
#define SEAM(k) do {} while (0)
#endif
#ifndef PH_MASK
#define PH_MASK 0xFFFFFFFFu
#endif
#ifndef DUP_MASK
#define DUP_MASK 0u
#endif
#define REPS(j) (int)(1u + ((DUP_MASK >> (j)) & 1u))
#define IN(k) (((PH_MASK >> (((k) == 0) ? 0 : (((k) - 1) % NPH) + 1)) & 1u) && lo <= (k) && (k) < hi)
#pragma unroll 1
    for (int L = -1; L < DEPTH; ++L) {
        const int pb = 1 + L * NPH;
        ASMV("" : "+v"(F.tid)); ASMV("" : "+s"(F.wg), "+s"(F.G)); F.lane = F.tid & 63; F.wave = rfl(F.tid >> 6);
        if (L >= 0 && IN(pb + 0)) { pw_experts(F, L, F.wg * NWAVES + F.wave, F.G * NWAVES); phase_pconv(F, L); SEAM(pb + 1); }
        if (L >= 0) {
        if (IN(pb + 2)) {
            pg8::Gemm g{F.XB(L), F.WIN(), M, INWP, DM, 0, 0, nullptr}; pg8::StaticOrder S; S.init(M, INWP, F.G, F.wg);
            pg8::EpiBf16 E{F.PROJ(), INWP, F.XPART(), 1.0f / DM, nullptr}; for (int rep = 0; rep < REPS(3); ++rep) pg8::gemm_phase(lds, g, S, E, F.tid);
            {
                const int nu = (M / 256) * (INWP / 256), rem = nu % F.G, g2 = rem ? (F.wg >= rem ? F.G - rem : (1 << 28)) : F.G, c2 = F.wg;
                pg8::Gemm ge{F.PB(), F.WPLE(), M, DM, PLE, 0, 0, nullptr}; pg8::StaticOrder Se; Se.init(M, DM, g2, c2);
                pg8::EpiBf16 Ee{F.XB(L + 1), DM, nullptr, 0.f, F.EPART()}; pg8::gemm_phase(lds, ge, Se, Ee, F.tid); }
            SEAM(pb + 2);
        }
        if (IN(pb + 3)) { for (int rep = 0; rep < REPS(4); ++rep) { gmlp_units(F, L); attnprep_units(F, L); gdnprep_units(F, L); } SEAM(pb + 3); }
        if (IN(pb + 4)) {
            int nsc = NCHAIN < (F.G * 3) / 4 ? NCHAIN : (F.G * 3) / 4; if (nsc < 1) nsc = 1;
            for (int rep = 0; rep < REPS(5); ++rep) {
            if (F.G == 1) { scan_chains(F, 0, 1); attn_units(F, L, 0, 1); }
            else if (F.wg < nsc) scan_chains(F, F.wg, nsc);
            else attn_units(F, L, F.wg - nsc, F.G - nsc);
            }
            SEAM(pb + 4);
        }
        if (IN(pb + 5)) { for (int rep = 0; rep < REPS(6); ++rep) phase_assemble(F, L); SEAM(pb + 5); }
        if (IN(pb + 6)) {
            pg8::Gemm g{F.ACT(), F.WOUT(), M, DM, DM, 0, 0, nullptr}; pg8::StaticOrder S; S.init(M, DM, F.G, F.wg);
            pg8::EpiResB E{F.XB(L), F.XB(L), DM}; pg8::gemm_phase(lds, g, S, E, F.tid); SEAM(pb + 6);
        }
        if (IN(pb + 7)) { for (int rep = 0; rep < REPS(8); ++rep) { phase_router(F, L); bsync(); } SEAM(pb + 7); }
        }
        if (L >= 0 ? IN(pb + 8) : IN(0)) {
            const int npair = BATCH * NEXP; int slot = F.wg, nslots = F.G;
            if (L >= 0) { phase_topk(F); if (F.G > npair) { slot = F.wg - npair; nslots = F.G - npair; } } else phase_prologue(F);
            bsync();
            if (L + 1 < DEPTH && slot >= 0) phase_pw(F, L + 1, slot, nslots);
            if (L >= 0) SEAM(pb + 8);
        }
        if (L >= 0) {
        if (IN(pb + 10)) {
            pg8::Gemm g{F.ACT(), F.WGU(), MR, 2 * DE, DM, ROWS_E / 256, (size_t)2 * DE * DM * 2, F.IDX()}; pg8::StaticOrder S; S.init(MR, 2 * DE, F.G, F.wg);
            pg8::EpiSwiGLU E{F.HID(), DE, F.RSROW()}; for (int rep = 0; rep < REPS(11); ++rep) pg8::gemm_phase<pg8::EpiSwiGLU, true>(lds, g, S, E, F.tid); SEAM(pb + 10);
        }
        if (IN(pb + 11)) {
            { pg8::Gemm g{F.HID(), F.WD(), MR, DM, DE, ROWS_E / 256, (size_t)DM * DE * 2, nullptr}; pg8::StaticOrder S; S.init(MR, DM, F.G, F.wg);
              pg8::EpiScaleBf16 E{F.YE(), DM, F.GATEV()}; for (int rep = 0; rep < REPS(12); ++rep) pg8::gemm_phase(lds, g, S, E, F.tid); }
            SEAM(pb + 11);
        }
        }
        if (L >= 0 ? IN(pb + 12) : IN(0)) {
            if (L >= 0) phase_combine<false>(F, L);
            if (L >= 0) SEAM(pb + 12); else SEAM(0);
        }
        if (L >= 0) {
        if (IN(pb + 13)) {
            pg8::Gemm g{F.XB(L), F.WPG(L), M, DM, DM, 0, 0, nullptr}; pg8::StaticOrder S; S.init(M, DM, F.G, F.wg);
            pg8::EpiPleGate E{F.XB(L), F.XB(L + 1), F.XB(L + 1), F.EPART(), F.g_ple() + (size_t)L * DM, F.XPART(), (L == DEPTH - 1) ? F.out() : (float*)nullptr, DM, F.RSTD() + M}; pg8::gemm_phase(lds, g, S, E, F.tid); SEAM(pb + 13);
        }
        }
    }
#undef IN
#undef SEAM
}

#ifndef N_LAUNCH_MODE
#define N_LAUNCH_MODE 1
#endif
extern "C" void kernel_launch(void* const* d_in, const int* in_sizes, int n_in, void* d_out, int out_size, void* d_ws, size_t ws_size, hipStream_t stream) {
    Args a;
    memset(&a, 0, sizeof(a));
    for (int i = 0; i < 25; ++i) a.in[i] = d_in[i];
    a.out = (float*)d_out; a.ws = (unsigned char*)d_ws;
#ifndef HOST_EMU
    static int grid = 0;
    if (grid == 0) {
        int dev = 0, cus = 0;
        if (n_in != 25 || out_size != M * DM || ws_size < WS_END) { fprintf(stderr, "kernel_launch: unexpected shapes (n_in %d out %d ws %zu need %zu)\n", n_in, out_size, ws_size, (size_t)WS_END); grid = -1; return; }
        if (hipGetDevice(&dev) != hipSuccess || hipDeviceGetAttribute(&cus, hipDeviceAttributeMultiprocessorCount, dev) != hipSuccess) { grid = -1; return; }
        if (hipFuncSetAttribute((const void*)mega_fwd, hipFuncAttributeMaxDynamicSharedMemorySize, LDS_BYTES) != hipSuccess) { fprintf(stderr, "kernel_launch: hipFuncSetAttribute failed\n"); grid = -1; return; }
        int per_cu = 0;
        if (hipOccupancyMaxActiveBlocksPerMultiprocessor(&per_cu, (const void*)mega_fwd, NTHREADS, LDS_BYTES) != hipSuccess || per_cu < 1) fprintf(stderr, "kernel_launch: occupancy query says %d\n", per_cu);
        (void)hipGetLastError();
        grid = cus;
    }
    if (grid < 0) return;
    (void)hipMemsetAsync((char*)d_ws + WS_CTL, 0, CTL_BYTES, stream);
    if (N_LAUNCH_MODE == 1) { a.ph_lo = 0; a.ph_hi = NPHASES; hipLaunchKernelGGL(mega_fwd, dim3(grid), dim3(NTHREADS), LDS_BYTES, stream, a); }
    else for (int ph = 0; ph < NPHASES; ++ph) { a.ph_lo = ph; a.ph_hi = ph + 1; hipLaunchKernelGGL(mega_fwd, dim3(grid), dim3(NTHREADS), LDS_BYTES, stream, a); }
#else
    (void)in_sizes; (void)n_in; (void)out_size; (void)ws_size; (void)stream;
    for (int ph = emu_ph_lo; ph < emu_ph_hi && ph < NPHASES; ++ph) { a.ph_lo = ph; a.ph_hi = ph + 1; Args aa = a; emu::launch([aa]() { mega_fwd(aa); }, emu_grid, NTHREADS, LDS_BYTES); fprintf(stderr, "phase %d done\n", ph); }
#endif
}
```

```cpp
#ifndef HOST_EMU
#include <hip/hip_runtime.h>
#include <cstdio>
#include <cstdint>
#include <cstring>
#define DEV __device__ __forceinline__
#define DEVM __device__ __forceinline__
#define LAS __attribute__((address_space(3)))
#define ASMV(...) asm volatile(__VA_ARGS__)
#else
#define DEV static inline
#define DEVM inline
#define LAS
#define ASMV(...) do {} while (0)
#define __global__
#define __launch_bounds__(...)
#endif

typedef unsigned short bf16_t;
typedef short bf16x8 __attribute__((ext_vector_type(8)));
typedef float f32x4 __attribute__((ext_vector_type(4)));
typedef float f32x16 __attribute__((ext_vector_type(16)));
typedef unsigned u32x4 __attribute__((ext_vector_type(4)));
typedef unsigned u32x2 __attribute__((ext_vector_type(2)));

#ifdef CFG_SMALL
constexpr int BATCH = 2, SEQ = 512, DM = 512, DEPTH = 2, NEXP = 4;
#else
constexpr int BATCH = 8, SEQ = 4096, DM = 1024, DEPTH = 4, NEXP = 16;
#endif
constexpr int PLE = 256, HD = 64;
constexpr int GW = DM / 4, GG = GW / HD, GCH = 128;
constexpr int BW = 3 * DM / 8, BH = BW / HD;
constexpr int CW = DM - GW - BW, CHN = CW / HD;
constexpr int CAP = 2 * SEQ / NEXP, DE = DM;
constexpr int M = BATCH * SEQ;
constexpr int O_AU = 0, O_AV = GW, O_BQ = 2 * GW, O_BK = O_BQ + BW, O_BV = O_BK + BW, O_CQKV = O_BV + BW, O_CG = O_CQKV + 3 * CW, O_CA = O_CG + CW, O_CB = O_CA + 2 * CHN, INW = O_CB + 2 * CHN;
constexpr int INWP = (INW + 255) / 256 * 256;
constexpr int ROWS_E = BATCH * CAP, MR = NEXP * ROWS_E;
constexpr int NCH = SEQ / 64;
constexpr int NCHAIN = BATCH * CHN * 2;
constexpr int RECB = 40960;
constexpr float NORM_EPS = 1e-6f;
constexpr int NPH = 14, NPHASES = 1 + NPH * DEPTH;
constexpr int NTHREADS = 512, NWAVES = 8;
static_assert(M % 256 == 0 && ROWS_E % 256 == 0 && DM % 256 == 0 && SEQ % 256 == 0, "shape");

constexpr size_t al4k(size_t x) { return (x + 4095) & ~(size_t)4095; }
constexpr size_t WS_CTL = 0, CTL_BYTES = 1u << 20;
constexpr size_t WS_ROPE = WS_CTL + CTL_BYTES;
constexpr size_t WS_AFF = WS_ROPE + al4k((size_t)M * 16 * 4);
constexpr size_t WS_IDX = WS_AFF + al4k((size_t)BATCH * NEXP * SEQ * 4);
constexpr size_t WS_GATEV = WS_IDX + al4k((size_t)MR * 4);
constexpr size_t WS_INV = WS_GATEV + al4k((size_t)MR * 4);
constexpr size_t WS_DEN = WS_INV + al4k((size_t)M * NEXP * 4);
constexpr size_t WS_GAM = WS_DEN + al4k((size_t)3 * M * BH * 4);
constexpr size_t WS_XPART = WS_GAM + al4k((size_t)NCHAIN * NCH * 4);
constexpr size_t WS_EPART = WS_XPART + al4k((size_t)M * 16 * 4);
constexpr size_t WS_RSTD = WS_EPART + al4k((size_t)M * 16 * 4);
constexpr size_t WS_RSROW = WS_RSTD + al4k((size_t)2 * M * 4);
constexpr size_t WS_PB = WS_RSROW + al4k((size_t)MR * 4);
constexpr size_t WS_WS16 = WS_PB + al4k((size_t)M * PLE * 2);
constexpr size_t WS_WIN = WS_WS16 + al4k((size_t)GG * 128 * 128 * 2);
constexpr size_t WS_WOUT = WS_WIN + al4k((size_t)INWP * DM * 2);
constexpr size_t WS_WGU = WS_WOUT + al4k((size_t)DM * DM * 2);
constexpr size_t WS_WD = WS_WGU + al4k((size_t)NEXP * 2 * DE * DM * 2);
constexpr size_t WS_WPLE = WS_WD + al4k((size_t)NEXP * DM * DE * 2);
constexpr size_t WS_WPG = WS_WPLE + al4k((size_t)DM * PLE * 2);
constexpr size_t WS_XB = WS_WPG + 2 * al4k((size_t)DM * DM * 2);
constexpr size_t WS_ACT = WS_XB + 2 * al4k((size_t)M * DM * 2);
constexpr size_t WS_BIG = WS_ACT + al4k((size_t)M * DM * 2);
constexpr size_t WS_PROJ = WS_BIG;
constexpr size_t WS_QN = WS_PROJ + al4k((size_t)M * INWP * 2);
constexpr size_t WS_KN = WS_QN + al4k((size_t)M * BW * 2);
constexpr size_t WS_VT = WS_KN + al4k((size_t)M * BW * 2);
constexpr size_t VT_STRIDE = al4k((size_t)M * BW * 2);
constexpr size_t WS_NUM = WS_VT + 3 * VT_STRIDE;
constexpr size_t WS_REC = WS_NUM + 3 * VT_STRIDE;
constexpr size_t WS_OF = WS_REC + al4k((size_t)NCHAIN * NCH * RECB);
constexpr size_t WS_MIXEND = WS_OF + al4k((size_t)2 * M * CW * 2);
constexpr size_t WS_XE = WS_BIG;
constexpr size_t WS_HID = WS_XE + al4k((size_t)MR * DM * 2);
constexpr size_t WS_YE = WS_HID + al4k((size_t)MR * DE * 2);
constexpr size_t WS_ERAW = WS_YE + al4k((size_t)MR * DM * 2);
constexpr size_t WS_MOEEND = WS_ERAW + al4k((size_t)M * DM * 2);
constexpr size_t WS_END = WS_MIXEND > WS_MOEEND ? WS_MIXEND : WS_MOEEND;
#ifndef CFG_SMALL
static_assert(WS_END <= ((size_t)1 << 30), "workspace must fit 1 GiB");
#endif

DEV float bf2f(bf16_t b) { unsigned u = ((unsigned)b) << 16; return __builtin_bit_cast(float, u); }
#ifndef HOST_EMU
typedef __bf16 hwbf16x2 __attribute__((ext_vector_type(2)));
typedef float hwf32x2 __attribute__((ext_vector_type(2)));
DEV unsigned pk2(float lo, float hi) { return __builtin_bit_cast(unsigned, __builtin_convertvector((hwf32x2){lo, hi}, hwbf16x2)); }
DEV unsigned f2bf(float f) { return (unsigned)__builtin_bit_cast(unsigned short, (__bf16)f); }
#else
DEV unsigned f2bf(float f) { unsigned u = __builtin_bit_cast(unsigned, f); return (u + 0x7fffu + ((u >> 16) & 1u)) >> 16; }
DEV unsigned pk2(float lo, float hi) { return f2bf(lo) | (f2bf(hi) << 16); }
#endif
DEV float lo16(unsigned w) { return __builtin_bit_cast(float, w << 16); }
DEV float hi16(unsigned w) { return __builtin_bit_cast(float, w & 0xffff0000u); }
#ifndef HOST_EMU
DEV f32x4 mfma16(bf16x8 a, bf16x8 b, f32x4 c) { return __builtin_amdgcn_mfma_f32_16x16x32_bf16(a, b, c, 0, 0, 0); }
DEV f32x16 mfma32(bf16x8 a, bf16x8 b, f32x16 c) { return __builtin_amdgcn_mfma_f32_32x32x16_bf16(a, b, c, 0, 0, 0); }
DEV float shx(float v, int m) { return __shfl_xor(v, m); }
DEV unsigned shup(unsigned v, int d) { return __shfl_up(v, d); }
DEV int shfl_i(int v, int src) { return __shfl(v, src); }
DEV unsigned long long ballot_(bool p) { return __ballot(p); }
DEV void bsync() { __syncthreads(); }
DEV void wsync() { __builtin_amdgcn_wave_barrier(); }
DEV void rawbar() { __builtin_amdgcn_s_barrier(); }
DEV void glds16(const void* g, LAS void* l) { __builtin_amdgcn_global_load_lds((const unsigned*)g, (LAS unsigned*)l, 16, 0, 0); }
DEV float fexp(float x) { return __expf(x); }
DEV float flog(float x) { return __logf(x); }
DEV float frsqrt(float x) { return rsqrtf(x); }
DEV float frcp(float x) { return __builtin_amdgcn_rcpf(x); }
DEV int rfl(int v) { return __builtin_amdgcn_readfirstlane(v); }
#define SETPRIO(n) __builtin_amdgcn_s_setprio(n)
#define SCHEDB() __builtin_amdgcn_sched_barrier(0)
#else
DEV f32x4 mfma16(bf16x8 a, bf16x8 b, f32x4 c) { return emu_mfma16(a, b, c); }
DEV f32x16 mfma32(bf16x8 a, bf16x8 b, f32x16 c) { return emu_mfma32(a, b, c); }
DEV float shx(float v, int m) { return emu_shfl_xor(v, m); }
DEV unsigned shup(unsigned v, int d) { return emu_shfl_up(v, d); }
DEV int shfl_i(int v, int src) { return emu_shfl(v, src); }
DEV unsigned long long ballot_(bool p) { return emu_ballot(p ? 1 : 0); }
DEV void bsync() { emu::block_barrier(); }
DEV void wsync() { int d = 0, all[64]; emu::wave_all(d, all); }
DEV void rawbar() { emu::block_barrier(); }
DEV void glds16(const void* g, void* l) { memcpy((char*)l + (threadIdx.x & 63) * 16, g, 16); }
DEV float fexp(float x) { return expf(x); }
DEV float flog(float x) { return logf(x); }
DEV float frsqrt(float x) { return 1.0f / sqrtf(x); }
DEV float frcp(float x) { return 1.0f / x; }
DEV int rfl(int v) { return v; }
#define SETPRIO(n) do {} while (0)
#define SCHEDB() do {} while (0)
#endif
DEV float wave_sum(float v) {
#pragma unroll
    for (int o = 1; o < 64; o <<= 1) v += shx(v, o);
    return v;
}
DEV float wave_max(float v) {
#pragma unroll
    for (int o = 1; o < 64; o <<= 1) v = fmaxf(v, shx(v, o));
    return v;
}
DEV float gelu_tanh(float x) { const float y = 0.7978845608028654f * (x + 0.044715f * x * x * x); const float e = fexp(2.0f * y); return 0.5f * x * (2.0f - 2.0f * frcp(e + 1.0f)); }
DEV float sigmoidf_(float x) { return frcp(1.0f + fexp(-x)); }
DEV float siluf_(float x) { return x * sigmoidf_(x); }
DEV float softplusf_(float x) { return x > 20.f ? x : flog(1.0f + fexp(x)); }
DEV void unpack8(u32x4 r, float* v) { v[0] = lo16(r.x); v[1] = hi16(r.x); v[2] = lo16(r.y); v[3] = hi16(r.y); v[4] = lo16(r.z); v[5] = hi16(r.z); v[6] = lo16(r.w); v[7] = hi16(r.w); }
DEV u32x4 pack8(const float* v) { u32x4 r; r.x = pk2(v[0], v[1]); r.y = pk2(v[2], v[3]); r.z = pk2(v[4], v[5]); r.w = pk2(v[6], v[7]); return r; }

namespace pg8 {
constexpr int BM = 256, BK = 64, HALF = 128, HTB = HALF * BK * 2, STAGE_BYTES = 8 * HTB, NXCD = 8, WGM = 8;
DEV int lds_byte(int r, int c) { const int st = (r >> 4) * 2 + (c >> 5), rr = r & 15, cc = c & 31, ob = rr * 64 + cc * 2; return st * 1024 + (ob ^ (((ob >> 9) & 1) << 5)); }
DEV void stage_rc(int b, int& R, int& C) { const int st = b / 1024, sb = b % 1024, swz = sb ^ (((sb >> 9) & 1) << 5); R = (st >> 1) * 16 + swz / 64; C = (st & 1) * 32 + (swz % 64) / 2; }
DEV int perm32(int rho) { const int n = rho >> 4, i = rho & 15; return 8 * (i >> 2) + 4 * n + (i & 3); }
struct Unit { int pm, pn; };
struct Gemm { const bf16_t* A; const bf16_t* Bt; int M, N, K; int grp_tiles; size_t grp_stride; const int* gidx; };
struct StaticOrder {
    int nM, nN, nwg, G, c;
    DEVM void init(int M_, int N_, int G_, int c_) { nM = M_ / BM; nN = N_ / BM; nwg = nM * nN; G = G_; c = c_; }
    DEVM bool next(int i, Unit& u) const {
        const long L = (long)i * G + c; if (L >= nwg) return false;
        int wgid = (int)L; { const int q = nwg / NXCD, r = nwg % NXCD, xcd = wgid % NXCD, off = wgid / NXCD; wgid = (xcd < r ? xcd * (q + 1) : r * (q + 1) + (xcd - r) * q) + off; }
        const int nig = WGM * nN, gid = wgid / nig, fm = gid * WGM, gsz = (nM - fm) < WGM ? (nM - fm) : WGM;
        u.pm = fm + ((wgid % nig) % gsz); u.pn = (wgid % nig) / gsz; return true;
    }
};
template <class Epi, bool GATHER = false>
DEV void gemm_phase(LAS unsigned char* lds, const Gemm g, const StaticOrder& S, const Epi& E, const int tid) {
    const int wid = rfl(tid >> 6), lane = tid & 63, wr = wid >> 2, wc = wid & 3, fr = lane & 15, fq = lane >> 4;
    const int K = g.K, nt = K / BK;
    unsigned voffA[2], voffB[2]; int rowA[2], colA2[2];
#pragma unroll
    for (int i = 0; i < 2; ++i) { int R, C; stage_rc(tid * 16 + i * 8192, R, C); const int Rb = Epi::PERM ? ((R & ~31) + perm32(R & 31)) : R;
        voffA[i] = (unsigned)(R * K + C) * 2u; voffB[i] = (unsigned)(Rb * K + C) * 2u; rowA[i] = R; colA2[i] = C * 2; }
    unsigned cro[2][2], nro[2][2];
#define PG8_ROFF(dst, u) do { _Pragma("unroll") for (int _h = 0; _h < 2; ++_h) _Pragma("unroll") for (int _i = 0; _i < 2; ++_i) { const int _r = (u).pm * BM + _h * HALF + rowA[_i]; \
        dst[_h][_i] = (unsigned)(((_r / CAP) % BATCH) * SEQ + g.gidx[_r]) * (unsigned)(K * 2) + (unsigned)colA2[_i]; } } while (0)
    const size_t kstep = (size_t)(BK * 2);
    const size_t hstep = (size_t)HALF * K * 2;
    const size_t tstep = 2 * hstep;
    const unsigned ldsw = (unsigned)wid * 1024u;
    const int aoff = lds_byte(wr * 64 + fr, fq * 8), boff = lds_byte(wc * 32 + fr, fq * 8);
#define PG8_SA(b, h) (((b) * 2 + (h)) * HTB)
#define PG8_SB(b, h) ((4 + (b) * 2 + (h)) * HTB)
#define PG8_STAGE(bufoff, gbase, voff) do { _Pragma("unroll") for (int _i = 0; _i < 2; ++_i) \
        glds16((const char*)(gbase) + (voff)[_i], lds + (bufoff) + ldsw + _i * 8192); } while (0)
#define PG8_STAGE_A(bufoff, ubase, kofs, h, ro) do { if (GATHER) { PG8_STAGE(bufoff, (const char*)g.A + (kofs), (ro)[h]); } else { PG8_STAGE(bufoff, (ubase) + (h) * hstep + (kofs), voffA); } } while (0)
#define PG8_LDA(dst, b, h) do { _Pragma("unroll") for (int m = 0; m < 4; ++m) _Pragma("unroll") for (int k = 0; k < 2; ++k) dst[m][k] = *(const LAS bf16x8*)(lds + PG8_SA(b, h) + aoff + m * 2048 + k * 1024); } while (0)
#define PG8_LDB(dst, b, h) do { _Pragma("unroll") for (int n = 0; n < 2; ++n) _Pragma("unroll") for (int k = 0; k < 2; ++k) dst[n][k] = *(const LAS bf16x8*)(lds + PG8_SB(b, h) + boff + n * 2048 + k * 1024); } while (0)
#define PG8_MMA(ai, bj, At, Bt) do { SETPRIO(1); _Pragma("unroll") for (int m = 0; m < 4; ++m) _Pragma("unroll") for (int n = 0; n < 2; ++n) _Pragma("unroll") for (int k = 0; k < 2; ++k) \
        acc[ai][bj][m][n] = mfma16(Bt[n][k], At[m][k], acc[ai][bj][m][n]); SETPRIO(0); } while (0)
#define PG8_WAIT_V(n) ASMV("s_waitcnt vmcnt(" #n ")" ::: "memory")
#define PG8_WAIT_L(n) ASMV("s_waitcnt lgkmcnt(" #n ")" ::: "memory")
#define PG8_BAR rawbar()
#define PG8_SCHED SCHEDB()
#define PG8_BBASE(u) ((const char*)g.Bt + (g.grp_tiles ? (size_t)((u).pm / g.grp_tiles) * g.grp_stride : (size_t)0) + (size_t)(u).pn * tstep)
    Unit cur, nxt; int ui = 0;
    if (!S.next(0, cur)) return;
    f32x4 acc[2][2][4][2];
#pragma unroll
    for (int a = 0; a < 2; ++a)
#pragma unroll
        for (int b = 0; b < 2; ++b)
#pragma unroll
            for (int m = 0; m < 4; ++m)
#pragma unroll
                for (int n = 0; n < 2; ++n) acc[a][b][m][n] = (f32x4){0.f, 0.f, 0.f, 0.f};
    bf16x8 At[4][2], B0[2][2], B1[2][2];
    const char* cA = (const char*)g.A + (size_t)cur.pm * tstep; const char* cB = PG8_BBASE(cur);
    if (GATHER) { PG8_ROFF(cro, cur); PG8_ROFF(nro, cur); }
    const int krot = (2 * (S.c & 7)) & (nt - 1);
#define PG8_KO(kt) ((size_t)(((kt) + krot) & (nt - 1)) * kstep)
    const size_t kb0 = PG8_KO(0);
    PG8_STAGE(PG8_SB(0, 0), cB + kb0, voffB); PG8_STAGE(PG8_SB(0, 1), cB + hstep + kb0, voffB); PG8_STAGE_A(PG8_SA(0, 0), cA, kb0, 0, cro); PG8_STAGE_A(PG8_SA(0, 1), cA, kb0, 1, cro);
    if (wr == 1) PG8_BAR;
    PG8_WAIT_V(2); PG8_BAR;
    PG8_STAGE(PG8_SB(1, 0), cB + kb0 + kstep, voffB); PG8_STAGE_A(PG8_SA(1, 0), cA, kb0 + kstep, 0, cro); PG8_STAGE(PG8_SB(1, 1), cB + hstep + kb0 + kstep, voffB);
    PG8_WAIT_V(6); PG8_BAR;
    for (;;) {
        const bool has_next = S.next(ui + 1, nxt);
        const char* nA = has_next ? (const char*)g.A + (size_t)nxt.pm * tstep : cA; const char* nB = has_next ? PG8_BBASE(nxt) : cB;
        if (GATHER && has_next) PG8_ROFF(nro, nxt);
        for (int t = 0; t < nt; t += 2) {
            const bool last = (t == nt - 2);
            const size_t k1 = PG8_KO(t) + kstep, k2 = PG8_KO(last ? 0 : t + 2), k3 = k2 + kstep;
            const char* a2u = last ? nA : cA; const char* b2 = (last ? nB : cB) + k2;
            const char* b3 = b2 + kstep;
            unsigned ro2[2][2];
#pragma unroll
            for (int _h = 0; _h < 2; ++_h)
#pragma unroll
                for (int _i = 0; _i < 2; ++_i) ro2[_h][_i] = last ? nro[_h][_i] : cro[_h][_i];
            PG8_LDB(B0, 0, 0); PG8_LDB(B1, 0, 1); PG8_SCHED; PG8_LDA(At, 0, 0); PG8_STAGE_A(PG8_SA(1, 1), cA, k1, 1, cro);
            PG8_WAIT_V(8); PG8_WAIT_L(0); PG8_BAR; PG8_MMA(0, 0, At, B0); PG8_MMA(0, 1, At, B1); PG8_BAR; PG8_SCHED;
            PG8_LDA(At, 0, 1); PG8_STAGE(PG8_SB(0, 0), b2, voffB); PG8_STAGE(PG8_SB(0, 1), b2 + hstep, voffB); PG8_STAGE_A(PG8_SA(0, 0), a2u, k2, 0, ro2);
            PG8_WAIT_V(8); PG8_WAIT_L(0); PG8_BAR; PG8_MMA(1, 0, At, B0); PG8_MMA(1, 1, At, B1); PG8_BAR; PG8_SCHED;
            PG8_LDB(B0, 1, 0); PG8_LDB(B1, 1, 1); PG8_SCHED; PG8_LDA(At, 1, 0); PG8_STAGE_A(PG8_SA(0, 1), a2u, k2, 1, ro2);
            PG8_WAIT_V(8); PG8_WAIT_L(0); PG8_BAR; PG8_MMA(0, 0, At, B0); PG8_MMA(0, 1, At, B1); PG8_BAR; PG8_SCHED;
            PG8_LDA(At, 1, 1); PG8_STAGE(PG8_SB(1, 0), b3, voffB); PG8_STAGE(PG8_SB(1, 1), b3 + hstep, voffB); PG8_STAGE_A(PG8_SA(1, 0), a2u, k3, 0, ro2);
            PG8_WAIT_V(8); PG8_WAIT_L(0); PG8_BAR; PG8_MMA(1, 0, At, B0); PG8_MMA(1, 1, At, B1); PG8_BAR; PG8_SCHED;
        }
        if (wr == 0) PG8_BAR;
        E(acc, cur, wr, wc, fr, fq);
        if (!has_next) break;
#pragma unroll
        for (int a = 0; a < 2; ++a)
#pragma unroll
            for (int b = 0; b < 2; ++b)
#pragma unroll
                for (int m = 0; m < 4; ++m)
#pragma unroll
                    for (int n = 0; n < 2; ++n) acc[a][b][m][n] = (f32x4){0.f, 0.f, 0.f, 0.f};
        cur = nxt; cA = nA; cB = nB; ++ui;
        if (wr == 1) PG8_BAR;
        if (GATHER) {
#pragma unroll
            for (int _h = 0; _h < 2; ++_h)
#pragma unroll
                for (int _i = 0; _i < 2; ++_i) cro[_h][_i] = nro[_h][_i]; }
    }
    PG8_WAIT_V(0);
    PG8_BAR;
#undef PG8_SA
#undef PG8_SB
#undef PG8_STAGE
#undef PG8_STAGE_A
#undef PG8_ROFF
#undef PG8_LDA
#undef PG8_LDB
#undef PG8_MMA
#undef PG8_WAIT_V
#undef PG8_WAIT_L
#undef PG8_BAR
#undef PG8_SCHED
#undef PG8_BBASE
#undef PG8_KO
}
constexpr int NPART = 16;
DEV float part_rstd(const float* part, int row, float inv_n, int fq) {
    const f32x4 a = *((const f32x4*)(part + (size_t)row * NPART) + fq);
    float s = (a[0] + a[1]) + (a[2] + a[3]);
    s += shx(s, 16); s += shx(s, 32);
    return frsqrt(s * inv_n + NORM_EPS);
}
struct EpiBf16 {
    static constexpr bool PERM = true;
    bf16_t* O; int ldc; const float* rs_part; float rs_inv_n; float* out_part;
    DEVM void operator()(const f32x4 (&acc)[2][2][4][2], const Unit& u, int wr, int wc, int fr, int fq) const {
        const int row0 = u.pm * BM + wr * 64 + fr, col0 = u.pn * BM + wc * 32 + 8 * fq;
#pragma unroll
        for (int ai = 0; ai < 2; ++ai)
#pragma unroll
            for (int m = 0; m < 4; ++m) { const int row = row0 + ai * HALF + m * 16; bf16_t* rowp = O + (size_t)row * ldc + col0;
                const float rs = rs_part ? part_rstd(rs_part, row, rs_inv_n, fq) : 1.0f; float ss = 0.f;
#pragma unroll
                for (int bj = 0; bj < 2; ++bj) { const f32x4 v0 = acc[ai][bj][m][0] * rs, v1 = acc[ai][bj][m][1] * rs;
                    ss += ((v0[0] * v0[0] + v0[1] * v0[1]) + (v0[2] * v0[2] + v0[3] * v0[3])) + ((v1[0] * v1[0] + v1[1] * v1[1]) + (v1[2] * v1[2] + v1[3] * v1[3]));
                    u32x4 w; w.x = pk2(v0[0], v0[1]); w.y = pk2(v0[2], v0[3]); w.z = pk2(v1[0], v1[1]); w.w = pk2(v1[2], v1[3]);
                    *(u32x4*)(rowp + bj * HALF) = w; }
                if (out_part) { ss += shx(ss, 16); ss += shx(ss, 32); if (fq == 0) out_part[(size_t)row * NPART + u.pn * 4 + wc] = ss; } }
    }
};
struct EpiResB {
    static constexpr bool PERM = true;
    const bf16_t* res; bf16_t* out; int ldc;
    DEVM void operator()(const f32x4 (&acc)[2][2][4][2], const Unit& u, int wr, int wc, int fr, int fq) const {
        const int row0 = u.pm * BM + wr * 64 + fr, col0 = u.pn * BM + wc * 32 + 8 * fq;
#pragma unroll
        for (int ai = 0; ai < 2; ++ai) {
            u32x4 r[4][2];
#pragma unroll
            for (int m = 0; m < 4; ++m) { const size_t off = (size_t)(row0 + ai * HALF + m * 16) * ldc + col0;
#pragma unroll
                for (int bj = 0; bj < 2; ++bj) r[m][bj] = *(const u32x4*)(res + off + bj * HALF); }
#pragma unroll
            for (int m = 0; m < 4; ++m) { const size_t off = (size_t)(row0 + ai * HALF + m * 16) * ldc + col0;
#pragma unroll
                for (int bj = 0; bj < 2; ++bj) { const f32x4 a0 = acc[ai][bj][m][0], a1 = acc[ai][bj][m][1]; const u32x4 y = r[m][bj];
                    u32x4 o; o.x = pk2(lo16(y.x) + a0[0], hi16(y.x) + a0[1]); o.y = pk2(lo16(y.y) + a0[2], hi16(y.y) + a0[3]); o.z = pk2(lo16(y.z) + a1[0], hi16(y.z) + a1[1]); o.w = pk2(lo16(y.w) + a1[2], hi16(y.w) + a1[3]);
                    *(u32x4*)(out + off + bj * HALF) = o; } }
        }
    }
};
struct EpiSwiGLU {
    static constexpr bool PERM = true;
    bf16_t* O; int ldc; const float* rstd;
    DEVM void operator()(const f32x4 (&acc)[2][2][4][2], const Unit& u, int wr, int wc, int fr, int fq) const {
        const int row0 = u.pm * BM + wr * 64 + fr, col0 = u.pn * HALF + wc * 32 + 8 * fq;
        float rs[2][4];
#pragma unroll
        for (int ai = 0; ai < 2; ++ai)
#pragma unroll
            for (int m = 0; m < 4; ++m) rs[ai][m] = 1.0f;
#pragma unroll
        for (int ai = 0; ai < 2; ++ai)
#pragma unroll
            for (int m = 0; m < 4; ++m) { bf16_t* rowp = O + (size_t)(row0 + ai * HALF + m * 16) * ldc + col0;
                float h[8];
#pragma unroll
                for (int n = 0; n < 2; ++n)
#pragma unroll
                    for (int i = 0; i < 4; ++i) { const float gt = acc[ai][0][m][n][i] * rs[ai][m], up = acc[ai][1][m][n][i] * rs[ai][m]; h[n * 4 + i] = siluf_(gt) * up; }
                *(u32x4*)rowp = pack8(h); }
    }
};
struct EpiScaleBf16 {
    static constexpr bool PERM = true;
    bf16_t* O; int ldc; const float* rowscale;
    DEVM void operator()(const f32x4 (&acc)[2][2][4][2], const Unit& u, int wr, int wc, int fr, int fq) const {
        const int row0 = u.pm * BM + wr * 64 + fr, col0 = u.pn * BM + wc * 32 + 8 * fq;
#pragma unroll
        for (int ai = 0; ai < 2; ++ai)
#pragma unroll
            for (int m = 0; m < 4; ++m) { const int row = row0 + ai * HALF + m * 16; const float sc = rowscale[row]; bf16_t* rowp = O + (size_t)row * ldc + col0;
#pragma unroll
                for (int bj = 0; bj < 2; ++bj) { const f32x4 v0 = acc[ai][bj][m][0] * sc, v1 = acc[ai][bj][m][1] * sc;
                    u32x4 w; w.x = pk2(v0[0], v0[1]); w.y = pk2(v0[2], v0[3]); w.z = pk2(v1[0], v1[1]); w.w = pk2(v1[2], v1[3]);
                    *(u32x4*)(rowp + bj * HALF) = w; } }
    }
};
struct EpiPleGate {
    static constexpr bool PERM = true;
    const bf16_t* x; bf16_t* xo; const bf16_t* eraw; const float* epart; const float* gple; float* xpart; float* outf; int ldc; const float* rstd;
    DEVM void operator()(const f32x4 (&acc)[2][2][4][2], const Unit& u, int wr, int wc, int fr, int fq) const {
        const int row0 = u.pm * BM + wr * 64 + fr, col0 = u.pn * BM + wc * 32 + 8 * fq;
        f32x4 gp[2][2];
#pragma unroll
        for (int bj = 0; bj < 2; ++bj)
#pragma unroll
            for (int n = 0; n < 2; ++n) gp[bj][n] = *(const f32x4*)(gple + col0 + bj * HALF + n * 4);
#pragma unroll
        for (int ai = 0; ai < 2; ++ai)
#pragma unroll
            for (int mp = 0; mp < 2; ++mp) {
                u32x4 r[2][2], e2[2][2]; float ers[2], xrs[2];
#pragma unroll
                for (int mm = 0; mm < 2; ++mm) { const int row = row0 + ai * HALF + (2 * mp + mm) * 16; const size_t off = (size_t)row * ldc + col0;
                    ers[mm] = part_rstd(epart, row, 1.0f / DM, fq); xrs[mm] = rstd[row];
#pragma unroll
                    for (int bj = 0; bj < 2; ++bj) { r[mm][bj] = *(const u32x4*)(x + off + bj * HALF); e2[mm][bj] = *(const u32x4*)(eraw + off + bj * HALF); } }
                f32x4 wv[2][2][2];
#pragma unroll
                for (int mm = 0; mm < 2; ++mm) { float ss = 0.f; const int row = row0 + ai * HALF + (2 * mp + mm) * 16;
#pragma unroll
                    for (int bj = 0; bj < 2; ++bj)
#pragma unroll
                        for (int n = 0; n < 2; ++n) { const f32x4 a = acc[ai][bj][2 * mp + mm][n] * xrs[mm]; const f32x4 g = gp[bj][n] * ers[mm];
                            const unsigned r0 = n ? r[mm][bj].z : r[mm][bj].x, r1 = n ? r[mm][bj].w : r[mm][bj].y, e0 = n ? e2[mm][bj].z : e2[mm][bj].x, e1 = n ? e2[mm][bj].w : e2[mm][bj].y;
                            f32x4 w; w[0] = lo16(r0) + lo16(e0) * g[0] * sigmoidf_(a[0]); w[1] = hi16(r0) + hi16(e0) * g[1] * sigmoidf_(a[1]); w[2] = lo16(r1) + lo16(e1) * g[2] * sigmoidf_(a[2]); w[3] = hi16(r1) + hi16(e1) * g[3] * sigmoidf_(a[3]);
                            ss += (w[0] * w[0] + w[1] * w[1]) + (w[2] * w[2] + w[3] * w[3]); wv[mm][bj][n] = w; }
                    ss += shx(ss, 16); ss += shx(ss, 32); if (!outf && fq == 0) xpart[(size_t)row * NPART + u.pn * 4 + wc] = ss; }
                if (outf) {
#pragma unroll
                    for (int mm = 0; mm < 2; ++mm) { const size_t off = (size_t)(row0 + ai * HALF + (2 * mp + mm) * 16) * ldc + col0;
#pragma unroll
                        for (int bj = 0; bj < 2; ++bj)
#pragma unroll
                            for (int n = 0; n < 2; ++n) *(f32x4*)(outf + off + bj * HALF + n * 4) = wv[mm][bj][n]; }
                } else {
#pragma unroll
                    for (int mm = 0; mm < 2; ++mm) { const size_t off = (size_t)(row0 + ai * HALF + (2 * mp + mm) * 16) * ldc + col0;
#pragma unroll
                        for (int bj = 0; bj < 2; ++bj) { const f32x4 w0 = wv[mm][bj][0], w1 = wv[mm][bj][1]; u32x4 o; o.x = pk2(w0[0], w0[1]); o.y = pk2(w0[2], w0[3]); o.z = pk2(w1[0], w1[1]); o.w = pk2(w1[2], w1[3]); *(u32x4*)(xo + off + bj * HALF) = o; } }
                }
            }
    }
};
}

#ifndef HOST_EMU
#define XB_TMO      128
#define XB_XCNT(j)  (256  + 64 * (j))
#define XB_XSUB(j)  (1280 + 64 * (j))
#define XB_XGEN(j)  (2304 + 64 * (j))
#define XB_TOP      3328
#define XB_TOPGEN   3392
#define XCD_BAR_WORDS 3456
#define XB_SPIN_CAP (1u << 22)
__device__ __forceinline__ unsigned xb_ld(unsigned* p)              { return __hip_atomic_load(p, __ATOMIC_RELAXED, __HIP_MEMORY_SCOPE_AGENT); }
__device__ __forceinline__ unsigned xb_add(unsigned* p, unsigned v) { return __hip_atomic_fetch_add(p, v, __ATOMIC_RELAXED, __HIP_MEMORY_SCOPE_AGENT); }
__device__ __forceinline__ unsigned xb_xcc_id() { return (unsigned)__builtin_amdgcn_s_getreg((3 << 11) | 20) & 0xFu; }
#define XB_SPIN(cond, bar) do { unsigned _sp = 0; while (cond) { __builtin_amdgcn_s_sleep(1); \
    if ((++_sp & 255u) == 0u) { if (xb_ld(&(bar)[XB_TMO])) break; if (_sp > XB_SPIN_CAP) { atomicAdd(&(bar)[XB_TMO], 1u); break; } } } } while (0)
struct XcdBarrier { unsigned* bar; unsigned x; volatile LAS unsigned* st; };
__device__ __forceinline__ XcdBarrier xcd_barrier_post(unsigned* bar, volatile LAS unsigned* st) {
    XcdBarrier b; b.bar = bar; b.x = xb_xcc_id(); b.st = st;
    if (threadIdx.x == 0) (void)xb_add(&bar[XB_XCNT(b.x)], 1u);
    return b;
}
__device__ __forceinline__ void xcd_barrier_complete(unsigned* bar, unsigned x, unsigned& nloc, unsigned& nx) {
    const unsigned G = gridDim.x * gridDim.y * gridDim.z;
    unsigned sum, cnt, mine, sp = 0u;
    for (;;) {
        sum = 0u; cnt = 0u; mine = 0u;
#pragma unroll
        for (unsigned j = 0; j < 16; ++j) { const unsigned c = xb_ld(&bar[XB_XCNT(j)]); sum += c; cnt += (c > 0u) ? 1u : 0u; mine = (j == x) ? c : mine; }
        if (sum == G) break;
        __builtin_amdgcn_s_sleep(1);
        if ((++sp & 255u) == 0u) { if (xb_ld(&bar[XB_TMO])) break; if (sp > XB_SPIN_CAP) { atomicAdd(&bar[XB_TMO], 1u); break; } }
    }
    nloc = mine > 0u ? mine : 1u; nx = cnt > 0u ? cnt : 1u;
}
__device__ __forceinline__ void xcd_barrier(const XcdBarrier& b) {
    asm volatile("s_waitcnt vmcnt(0)" ::: "memory");
    __syncthreads();
    if (threadIdx.x == 0) {
        unsigned* bar = b.bar;
        __builtin_amdgcn_s_waitcnt(0);
        unsigned nloc = b.st[0], nx = b.st[1];
        if (nloc == 0u) { xcd_barrier_complete(bar, b.x, nloc, nx); b.st[0] = nloc; b.st[1] = nx; }
        const unsigned old = xb_add(&bar[XB_XSUB(b.x)], 1u);
        const unsigned gen = old / nloc;
        if (old + 1u == (gen + 1u) * nloc) {
            __builtin_amdgcn_fence(__ATOMIC_RELEASE, "agent");
            asm volatile("s_waitcnt vmcnt(0)" ::: "memory");
            const unsigned og = xb_add(&bar[XB_TOP], 1u);
            const unsigned tg = og / nx;
            if (og + 1u == (tg + 1u) * nx) xb_add(&bar[XB_TOPGEN], 1u);
            else XB_SPIN(xb_ld(&bar[XB_TOPGEN]) == tg, bar);
            __builtin_amdgcn_fence(__ATOMIC_ACQUIRE, "agent");
            xb_add(&bar[XB_XGEN(b.x)], 1u);
            asm volatile("s_waitcnt vmcnt(0)" ::: "memory");
        } else {
            XB_SPIN(xb_ld(&bar[XB_XGEN(b.x)]) == gen, bar);
            __builtin_amdgcn_fence(__ATOMIC_ACQUIRE, "agent");
            asm volatile("s_waitcnt vmcnt(0)" ::: "memory");
        }
    }
    __syncthreads();
}
#endif

constexpr int LDS_STAGE = 131072;
constexpr int LDS_MISC = 144384;
constexpr int LDS_BYTES = 147456;
struct Args { const void* in[25]; float* out; unsigned char* ws; int ph_lo, ph_hi; };
struct Frame {
    LAS unsigned char* lds;
    int tid, lane, wave, G, wg;
    const Args* a;
    DEVM const float* x() const { return (const float*)a->in[0]; }
    DEVM const float* p() const { return (const float*)a->in[1]; }
    DEVM const int* pos() const { return (const int*)a->in[2]; }
    DEVM const float* g_mix() const { return (const float*)a->in[3]; }
    DEVM const float* w_in() const { return (const float*)a->in[4]; }
    DEVM const float* ln_v_g() const { return (const float*)a->in[5]; }
    DEVM const float* ln_v_b() const { return (const float*)a->in[6]; }
    DEVM const float* w_s() const { return (const float*)a->in[7]; }
    DEVM const float* b_s() const { return (const float*)a->in[8]; }
    DEVM const float* q_norm_g() const { return (const float*)a->in[9]; }
    DEVM const float* k_norm_g() const { return (const float*)a->in[10]; }
    DEVM const float* conv_w() const { return (const float*)a->in[11]; }
    DEVM const float* a_log() const { return (const float*)a->in[12]; }
    DEVM const float* dt_bias() const { return (const float*)a->in[13]; }
    DEVM const float* o_norm_g() const { return (const float*)a->in[14]; }
    DEVM const float* w_out() const { return (const float*)a->in[15]; }
    DEVM const float* g_ffn() const { return (const float*)a->in[16]; }
    DEVM const float* w_router() const { return (const float*)a->in[17]; }
    DEVM const float* w_e_gate() const { return (const float*)a->in[18]; }
    DEVM const float* w_e_up() const { return (const float*)a->in[19]; }
    DEVM const float* w_e_down() const { return (const float*)a->in[20]; }
    DEVM const float* w_ple() const { return (const float*)a->in[21]; }
    DEVM const float* g_ple() const { return (const float*)a->in[22]; }
    DEVM const float* g_ple_gate() const { return (const float*)a->in[23]; }
    DEVM const float* w_ple_gate() const { return (const float*)a->in[24]; }
    DEVM float* out() const { return a->out; }
    DEVM unsigned char* ws() const { return a->ws; }
    DEVM float* ROPE() const { return (float*)(a->ws + WS_ROPE); }
    DEVM float* AFF() const { return (float*)(a->ws + WS_AFF); }
    DEVM float* GATEV() const { return (float*)(a->ws + WS_GATEV); }
    DEVM float* DEN() const { return (float*)(a->ws + WS_DEN); }
    DEVM float* GAM() const { return (float*)(a->ws + WS_GAM); }
    DEVM float* XPART() const { return (float*)(a->ws + WS_XPART); }
    DEVM float* EPART() const { return (float*)(a->ws + WS_EPART); }
    DEVM float* RSTD() const { return (float*)(a->ws + WS_RSTD); }
    DEVM float* RSROW() const { return (float*)(a->ws + WS_RSROW); }
    DEVM int* IDX() const { return (int*)(a->ws + WS_IDX); }
    DEVM int* INV() const { return (int*)(a->ws + WS_INV); }
    DEVM bf16_t* PB() const { return (bf16_t*)(a->ws + WS_PB); }
    DEVM bf16_t* WS16() const { return (bf16_t*)(a->ws + WS_WS16); }
    DEVM bf16_t* WIN() const { return (bf16_t*)(a->ws + WS_WIN); }
    DEVM bf16_t* WOUT() const { return (bf16_t*)(a->ws + WS_WOUT); }
    DEVM bf16_t* WGU() const { return (bf16_t*)(a->ws + WS_WGU); }
    DEVM bf16_t* WD() const { return (bf16_t*)(a->ws + WS_WD); }
    DEVM bf16_t* WPLE() const { return (bf16_t*)(a->ws + WS_WPLE); }
    DEVM bf16_t* WPG(int L) const { return (bf16_t*)(a->ws + WS_WPG + (size_t)(L & 1) * al4k((size_t)DM * DM * 2)); }
    DEVM bf16_t* ACT() const { return (bf16_t*)(a->ws + WS_ACT); }
    DEVM bf16_t* XB(int L) const { return (bf16_t*)(a->ws + WS_XB + (size_t)(L & 1) * al4k((size_t)M * DM * 2)); }
    DEVM bf16_t* PROJ() const { return (bf16_t*)(a->ws + WS_PROJ); }
    DEVM bf16_t* QN() const { return (bf16_t*)(a->ws + WS_QN); }
    DEVM bf16_t* KN() const { return (bf16_t*)(a->ws + WS_KN); }
    DEVM bf16_t* NUM() const { return (bf16_t*)(a->ws + WS_NUM); }
    DEVM bf16_t* OFB() const { return (bf16_t*)(a->ws + WS_OF); }
    DEVM bf16_t* XE() const { return (bf16_t*)(a->ws + WS_XE); }
    DEVM bf16_t* HID() const { return (bf16_t*)(a->ws + WS_HID); }
    DEVM bf16_t* YE() const { return (bf16_t*)(a->ws + WS_YE); }
    DEVM bf16_t* ERAW() const { return (bf16_t*)(a->ws + WS_ERAW); }
    DEVM unsigned char* VT() const { return (unsigned char*)(a->ws + WS_VT); }
    DEVM unsigned char* REC() const { return (unsigned char*)(a->ws + WS_REC); }
};

constexpr int NJ = DM / 256;
DEV void phase_prologue(Frame& F) {
    { const int gw = F.wg * NWAVES + F.wave, NGW = F.G * NWAVES;
      for (int m0 = gw * 4; m0 < M; m0 += NGW * 4) {
        f32x4 v[4][NJ];
#pragma unroll
        for (int r = 0; r < 4; ++r)
#pragma unroll
            for (int j = 0; j < NJ; ++j) v[r][j] = *((const f32x4*)(F.x() + (size_t)(m0 + r) * DM) + F.lane + 64 * j);
#pragma unroll
        for (int r = 0; r < 4; ++r)
#pragma unroll
            for (int j = 0; j < NJ; ++j) { u32x2 o; o.x = pk2(v[r][j][0], v[r][j][1]); o.y = pk2(v[r][j][2], v[r][j][3]); *((u32x2*)(F.XB(0) + (size_t)(m0 + r) * DM) + F.lane + 64 * j) = o; }
#pragma unroll
        for (int r = 0; r < 4; ++r) { float ss = 0.f;
#pragma unroll
            for (int j = 0; j < NJ; ++j) ss += (v[r][j][0] * v[r][j][0] + v[r][j][1] * v[r][j][1]) + (v[r][j][2] * v[r][j][2] + v[r][j][3] * v[r][j][3]);
            ss = wave_sum(ss); if (F.lane < pg8::NPART) F.XPART()[(size_t)(m0 + r) * pg8::NPART + F.lane] = (F.lane == 0) ? ss : 0.f; }
      } }
    for (int i = F.wg * NTHREADS + F.tid; i < M * pg8::NPART; i += F.G * NTHREADS) F.EPART()[i] = 0.f;
    for (int i = F.wg * NTHREADS + F.tid; i < M * 8; i += F.G * NTHREADS) {
        const int tok = i >> 3, k = i & 7;
        const float inv_freq = powf(500000.0f, -(float)k * 0.125f);
        const float ang = (float)F.pos()[tok] * inv_freq;
        F.ROPE()[tok * 16 + k] = cosf(ang); F.ROPE()[tok * 16 + 8 + k] = sinf(ang);
    }
}

DEV void tr_item(const float* W, int K, int N, bf16_t* WT, int ldk, int k0, int n0, int drow0, LAS float* scr, int lane, const float* rowgain = nullptr) {
#pragma unroll 8
    for (int i = 0; i < 32; ++i) { const int kk = 2 * i + (lane >> 5); const int n = n0 + (lane & 31); const float gk = rowgain ? rowgain[k0 + kk] : 1.0f; scr[kk * 33 + (lane & 31)] = (n < N) ? W[(size_t)(k0 + kk) * N + n] * gk : 0.f; }
    ASMV("s_waitcnt lgkmcnt(0)" ::: "memory"); wsync();
    const int c = lane & 7;
#pragma unroll
    for (int j = 0; j < 4; ++j) { const int n = (lane >> 3) + 8 * j; const LAS float* s = scr + (8 * c) * 33 + n;
        u32x4 o; o.x = pk2(s[0 * 33], s[1 * 33]); o.y = pk2(s[2 * 33], s[3 * 33]); o.z = pk2(s[4 * 33], s[5 * 33]); o.w = pk2(s[6 * 33], s[7 * 33]);
        *(u32x4*)(WT + (size_t)(drow0 + n) * ldk + k0 + 8 * c) = o; }
    ASMV("s_waitcnt lgkmcnt(0)" ::: "memory"); wsync();
}
constexpr int PW_I_IN = (DM / 64) * (INWP / 32), PW_I_OUT = (DM / 64) * (DM / 32), PW_I_G = (DM / 64) * (DE / 32), PW_I_D = (DE / 64) * (DM / 32), PW_I_PLE = (PLE / 64) * (DM / 32), PW_I_PG = (DM / 64) * (DM / 32);
DEV void phase_pw(Frame& F, int L, int slot, int nslots) {
    LAS float* scr = (LAS float*)(F.lds + F.wave * 16384);
    const int gw = slot * NWAVES + F.wave, NGW = nslots * NWAVES;
    constexpr int NIT = PW_I_IN + PW_I_OUT + PW_I_PLE + PW_I_PG;
    for (int it = gw; it < NIT; it += NGW) {
        int r = it;
        if (r < PW_I_IN) { const int nb = INWP / 32, kb = r / nb, n0 = (r % nb) * 32; tr_item(F.w_in() + (size_t)L * DM * INW, DM, INW, F.WIN(), DM, kb * 64, n0, n0, scr, F.lane, F.g_mix() + (size_t)L * DM); continue; } r -= PW_I_IN;
        if (r < PW_I_OUT) { const int nb = DM / 32, kb = r / nb, n0 = (r % nb) * 32; tr_item(F.w_out() + (size_t)L * DM * DM, DM, DM, F.WOUT(), DM, kb * 64, n0, n0, scr, F.lane); continue; } r -= PW_I_OUT;
        if (r < PW_I_PLE) { const int nb = DM / 32, kb = r / nb, n0 = (r % nb) * 32; tr_item(F.w_ple() + (size_t)L * PLE * DM, PLE, DM, F.WPLE(), PLE, kb * 64, n0, n0, scr, F.lane); continue; } r -= PW_I_PLE;
        { const int nb = DM / 32, kb = r / nb, n0 = (r % nb) * 32; tr_item(F.w_ple_gate() + (size_t)L * DM * DM, DM, DM, F.WPG(L), DM, kb * 64, n0, n0, scr, F.lane, F.g_ple_gate() + (size_t)L * DM); }
    }
    for (int i = slot * NTHREADS + F.tid; i < GG * 128 * 128 / 4; i += nslots * NTHREADS) {
        const f32x4 v = *(const f32x4*)(F.w_s() + (size_t)L * GG * 128 * 128 + (size_t)i * 4);
        u32x2 o; o.x = pk2(v[0], v[1]); o.y = pk2(v[2], v[3]); *(u32x2*)(F.WS16() + (size_t)i * 4) = o;
    }
}
DEV void pw_experts(Frame& F, int L, int slot_wave, int n_waves) {
    LAS float* scr = (LAS float*)(F.lds + F.wave * 16384);
    constexpr int PER_E = 2 * PW_I_G + PW_I_D;
    for (int it = slot_wave; it < NEXP * PER_E; it += n_waves) {
        const int e = it / PER_E; int q = it % PER_E;
        if (q < 2 * PW_I_G) { const int which = q / PW_I_G; q %= PW_I_G; const int nb = DE / 32, kb = q / nb, n0 = (q % nb) * 32;
            const float* W = (which ? F.w_e_up() : F.w_e_gate()) + ((size_t)L * NEXP + e) * DM * DE;
            tr_item(W, DM, DE, F.WGU() + (size_t)e * 2 * DE * DM, DM, kb * 64, n0, 256 * (n0 / 128) + 128 * which + (n0 % 128), scr, F.lane); }
        else { q -= 2 * PW_I_G; const int nb = DM / 32, kb = q / nb, n0 = (q % nb) * 32;
            tr_item(F.w_e_down() + ((size_t)L * NEXP + e) * DE * DM, DE, DM, F.WD() + (size_t)e * DM * DE, DE, kb * 64, n0, n0, scr, F.lane); }
    }
}

DEV void phase_norm1(Frame& F, int L) {
    const int gw = F.wg * NWAVES + F.wave, NGW = F.G * NWAVES;
    constexpr int R = 4;
    for (int m0 = gw * R; m0 < M; m0 += NGW * R) {
        f32x4 v[R][NJ];
#pragma unroll
        for (int r = 0; r < R; ++r)
#pragma unroll
            for (int j = 0; j < NJ; ++j) { const u32x2 y = *((const u32x2*)(F.XB(L) + (size_t)(m0 + r) * DM) + F.lane + 64 * j); v[r][j] = (f32x4){lo16(y.x), hi16(y.x), lo16(y.y), hi16(y.y)}; }
#pragma unroll
        for (int r = 0; r < R; ++r) {
            float s = 0.f;
#pragma unroll
            for (int j = 0; j < NJ; ++j) s += (v[r][j][0] * v[r][j][0] + v[r][j][1] * v[r][j][1]) + (v[r][j][2] * v[r][j][2] + v[r][j][3] * v[r][j][3]);
            const float rstd = frsqrt(wave_sum(s) * (1.f / DM) + NORM_EPS);
            u32x2* o8 = (u32x2*)(F.ACT() + (size_t)(m0 + r) * DM) + F.lane;
#pragma unroll
            for (int j = 0; j < NJ; ++j) { const f32x4 g = *((const f32x4*)(F.g_mix() + (size_t)L * DM) + F.lane + 64 * j); u32x2 o; o.x = pk2(v[r][j][0] * rstd * g[0], v[r][j][1] * rstd * g[1]); o.y = pk2(v[r][j][2] * rstd * g[2], v[r][j][3] * rstd * g[3]); o8[64 * j] = o; }
        }
    }
}

DEV void gmlp_units(Frame& F, int L) {
    LAS bf16_t* vnT = (LAS bf16_t*)F.lds;
    const int tid = F.tid, lane = F.lane, w = F.wave;
    for (int unit = F.wg; unit < (M / GCH) * GG; unit += F.G) {
        const int g = unit % GG, t0 = (unit / GG) * GCH;
        {
            const int j = tid >> 2, qd = tid & 3;
            const bf16_t* src = F.PROJ() + (size_t)(t0 + j) * INWP + O_AV + g * 64 + qd * 16;
            float v[16]; unpack8(*(const u32x4*)src, v); unpack8(*(const u32x4*)(src + 8), v + 8);
            float s = 0.f;
#pragma unroll
            for (int i = 0; i < 16; ++i) { v[i] = gelu_tanh(v[i]); s += v[i]; }
            s += shx(s, 1); s += shx(s, 2);
            const float mu = s * (1.f / 64.f); float q = 0.f;
#pragma unroll
            for (int i = 0; i < 16; ++i) { v[i] -= mu; q += v[i] * v[i]; }
            q += shx(q, 1); q += shx(q, 2);
            const float rstd = frsqrt(q * (1.f / 64.f) + NORM_EPS);
            const float* lg = F.ln_v_g() + ((size_t)L * GG + g) * 64 + qd * 16; const float* lb = F.ln_v_b() + ((size_t)L * GG + g) * 64 + qd * 16;
#pragma unroll
            for (int i = 0; i < 16; ++i) vnT[(qd * 16 + i) * 136 + j] = (bf16_t)f2bf(v[i] * rstd * lg[i] + lb[i]);
        }
        const int mt = w & 1, nt = w >> 1, r = lane & 31, h = lane >> 5, tok = t0 + nt * 32 + r;
        bf16x8 bw[8]; u32x2 uu[4];
        { const bf16_t* wrow = F.WS16() + ((size_t)g * 128 + nt * 32 + r) * 128;
#pragma unroll
          for (int s = 0; s < 8; ++s) bw[s] = *(const bf16x8*)(wrow + s * 16 + h * 8);
#pragma unroll
          for (int rr = 0; rr < 4; ++rr) uu[rr] = *(const u32x2*)(F.PROJ() + (size_t)tok * INWP + O_AU + g * 64 + mt * 32 + 8 * rr + 4 * h); }
        const float bias = F.b_s()[((size_t)L * GG + g) * 128 + nt * 32 + r];
        bsync();
        {
            f32x16 acc; for (int i = 0; i < 16; ++i) acc[i] = 0.f;
#pragma unroll
            for (int s = 0; s < 8; ++s) {
                const bf16x8 a = *(const LAS bf16x8*)(vnT + (mt * 32 + r) * 136 + s * 16 + h * 8);
                acc = mfma32(a, bw[s], acc);
            }
#pragma unroll
            for (int rr = 0; rr < 4; ++rr) {
                const int d0 = mt * 32 + 8 * rr + 4 * h;
                const u32x2 u2 = uu[rr];
                const float u0 = gelu_tanh(lo16(u2.x)), u1 = gelu_tanh(hi16(u2.x)), u2f = gelu_tanh(lo16(u2.y)), u3 = gelu_tanh(hi16(u2.y));
                u32x2 o; o.x = pk2(u0 * (acc[4 * rr + 0] + bias), u1 * (acc[4 * rr + 1] + bias)); o.y = pk2(u2f * (acc[4 * rr + 2] + bias), u3 * (acc[4 * rr + 3] + bias));
                *(u32x2*)(F.ACT() + (size_t)tok * DM + g * 64 + d0) = o;
            }
        }
        bsync();
    }
}

DEV void attnprep_units(Frame& F, int L) {
    LAS bf16_t* vt = (LAS bf16_t*)F.lds;
    const int tid = F.tid;
    for (int unit = F.wg; unit < BATCH * BH * (SEQ / 256); unit += F.G) {
        const int blk = unit % (SEQ / 256), bh = unit / (SEQ / 256), h = bh % BH, b = bh / BH, tb = blk * 256;
#pragma unroll
        for (int pass = 0; pass < 4; ++pass) {
            const int which = pass >> 1, tl = (pass & 1) * 128 + (tid >> 2), qd = tid & 3, s = tb + tl, tok = b * SEQ + s;
            const bf16_t* src = F.PROJ() + (size_t)tok * INWP + (which ? O_BK : O_BQ) + h * 64 + qd * 16;
            float v[16]; unpack8(*(const u32x4*)src, v); unpack8(*(const u32x4*)(src + 8), v + 8);
            float ss = 0.f;
#pragma unroll
            for (int i = 0; i < 16; ++i) ss += v[i] * v[i];
            ss += shx(ss, 1); ss += shx(ss, 2);
            const float rstd = frsqrt(ss * (1.f / 64.f) + NORM_EPS);
            const float* gn = (which ? F.k_norm_g() : F.q_norm_g()) + (size_t)L * 64 + qd * 16;
#pragma unroll
            for (int i = 0; i < 16; ++i) v[i] = v[i] * rstd * gn[i];
            if (qd == 0) {
                const float* rp = F.ROPE() + (size_t)tok * 16;
#pragma unroll
                for (int i = 0; i < 8; ++i) { const float c = rp[i], sn = rp[8 + i], x1 = v[i], x2 = v[8 + i]; v[i] = x1 * c - x2 * sn; v[8 + i] = x2 * c + x1 * sn; }
            }
            if (which == 0) {
#pragma unroll
                for (int i = 0; i < 16; ++i) v[i] *= 0.125f;
            }
            bf16_t* dst = (which ? F.KN() : F.QN()) + ((size_t)bh * SEQ + s) * 64 + qd * 16;
            *(u32x4*)dst = pack8(v); *(u32x4*)(dst + 8) = pack8(v + 8);
        }
#pragma unroll
        for (int i = 0; i < 4; ++i) { const int id = tid + 512 * i, tl = id >> 3, dc = id & 7;
            const u32x4 r = *(const u32x4*)(F.PROJ() + (size_t)(b * SEQ + tb + tl) * INWP + O_BV + h * 64 + dc * 8);
            const unsigned ww[4] = {r.x, r.y, r.z, r.w};
#pragma unroll
            for (int e = 0; e < 4; ++e) { vt[(dc * 8 + 2 * e) * 264 + tl] = (bf16_t)(ww[e] & 0xffffu); vt[(dc * 8 + 2 * e + 1) * 264 + tl] = (bf16_t)(ww[e] >> 16); } }
        bsync();
#pragma unroll
        for (int p = 0; p < 3; ++p) {
            const int dil = (p == 0) ? 1 : (p == 1 ? 4 : 16), Lp = SEQ / dil, cpr = 32 / dil;
            bf16_t* VTp = (bf16_t*)(F.VT() + (size_t)p * VT_STRIDE);
#pragma unroll
            for (int i = 0; i < 4; ++i) { const int item = tid + 512 * i, d = item >> 5, rc = item & 31, r = rc / cpr, c = rc % cpr;
                unsigned short e8[8];
#pragma unroll
                for (int e = 0; e < 8; ++e) e8[e] = vt[d * 264 + r + dil * (8 * c + e)];
                u32x4 o; o.x = e8[0] | ((unsigned)e8[1] << 16); o.y = e8[2] | ((unsigned)e8[3] << 16); o.z = e8[4] | ((unsigned)e8[5] << 16); o.w = e8[6] | ((unsigned)e8[7] << 16);
                *(u32x4*)(VTp + (((size_t)bh * dil + r) * 64 + d) * Lp + tb / dil + 8 * c) = o; }
        }
        bsync();
    }
}

DEV int perm_pi(int sg) { return 32 * (sg >> 5) + 16 * ((sg & 7) >> 2) + 4 * ((sg >> 3) & 3) + (sg & 3); }
DEV int perm_inv(int a) { return 32 * (a >> 5) + 8 * ((a >> 2) & 3) + 4 * ((a >> 4) & 1) + (a & 3); }
constexpr int G3_QB = 0, G3_KB = 9216, G3_VB = 18432, G3_LM = 27648, G3_TM = 62464, G3_XS = 72704, G3_VEC = 134144;
constexpr int LMP = 68, LMD = 64 * LMP, TMP = 20, TMB = 16 * TMP;
constexpr int G3_CW = 121856;
static_assert(G3_CW + 5 * 3 * CW * 2 <= G3_VEC, "LDS map");
DEV void gdnprep_units(Frame& F, int L) {
    LAS bf16_t* QB = (LAS bf16_t*)(F.lds + G3_QB); LAS bf16_t* KB = (LAS bf16_t*)(F.lds + G3_KB); LAS bf16_t* VB = (LAS bf16_t*)(F.lds + G3_VB);
    LAS float* LM = (LAS float*)(F.lds + G3_LM); LAS float* TMx = (LAS float*)(F.lds + G3_TM); LAS unsigned char* XS = F.lds + G3_XS;
    LAS float* BT = (LAS float*)(F.lds + G3_VEC); LAS float* GC = BT + 128; LAS float* EQ = BT + 256; LAS float* EK = BT + 384; LAS float* BEQ = BT + 512;
    const int tid = F.tid, lane = F.lane, w = F.wave;
    LAS bf16_t* CWL = (LAS bf16_t*)(F.lds + G3_CW);
    for (int i = tid; i < 5 * 3 * CW / 8; i += NTHREADS) { const float* wp = F.conv_w() + (size_t)L * 5 * 3 * CW + (size_t)i * 8; const f32x4 w0 = *(const f32x4*)wp, w1 = *(const f32x4*)(wp + 4);
        float t8[8] = {w0[0], w0[1], w0[2], w0[3], w1[0], w1[1], w1[2], w1[3]}; *(LAS u32x4*)(CWL + (size_t)i * 8) = pack8(t8); }
    bsync();
    for (int unit = F.wg; unit < BATCH * CHN * NCH; unit += F.G) {
        const int n = unit % NCH, bhh = unit / NCH, h = bhh % CHN, b = bhh / CHN;
        {
        float g_t = 0.f, b_t = 0.f;
        if (tid < 128) { const int dir = tid >> 6, tt = tid & 63; const size_t tok = (size_t)b * SEQ + n * 64 + tt;
            const float a = bf2f(F.PROJ()[tok * INWP + O_CA + dir * CHN + h]), bb = bf2f(F.PROJ()[tok * INWP + O_CB + dir * CHN + h]);
            g_t = -fexp(F.a_log()[((size_t)L * 2 + dir) * CHN + h]) * softplusf_(a + F.dt_bias()[((size_t)L * 2 + dir) * CHN + h]); b_t = sigmoidf_(bb); }
#pragma unroll
        for (int i = 0; i < 3; ++i) {
            const int item = tid + 512 * i, t = item / 24, cg = item % 24, which = cg >> 3, c8 = cg & 7, ch = which * CW + h * 64 + c8 * 8;
            float acc[8];
#pragma unroll
            for (int e = 0; e < 8; ++e) acc[e] = 0.f;
            u32x4 xr[5]; float okf[5];
#pragma unroll
            for (int kk = 0; kk < 5; ++kk) { const int sq = n * 64 + t + kk - 2; const bool ok = sq >= 0 && sq < SEQ; const int sqc = sq < 0 ? 0 : (sq >= SEQ ? SEQ - 1 : sq);
                okf[kk] = ok ? 1.f : 0.f; xr[kk] = *(const u32x4*)(F.PROJ() + (size_t)(b * SEQ + sqc) * INWP + O_CQKV + ch); }
#pragma unroll
            for (int kk = 0; kk < 5; ++kk) { float xv[8], wv[8]; unpack8(xr[kk], xv); unpack8(*(const LAS u32x4*)(CWL + (kk * 3 * CW + ch)), wv);
#pragma unroll
                for (int e = 0; e < 8; ++e) acc[e] += xv[e] * (wv[e] * okf[kk]); }
            float ss = 0.f;
#pragma unroll
            for (int e = 0; e < 8; ++e) { acc[e] = siluf_(acc[e]); ss += acc[e] * acc[e]; }
            ss += shx(ss, 1); ss += shx(ss, 2); ss += shx(ss, 4);
            const float sc = (which == 2) ? 1.0f : frsqrt(ss + NORM_EPS) * (which == 0 ? 0.125f : 1.0f);
#pragma unroll
            for (int e = 0; e < 8; ++e) acc[e] *= sc;
            *(LAS u32x4*)((which == 0 ? QB : (which == 1 ? KB : VB)) + t * 72 + c8 * 8) = pack8(acc);
        }
        if (w < 2) {
            const int dir = w;
            float g = dir ? __builtin_bit_cast(float, shfl_i(__builtin_bit_cast(int, g_t), 63 - lane)) : g_t;
            const float bt = dir ? __builtin_bit_cast(float, shfl_i(__builtin_bit_cast(int, b_t), 63 - lane)) : b_t;
#pragma unroll
            for (int d = 1; d < 64; d <<= 1) { const float o = __builtin_bit_cast(float, shup(__builtin_bit_cast(unsigned, g), d)); if (lane >= d) g += o; }
            const float last = __builtin_bit_cast(float, shfl_i(__builtin_bit_cast(int, g), 63)), eq = fexp(g);
            BT[dir * 64 + lane] = bt; GC[dir * 64 + lane] = g; EQ[dir * 64 + lane] = eq; EK[dir * 64 + lane] = fexp(last - g); BEQ[dir * 64 + lane] = bt * eq;
            if (lane == 63) { const int chain = (b * CHN + h) * 2 + dir, mm = dir ? NCH - 1 - n : n; F.GAM()[(size_t)chain * NCH + mm] = eq; }
        }
        bsync();
        }
        {
        {
            const int mat = w >> 2, tt = w & 3, c = lane & 15, g4 = lane >> 4;
            const LAS bf16_t* XA = (mat ? QB : KB) + (tt * 16 + c) * 72 + g4 * 8;
            const bf16x8 a0 = *(const LAS bf16x8*)XA, a1 = *(const LAS bf16x8*)(XA + 32);
            f32x4 acc[4];
#pragma unroll
            for (int ct = 0; ct < 4; ++ct) { const LAS bf16_t* XBp = KB + (ct * 16 + c) * 72 + g4 * 8;
                f32x4 a = {0.f, 0.f, 0.f, 0.f}; a = mfma16(a0, *(const LAS bf16x8*)XBp, a); a = mfma16(a1, *(const LAS bf16x8*)(XBp + 32), a); acc[ct] = a; }
            if (mat == 0) {
#pragma unroll 1
                for (int dir = 0; dir < 2; ++dir) {
                    float gct[4], btv[4], gcs[4];
#pragma unroll
                    for (int i = 0; i < 4; ++i) { const int t = 16 * tt + 4 * g4 + i, tau = dir ? 63 - t : t; gct[i] = GC[dir * 64 + tau]; btv[i] = BT[dir * 64 + tau]; }
#pragma unroll
                    for (int ct = 0; ct < 4; ++ct) { const int sq = 16 * ct + c, sg = dir ? 63 - sq : sq; gcs[ct] = GC[dir * 64 + sg]; }
#pragma unroll
                    for (int i = 0; i < 4; ++i) { const int t = 16 * tt + 4 * g4 + i, tau = dir ? 63 - t : t;
#pragma unroll
                        for (int ct = 0; ct < 4; ++ct) { const int sq = 16 * ct + c, sg = dir ? 63 - sq : sq;
                            LM[dir * LMD + tau * LMP + sg] = (sg < tau) ? btv[i] * acc[ct][i] * fexp(gct[i] - gcs[ct]) : 0.f; } }
                }
            } else {
#pragma unroll 1
                for (int dir = 0; dir < 2; ++dir) {
                    float gct[4], gcs[4]; int pcol[4];
#pragma unroll
                    for (int i = 0; i < 4; ++i) { const int t = 16 * tt + 4 * g4 + i, tau = dir ? 63 - t : t; gct[i] = GC[dir * 64 + tau]; }
#pragma unroll
                    for (int ct = 0; ct < 4; ++ct) { const int sq = 16 * ct + c, sg = dir ? 63 - sq : sq; gcs[ct] = GC[dir * 64 + sg]; pcol[ct] = perm_inv(sg); }
                    LAS bf16_t* QKI = (LAS bf16_t*)(XS + dir * 24576 + 16384);
#pragma unroll
                    for (int i = 0; i < 4; ++i) { const int t = 16 * tt + 4 * g4 + i, tau = dir ? 63 - t : t;
#pragma unroll
                        for (int ct = 0; ct < 4; ++ct) { const int sq = 16 * ct + c, sg = dir ? 63 - sq : sq;
                            QKI[tau * 64 + pcol[ct]] = (bf16_t)f2bf((sg <= tau) ? acc[ct][i] * fexp(gct[i] - gcs[ct]) : 0.f); } }
                }
            }
            if (mat == 0) {
                wsync();
                if (lane < 32) { const int dir = lane >> 4, blk = dir ? 3 - tt : tt;
                    const LAS float* Lb = LM + dir * LMD + (blk * 16) * LMP + blk * 16;
                    float tv[16];
#pragma unroll
                    for (int r = 0; r < 16; ++r) { float a = (r == c) ? 1.f : 0.f;
#pragma unroll
                        for (int s2 = 0; s2 < r; ++s2) a -= Lb[r * LMP + s2] * tv[s2];
                        tv[r] = a; }
                    LAS float* Tb = TMx + (dir * 4 + blk) * TMB;
#pragma unroll
                    for (int r = 0; r < 16; ++r) Tb[r * TMP + c] = tv[r]; }
            } else {
                const int t2 = tid - 256;
#pragma unroll 1
                for (int i = 0; i < 8; ++i) {
                    const int item = t2 + 256 * i, dir = item >> 10, mat2 = (item >> 9) & 1, row = (item >> 3) & 63, chk = item & 7;
                    const int chain = (b * CHN + h) * 2 + dir, mm = dir ? NCH - 1 - n : n;
                    unsigned char* rec = F.REC() + ((size_t)chain * NCH + mm) * RECB;
                    const int pi0 = 32 * (chk >> 2) + 4 * (chk & 3);
                    float o[8];
                    if (mat2 == 0) { const int t = dir ? 63 - row : row; const float eq = EQ[dir * 64 + row];
                        const u32x2 lo2 = *(const LAS u32x2*)(QB + t * 72 + pi0), hi2 = *(const LAS u32x2*)(QB + t * 72 + pi0 + 16);
                        o[0] = lo16(lo2.x) * eq; o[1] = hi16(lo2.x) * eq; o[2] = lo16(lo2.y) * eq; o[3] = hi16(lo2.y) * eq; o[4] = lo16(hi2.x) * eq; o[5] = hi16(hi2.x) * eq; o[6] = lo16(hi2.y) * eq; o[7] = hi16(hi2.y) * eq; }
                    else {
#pragma unroll
                        for (int e = 0; e < 8; ++e) { const int pi = pi0 + 16 * (e >> 2) + (e & 3), sq = dir ? 63 - pi : pi; o[e] = bf2f(KB[sq * 72 + row]) * EK[dir * 64 + pi]; } }
                    *(u32x4*)(rec + (mat2 ? 24576 : 8192) + row * 128 + chk * 16) = pack8(o);
                }
            }
        }
        bsync();
        }
        {
        {
            const int dir = w >> 2, c = lane & 15, g4 = lane >> 4;
            const LAS float* Lm = LM + dir * LMD; const LAS float* Tm = TMx + dir * 4 * TMB;
            bf16x8 AT[4], AL1, AL2, AL3a, AL3b;
#pragma unroll
            for (int i = 0; i < 4; ++i) { const f32x4 v = *(const LAS f32x4*)(Tm + i * TMB + c * TMP + 4 * g4); u32x4 t; t.x = pk2(v[0], v[1]); t.y = pk2(v[2], v[3]); t.z = 0u; t.w = 0u; AT[i] = __builtin_bit_cast(bf16x8, t); }
            { const f32x4 v = *(const LAS f32x4*)(Lm + (16 + c) * LMP + 4 * g4); u32x4 t; t.x = pk2(v[0], v[1]); t.y = pk2(v[2], v[3]); t.z = 0u; t.w = 0u; AL1 = __builtin_bit_cast(bf16x8, t); }
            { const f32x4 v = *(const LAS f32x4*)(Lm + (32 + c) * LMP + 4 * g4), v2 = *(const LAS f32x4*)(Lm + (32 + c) * LMP + 16 + 4 * g4); u32x4 t; t.x = pk2(v[0], v[1]); t.y = pk2(v[2], v[3]); t.z = pk2(v2[0], v2[1]); t.w = pk2(v2[2], v2[3]); AL2 = __builtin_bit_cast(bf16x8, t); }
            { const f32x4 v = *(const LAS f32x4*)(Lm + (48 + c) * LMP + 4 * g4), v2 = *(const LAS f32x4*)(Lm + (48 + c) * LMP + 16 + 4 * g4); u32x4 t; t.x = pk2(v[0], v[1]); t.y = pk2(v[2], v[3]); t.z = pk2(v2[0], v2[1]); t.w = pk2(v2[2], v2[3]); AL3a = __builtin_bit_cast(bf16x8, t); }
            { const f32x4 v = *(const LAS f32x4*)(Lm + (48 + c) * LMP + 32 + 4 * g4); u32x4 t; t.x = pk2(v[0], v[1]); t.y = pk2(v[2], v[3]); t.z = 0u; t.w = 0u; AL3b = __builtin_bit_cast(bf16x8, t); }
#pragma unroll 1
            for (int cti = 0; cti < 2; ++cti) {
                const int ct = 2 * (w & 3) + cti, col = 16 * ct + c;
                f32x4 R[4];
                const LAS bf16_t* rsrc = (ct < 4) ? VB + col : KB + (col - 64);
                const LAS float* rscl = ((ct < 4) ? BT : BEQ) + dir * 64;
#pragma unroll
                for (int i = 0; i < 4; ++i)
#pragma unroll
                    for (int e = 0; e < 4; ++e) { const int tau = 16 * i + 4 * g4 + e, t = dir ? 63 - tau : tau;
                        R[i][e] = bf2f(rsrc[t * 72]) * rscl[tau]; }
                const f32x4 z4 = {0.f, 0.f, 0.f, 0.f};
#define PKX(a, b2) __builtin_bit_cast(bf16x8, (u32x4){pk2((a)[0], (a)[1]), pk2((a)[2], (a)[3]), pk2((b2)[0], (b2)[1]), pk2((b2)[2], (b2)[3])})
                const f32x4 X0 = mfma16(AT[0], PKX(R[0], z4), z4);
                const f32x4 Y1 = R[1] - mfma16(AL1, PKX(X0, z4), z4);
                const f32x4 X1 = mfma16(AT[1], PKX(Y1, z4), z4);
                const bf16x8 X01 = PKX(X0, X1);
                const f32x4 Y2 = R[2] - mfma16(AL2, X01, z4);
                const f32x4 X2 = mfma16(AT[2], PKX(Y2, z4), z4);
                const f32x4 Y3 = R[3] - mfma16(AL3b, PKX(X2, z4), mfma16(AL3a, X01, z4));
                const f32x4 X3 = mfma16(AT[3], PKX(Y3, z4), z4);
#undef PKX
                const f32x4 X[4] = {X0, X1, X2, X3};
                if (ct < 4) { LAS bf16_t* U = (LAS bf16_t*)(XS + dir * 24576);
#pragma unroll
                    for (int i = 0; i < 4; ++i)
#pragma unroll
                        for (int e = 0; e < 4; ++e) U[(16 * i + 4 * g4 + e) * 64 + col] = (bf16_t)f2bf(X[i][e]); }
                else { LAS bf16_t* Wp = (LAS bf16_t*)(XS + dir * 24576 + 8192); const int sc = perm_inv(col - 64);
#pragma unroll
                    for (int i = 0; i < 4; ++i)
#pragma unroll
                        for (int e = 0; e < 4; ++e) Wp[(16 * i + 4 * g4 + e) * 64 + sc] = (bf16_t)f2bf(X[i][e]); }
            }
        }
        bsync();
        }
        {
#pragma unroll
        for (int k = 0; k < 6; ++k) { const int off = (tid + 512 * k) * 16, dir = off / 24576, oi = off % 24576;
            const int chain = (b * CHN + h) * 2 + dir, mm = dir ? NCH - 1 - n : n;
            unsigned char* rec = F.REC() + ((size_t)chain * NCH + mm) * RECB;
            *(u32x4*)(rec + (oi < 8192 ? 32768 + oi : (oi < 16384 ? oi - 8192 : oi))) = *(const LAS u32x4*)(XS + off); }
        }
    }
    bsync();
}

constexpr int ATT_KROWS = 384;
constexpr int ATT_VPITCH = 776;
constexpr int ATT_LDS_V = ATT_KROWS * 128;
struct AttUnit { int p, dil, Lp, QB, bh, r, jq0; };
DEV int att_qb(int Lp) { return Lp < 256 ? Lp : 256; }
DEV int att_units_total() { int t = 0; for (int p = 0; p < 3; ++p) { const int dil = (p == 0) ? 1 : (p == 1 ? 4 : 16); t += BATCH * BH * (SEQ / att_qb(SEQ / dil)); } return t; }
DEV bool att_decode(int u, AttUnit& a) {
    for (int p = 0; p < 3; ++p) { const int dil = (p == 0) ? 1 : (p == 1 ? 4 : 16), Lp = SEQ / dil, QB = att_qb(Lp), n = BATCH * BH * (SEQ / QB);
        if (u < n) { const int nb = Lp / QB, per_bh = dil * nb; a.p = p; a.dil = dil; a.Lp = Lp; a.QB = QB; a.bh = u / per_bh; const int q = u % per_bh; a.r = q / nb; a.jq0 = (q % nb) * QB; return true; }
        u -= n; }
    return false;
}
struct AttRegs { u32x4 kv[12]; };
DEV void att_load(Frame& F, const AttUnit& a, AttRegs& R) {
    const int tid = F.tid;
    const int nkeys = a.QB + 128, kbase = a.jq0 - 64;
    const bf16_t* Kb = F.KN() + (size_t)a.bh * SEQ * 64;
    const bf16_t* VTp = (const bf16_t*)(F.VT() + (size_t)a.p * VT_STRIDE) + ((size_t)a.bh * a.dil + a.r) * 64 * a.Lp;
#pragma unroll
    for (int i = 0; i < 6; ++i) {
        const int id = tid + 512 * i, row = id >> 3, cp = id & 7, j = kbase + row;
        u32x4 v = {0u, 0u, 0u, 0u};
        if (row < nkeys && j >= 0 && j < a.Lp) v = *(const u32x4*)(Kb + (size_t)(a.r + a.dil * j) * 64 + ((cp ^ (row & 7)) * 8));
        R.kv[i] = v;
    }
#pragma unroll
    for (int i = 0; i < 6; ++i) {
        const int id = tid + 512 * i, d = id / 48, ck = id % 48, j = kbase + ck * 8;
        u32x4 v = {0u, 0u, 0u, 0u};
        if (ck * 8 < nkeys && j >= 0 && j < a.Lp) v = *(const u32x4*)(VTp + (size_t)d * a.Lp + j);
        R.kv[6 + i] = v;
    }
}
DEV void att_store_lds(Frame& F, const AttRegs& R) {
    const int tid = F.tid;
#pragma unroll
    for (int i = 0; i < 6; ++i) { const int id = tid + 512 * i; *(LAS u32x4*)(F.lds + id * 16) = R.kv[i]; }
#pragma unroll
    for (int i = 0; i < 6; ++i) { const int id = tid + 512 * i, d = id / 48, ck = id % 48; LAS unsigned char* p = F.lds + ATT_LDS_V + d * ATT_VPITCH + ck * 16;
        u32x2 lo2, hi2; lo2.x = R.kv[6 + i].x; lo2.y = R.kv[6 + i].y; hi2.x = R.kv[6 + i].z; hi2.y = R.kv[6 + i].w; *(LAS u32x2*)p = lo2; *(LAS u32x2*)(p + 8) = hi2; }
}
DEV void att_loadq(Frame& F, const AttUnit& a, bf16x8 (&qf)[4]) {
    const int lane = F.lane, w = F.wave, r31 = lane & 31, hh = lane >> 5;
    if (w * 32 < a.QB) { const bf16_t* qp = F.QN() + ((size_t)a.bh * SEQ + a.r + a.dil * (a.jq0 + w * 32 + r31)) * 64 + 8 * hh;
#pragma unroll
        for (int s = 0; s < 4; ++s) qf[s] = *(const bf16x8*)(qp + 16 * s); }
}
DEV void att_compute(Frame& F, const AttUnit& a, const bf16x8 (&qf)[4], float Cb) {
    const int lane = F.lane, w = F.wave, r31 = lane & 31, hh = lane >> 5;
    if (w * 32 >= a.QB) return;
    const int jq = a.jq0 + w * 32;
    f32x16 o0, o1; for (int i = 0; i < 16; ++i) { o0[i] = 0.f; o1[i] = 0.f; }
    float lsum = 0.f;
#pragma unroll
    for (int kt = 0; kt < 5; ++kt) {
        const int jk = jq - 64 + 32 * kt, kl = 32 * w + 32 * kt;
        if (jk < 0 || jk >= a.Lp) continue;
        f32x16 sc; for (int i = 0; i < 16; ++i) sc[i] = 0.f;
        { const int row = kl + r31; const LAS unsigned char* kp = F.lds + row * 128;
#pragma unroll
          for (int s = 0; s < 4; ++s) sc = mfma32(*(const LAS bf16x8*)(kp + (((2 * s + hh) ^ (row & 7)) * 16)), qf[s], sc); }
        float pv[16];
#pragma unroll
        for (int i = 0; i < 16; ++i) { const int dlt = jk + (i & 3) + 8 * (i >> 2) + 4 * hh - (jq + r31);
            const float e = fexp(sc[i] - Cb); pv[i] = (dlt <= 64 && dlt >= -64) ? e : 0.f; lsum += pv[i]; }
        const bf16x8 p0 = __builtin_bit_cast(bf16x8, pack8(pv)), p1 = __builtin_bit_cast(bf16x8, pack8(pv + 8));
#pragma unroll
        for (int dt = 0; dt < 2; ++dt) {
            ASMV("" ::: "memory");
            const LAS unsigned char* vp = F.lds + ATT_LDS_V + (dt * 32 + r31) * ATT_VPITCH + (kl + 4 * hh) * 2;
            const u32x2 x0 = *(const LAS u32x2*)vp, x1 = *(const LAS u32x2*)(vp + 16), x2 = *(const LAS u32x2*)(vp + 32), x3 = *(const LAS u32x2*)(vp + 48);
            u32x4 a0, a1; a0.x = x0.x; a0.y = x0.y; a0.z = x1.x; a0.w = x1.y; a1.x = x2.x; a1.y = x2.y; a1.z = x3.x; a1.w = x3.y;
            if (dt == 0) { o0 = mfma32(__builtin_bit_cast(bf16x8, a0), p0, o0); o0 = mfma32(__builtin_bit_cast(bf16x8, a1), p1, o0); }
            else { o1 = mfma32(__builtin_bit_cast(bf16x8, a0), p0, o1); o1 = mfma32(__builtin_bit_cast(bf16x8, a1), p1, o1); }
        }
    }
    lsum += shx(lsum, 32);
    const int b = a.bh / BH, h = a.bh % BH; const size_t tok = (size_t)b * SEQ + a.r + a.dil * (jq + r31);
    bf16_t* np = F.NUM() + (size_t)a.p * (VT_STRIDE / 2) + tok * BW + h * 64;
#pragma unroll
    for (int g4 = 0; g4 < 4; ++g4) {
        u32x2 w0; w0.x = pk2(o0[4 * g4], o0[4 * g4 + 1]); w0.y = pk2(o0[4 * g4 + 2], o0[4 * g4 + 3]); *(u32x2*)(np + 8 * g4 + 4 * hh) = w0;
        u32x2 w1; w1.x = pk2(o1[4 * g4], o1[4 * g4 + 1]); w1.y = pk2(o1[4 * g4 + 2], o1[4 * g4 + 3]); *(u32x2*)(np + 32 + 8 * g4 + 4 * hh) = w1;
    }
    if (hh == 0) F.DEN()[((size_t)a.p * M + tok) * BH + h] = lsum;
}
DEV void attn_units(Frame& F, int L, int slot, int nslots) {
    const int lane = F.lane;
    const float gq = wave_max(fabsf(F.q_norm_g()[(size_t)L * 64 + lane])), gk = wave_max(fabsf(F.k_norm_g()[(size_t)L * 64 + lane]));
    const float Cb = 8.0f * gq * gk;
    const int total = att_units_total();
    for (int u = slot; u < total; u += nslots) {
        AttUnit cur; att_decode(u, cur);
        bf16x8 qf[4];
#pragma unroll
        for (int s = 0; s < 4; ++s) qf[s] = (bf16x8){0, 0, 0, 0, 0, 0, 0, 0};
        { AttRegs R; att_load(F, cur, R); att_loadq(F, cur, qf); att_store_lds(F, R); }
        bsync();
        att_compute(F, cur, qf, Cb);
        bsync();
    }
}

DEV void scan_store_o(Frame& F, bf16_t* Ob, int b, int h, int dir, int m) {
    const int t2 = F.tid - 256, nchunk = dir ? NCH - 1 - m : m;
    const LAS unsigned char* tile = F.lds + 3 * RECB + (m & 1) * 8192;
#pragma unroll
    for (int k = 0; k < 2; ++k) { const int id = t2 + 256 * k, tau = id >> 3, ck = id & 7, sq = nchunk * 64 + (dir ? 63 - tau : tau);
        *(u32x4*)(Ob + ((size_t)b * SEQ + sq) * CW + h * 64 + ck * 8) = *(const LAS u32x4*)(tile + tau * 128 + ck * 16); }
}
DEV void scan_chains(Frame& F, int slot, int nslots) {
    const int lane = F.lane, w = F.wave, c = lane & 15, g4 = lane >> 4;
    constexpr int NDMA = RECB / 4096;
    static_assert(NDMA == 10 && RECB % 8192 == 0, "the counted waits below assume 10 DMAs per loader wave per record");
    for (int chain = slot; chain < NCHAIN; chain += nslots) {
        const int dir = chain & 1, bhh = chain >> 1, h = bhh % CHN, b = bhh / CHN;
        const unsigned char* recs = F.REC() + (size_t)chain * NCH * RECB;
        const float* gam = F.GAM() + (size_t)chain * NCH;
#pragma unroll
        for (int it = 0; it < 2 * RECB / 8192; ++it) glds16(recs + it * 8192 + w * 1024 + lane * 16, F.lds + it * 8192 + w * 1024);
        ASMV("s_waitcnt vmcnt(0)" ::: "memory"); rawbar(); ASMV("" ::: "memory");
        f32x4 S[4];
#pragma unroll
        for (int i = 0; i < 4; ++i) S[i] = (f32x4){0.f, 0.f, 0.f, 0.f};
        bf16_t* Ob = F.OFB() + (size_t)dir * M * CW;
        int bi = 0;
#pragma unroll 1
        for (int m = 0; m < NCH; ++m) {
            LAS unsigned char* buf = F.lds + bi * RECB;
            if (w >= 4) {
                if (m + 2 < NCH) { const int bn = bi == 0 ? 2 : bi - 1;
                    const unsigned char* src = recs + (size_t)(m + 2) * RECB + (w - 4) * 1024 + lane * 16; LAS unsigned char* dst = F.lds + bn * RECB + (w - 4) * 1024;
#pragma unroll
                    for (int it = 0; it < NDMA; ++it) glds16(src + it * 4096, dst + it * 4096);
                    if (m > 0) scan_store_o(F, Ob, b, h, dir, m - 1);
                    ASMV("s_waitcnt vmcnt(12)" ::: "memory");
                } else { if (m > 0) scan_store_o(F, Ob, b, h, dir, m - 1); ASMV("s_waitcnt vmcnt(2)" ::: "memory"); }
            } else {
                const float gamma = gam[m];
                const LAS unsigned char* Wp = buf; const LAS unsigned char* Qp = buf + 8192; const LAS unsigned char* QKp = buf + 16384; const LAS unsigned char* Ktp = buf + 24576;
                const LAS bf16_t* U = (const LAS bf16_t*)(buf + 32768);
                const int aoff = c * 128 + g4 * 16;
                bf16x8 Sb[2];
#pragma unroll
                for (int ks = 0; ks < 2; ++ks) { u32x4 t; t.x = pk2(S[2 * ks][0], S[2 * ks][1]); t.y = pk2(S[2 * ks][2], S[2 * ks][3]); t.z = pk2(S[2 * ks + 1][0], S[2 * ks + 1][1]); t.w = pk2(S[2 * ks + 1][2], S[2 * ks + 1][3]); Sb[ks] = __builtin_bit_cast(bf16x8, t); }
                f32x4 VN[4];
#pragma unroll
                for (int tt = 0; tt < 4; ++tt) {
                    f32x4 a = {0.f, 0.f, 0.f, 0.f};
#pragma unroll
                    for (int ks = 0; ks < 2; ++ks) a = mfma16(*(const LAS bf16x8*)(Wp + tt * 2048 + aoff + ks * 64), Sb[ks], a);
#pragma unroll
                    for (int i = 0; i < 4; ++i) VN[tt][i] = bf2f(U[(16 * tt + 4 * g4 + i) * 64 + 16 * w + c]) - a[i];
                }
                bf16x8 VNb[2];
#pragma unroll
                for (int ks = 0; ks < 2; ++ks) { u32x4 t; t.x = pk2(VN[2 * ks][0], VN[2 * ks][1]); t.y = pk2(VN[2 * ks][2], VN[2 * ks][3]); t.z = pk2(VN[2 * ks + 1][0], VN[2 * ks + 1][1]); t.w = pk2(VN[2 * ks + 1][2], VN[2 * ks + 1][3]); VNb[ks] = __builtin_bit_cast(bf16x8, t); }
#pragma unroll
                for (int tt = 0; tt < 4; ++tt) {
                    ASMV("" ::: "memory");
                    f32x4 o = {0.f, 0.f, 0.f, 0.f};
#pragma unroll
                    for (int ks = 0; ks < 2; ++ks) o = mfma16(*(const LAS bf16x8*)(Qp + tt * 2048 + aoff + ks * 64), Sb[ks], o);
#pragma unroll
                    for (int ks = 0; ks < 2; ++ks) o = mfma16(*(const LAS bf16x8*)(QKp + tt * 2048 + aoff + ks * 64), VNb[ks], o);
#pragma unroll
                    for (int i = 0; i < 4; ++i) ((LAS bf16_t*)(F.lds + 3 * RECB + (m & 1) * 8192))[(16 * tt + 4 * g4 + i) * 64 + 16 * w + c] = (bf16_t)f2bf(o[i]);
                }
#pragma unroll
                for (int rt = 0; rt < 4; ++rt) {
                    ASMV("" ::: "memory");
                    f32x4 a = S[rt] * gamma;
#pragma unroll
                    for (int ks = 0; ks < 2; ++ks) a = mfma16(*(const LAS bf16x8*)(Ktp + rt * 2048 + aoff + ks * 64), VNb[ks], a);
                    S[rt] = a;
                }
                ASMV("s_waitcnt lgkmcnt(0)" ::: "memory");
            }
            rawbar(); ASMV("" ::: "memory");
            bi = bi == 2 ? 0 : bi + 1;
        }
        if (w >= 4) scan_store_o(F, Ob, b, h, dir, NCH - 1);
        ASMV("s_waitcnt vmcnt(0)" ::: "memory");
        rawbar();
    }
}

DEV void phase_assemble(Frame& F, int L) {
    const int nitems = M * (BH + CHN) * 4;
    const int stride = F.G * NTHREADS;
    for (int it0 = F.wg * NTHREADS; it0 < nitems; it0 += stride) {
        const int it = it0 + F.tid; const bool live = it < nitems;
        const int qd = it & 3, hd = live ? (it >> 2) % (BH + CHN) : 0, tok = live ? (it >> 2) / (BH + CHN) : 0;
        float v[16]; float ss = 0.f; bf16_t* dst;
        if (hd < BH) {
#pragma unroll
            for (int i = 0; i < 16; ++i) v[i] = 0.f;
            float den = 0.f;
#pragma unroll
            for (int p = 0; p < 3; ++p) { const bf16_t* np = F.NUM() + (size_t)p * (VT_STRIDE / 2) + (size_t)tok * BW + hd * 64 + qd * 16; float t[16]; unpack8(*(const u32x4*)np, t); unpack8(*(const u32x4*)(np + 8), t + 8);
#pragma unroll
                for (int i = 0; i < 16; ++i) v[i] += t[i];
                den += F.DEN()[((size_t)p * M + tok) * BH + hd]; }
            const float inv = 1.0f / den;
#pragma unroll
            for (int i = 0; i < 16; ++i) v[i] *= inv;
            dst = F.ACT() + (size_t)tok * DM + GW + hd * 64 + qd * 16;
        } else {
            const int hc = hd - BH; float bb[16], gt[16];
            const bf16_t* of = F.OFB() + (size_t)tok * CW + hc * 64 + qd * 16; const bf16_t* ob = of + (size_t)M * CW;
            unpack8(*(const u32x4*)of, v); unpack8(*(const u32x4*)(of + 8), v + 8); unpack8(*(const u32x4*)ob, bb); unpack8(*(const u32x4*)(ob + 8), bb + 8);
            const bf16_t* gp = F.PROJ() + (size_t)tok * INWP + O_CG + hc * 64 + qd * 16; unpack8(*(const u32x4*)gp, gt); unpack8(*(const u32x4*)(gp + 8), gt + 8);
            const float* og = F.o_norm_g() + (size_t)L * 64 + qd * 16;
#pragma unroll
            for (int i = 0; i < 16; ++i) { v[i] += bb[i]; ss += v[i] * v[i]; v[i] *= og[i] * siluf_(gt[i]); }
            dst = F.ACT() + (size_t)tok * DM + GW + BW + hc * 64 + qd * 16;
        }
        ss += shx(ss, 1); ss += shx(ss, 2);
        const float rstd = (hd < BH) ? 1.0f : frsqrt(ss * (1.f / 64.f) + NORM_EPS);
#pragma unroll
        for (int i = 0; i < 16; ++i) v[i] *= rstd;
        if (live) { *(u32x4*)dst = pack8(v); *(u32x4*)(dst + 8) = pack8(v + 8); }
    }
}

constexpr int RT_PITCH = DM + 8;
constexpr int RT_HI = 0, RT_LO = 16 * RT_PITCH * 2, RT_G = 2 * RT_LO;
DEV void phase_router(Frame& F, int L) {
    LAS bf16_t* WH = (LAS bf16_t*)(F.lds + RT_HI); LAS bf16_t* WL = (LAS bf16_t*)(F.lds + RT_LO); LAS float* GF = (LAS float*)(F.lds + RT_G);
    for (int i = F.tid; i < DM; i += NTHREADS) GF[i] = F.g_ffn()[(size_t)L * DM + i];
    { constexpr int NF = (DM * 16 + NTHREADS - 1) / NTHREADS;
#pragma unroll 4
      for (int i = 0; i < NF; ++i) { const int id = F.tid + NTHREADS * i; if (id < DM * 16) { const int d = id >> 4, e = id & 15;
          const float w = (e < NEXP) ? F.w_router()[(size_t)L * DM * NEXP + (size_t)d * NEXP + e] * F.g_ffn()[(size_t)L * DM + d] : 0.f;
          const unsigned hi = f2bf(w); const float lo = w - __builtin_bit_cast(float, hi << 16);
          WH[e * RT_PITCH + d] = (bf16_t)hi; WL[e * RT_PITCH + d] = (bf16_t)f2bf(lo); } } }
    bsync();
    const int gw = F.wg * NWAVES + F.wave, NGW = F.G * NWAVES, lane = F.lane, c = lane & 15, g4 = lane >> 4;
    constexpr int NKS = DM / 32;
    for (int rb = gw; rb < M / 16; rb += NGW) {
        const int row = rb * 16 + c;
        u32x4 xv[NKS];
        const u32x4* xp = (const u32x4*)(F.XB(L) + (size_t)row * DM + 8 * g4);
        u32x4* hp = (u32x4*)(F.ACT() + (size_t)row * DM + 8 * g4);
        const LAS bf16_t* whp = WH + c * RT_PITCH + 8 * g4; const LAS bf16_t* wlp = WL + c * RT_PITCH + 8 * g4; const LAS float* gfp = GF + 8 * g4;
#pragma unroll
        for (int ks = 0; ks < NKS; ++ks) xv[ks] = xp[4 * ks];
        f32x4 acc = {0.f, 0.f, 0.f, 0.f}; float ss = 0.f;
#pragma unroll
        for (int ks = 0; ks < NKS; ++ks) {
            const bf16x8 a = __builtin_bit_cast(bf16x8, xv[ks]);
            acc = mfma16(a, *(const LAS bf16x8*)(whp + 32 * ks), acc);
            acc = mfma16(a, *(const LAS bf16x8*)(wlp + 32 * ks), acc);
            float t[8]; unpack8(xv[ks], t);
#pragma unroll
            for (int e = 0; e < 8; ++e) ss += t[e] * t[e];
            if ((ks & 1) == 1) ASMV("" : "+v"(acc), "+v"(ss) :: "memory");
        }
        ss += shx(ss, 16); ss += shx(ss, 32);
        const float rstd = frsqrt(ss * (1.f / DM) + NORM_EPS);
#pragma unroll
        for (int ks = 0; ks < NKS; ++ks) { ASMV("" : "+v"(xv[ks]));
            float t[8]; unpack8(xv[ks], t);
            const f32x4 g0 = *(const LAS f32x4*)(gfp + 32 * ks), g1 = *(const LAS f32x4*)(gfp + 32 * ks + 4);
#pragma unroll
            for (int e = 0; e < 4; ++e) { t[e] *= rstd * g0[e]; t[4 + e] *= rstd * g1[e]; }
            hp[4 * ks] = pack8(t);
            ASMV("" ::: "memory"); }
#pragma unroll
        for (int i = 0; i < 4; ++i) {
            const float rs = __builtin_bit_cast(float, shfl_i(__builtin_bit_cast(int, rstd), 4 * g4 + i));
            float lg = (c < NEXP) ? acc[i] * rs : -3.0e38f;
            float mx = lg;
#pragma unroll
            for (int o = 1; o < 16; o <<= 1) mx = fmaxf(mx, shx(mx, o));
            const float ex = (c < NEXP) ? expf(lg - mx) : 0.f; float sm = ex;
#pragma unroll
            for (int o = 1; o < 16; o <<= 1) sm += shx(sm, o);
            const int m = rb * 16 + 4 * g4 + i, b = m / SEQ, sq = m % SEQ;
            if (c < NEXP) F.AFF()[((size_t)b * NEXP + c) * SEQ + sq] = ex / sm;
        }
    }
}

constexpr int KPT = (SEQ + NTHREADS - 1) / NTHREADS;
DEV unsigned block_sum_u(Frame& F, unsigned v, int parity) {
    LAS unsigned* red = (LAS unsigned*)(F.lds + 1024) + parity * 8;
    float f = (float)v; f = wave_sum(f);
    if (F.lane == 0) red[F.wave] = (unsigned)f;
    bsync();
    unsigned t = 0;
#pragma unroll
    for (int i = 0; i < NWAVES; ++i) t += red[i];
    return t;
}
DEV void phase_topk(Frame& F) {
    const int tid = F.tid, lane = F.lane;
    for (int pair = F.wg; pair < BATCH * NEXP; pair += F.G) {
        const int b = pair / NEXP, e = pair % NEXP;
        const float* aff = F.AFF() + (size_t)pair * SEQ;
        unsigned key[KPT];
#pragma unroll
        for (int i = 0; i < KPT; ++i) { const int s = tid * KPT + i; key[i] = (s < SEQ) ? __builtin_bit_cast(unsigned, aff[s]) : 0u; }
        unsigned prefix = 0u; int par = 0;
#pragma unroll 1
        for (int bit = 30; bit >= 0; --bit) {
            const unsigned cand = prefix | (1u << bit); unsigned cnt = 0;
#pragma unroll
            for (int i = 0; i < KPT; ++i) cnt += (key[i] >= cand) ? 1u : 0u;
            const unsigned tot = block_sum_u(F, cnt, par); par ^= 1;
            if (tot >= (unsigned)CAP) prefix = cand;
        }
        unsigned cgt = 0, ceq = 0;
#pragma unroll
        for (int i = 0; i < KPT; ++i) { cgt += (key[i] > prefix) ? 1u : 0u; ceq += (key[i] == prefix) ? 1u : 0u; }
        const unsigned ngt = block_sum_u(F, cgt, par); par ^= 1;
        const unsigned rr = (unsigned)CAP - ngt;
        unsigned v = cgt | (ceq << 16), inc = v;
#pragma unroll
        for (int d = 1; d < 64; d <<= 1) { const unsigned t = shup(inc, d); if (lane >= d) inc += t; }
        LAS unsigned* wt = (LAS unsigned*)(F.lds + 2048);
        if (lane == 63) wt[F.wave] = inc;
        bsync();
        unsigned base = 0;
#pragma unroll
        for (int i = 0; i < NWAVES; ++i) base += (i < F.wave) ? wt[i] : 0u;
        unsigned excl = base + inc - v; unsigned gtb = excl & 0xffffu, eqb = excl >> 16;
#pragma unroll
        for (int i = 0; i < KPT; ++i) { const int s = tid * KPT + i; if (s < SEQ) {
            const bool isgt = key[i] > prefix, iseq = key[i] == prefix; const bool sel = isgt || (iseq && eqb < rr);
            const unsigned slot = gtb + (eqb < rr ? eqb : rr);
            if (sel) { const size_t row = ((size_t)e * BATCH + b) * CAP + slot; F.IDX()[row] = s; F.GATEV()[row] = __builtin_bit_cast(float, key[i]); }
            F.INV()[((size_t)b * SEQ + s) * NEXP + e] = sel ? (int)slot : -1;
            gtb += isgt ? 1u : 0u; eqb += iseq ? 1u : 0u; } }
        bsync();
    }
}

DEV void phase_pconv(Frame& F, int L) {
    const int gw = F.wg * NWAVES + F.wave, NGW = F.G * NWAVES, lane = F.lane;
    for (int m0 = gw * 4; m0 < M; m0 += NGW * 4) {
        f32x4 v[4];
#pragma unroll
        for (int r = 0; r < 4; ++r) v[r] = *((const f32x4*)(F.p() + ((size_t)L * M + m0 + r) * PLE) + lane);
#pragma unroll
        for (int r = 0; r < 4; ++r) { u32x2 o; o.x = pk2(v[r][0], v[r][1]); o.y = pk2(v[r][2], v[r][3]); *((u32x2*)(F.PB() + (size_t)(m0 + r) * PLE) + lane) = o; }
    }
}

template <bool DRY> DEV void phase_combine(Frame& F, int L) {
    const int gw = F.wg * NWAVES + F.wave, NGW = F.G * NWAVES, lane = F.lane;
    constexpr int R = 2;
    for (int m0 = gw * R; m0 < M; m0 += NGW * R) {
        f32x4 v[R][NJ]; int inv[R];
#pragma unroll
        for (int r = 0; r < R; ++r) {
            inv[r] = (lane < NEXP) ? F.INV()[(size_t)(m0 + r) * NEXP + lane] : -1;
#pragma unroll
            for (int j = 0; j < NJ; ++j) { { const u32x2 y = *((const u32x2*)(F.XB(L) + (size_t)(m0 + r) * DM) + lane + 64 * j); v[r][j] = (f32x4){lo16(y.x), hi16(y.x), lo16(y.y), hi16(y.y)}; } }
        }
#pragma unroll
        for (int r = 0; r < R; ++r) {
            const int b = (m0 + r) / SEQ;
            unsigned long long mask = ballot_(inv[r] >= 0);
            while (mask) {
                const int e0 = __builtin_ctzll(mask); mask &= mask - 1;
                const bool two = mask != 0ull; const int e1 = two ? __builtin_ctzll(mask) : e0; if (two) mask &= mask - 1;
                const int s0 = shfl_i(inv[r], e0), s1 = shfl_i(inv[r], e1);
                const u32x2* y0 = (const u32x2*)(F.YE() + (((size_t)e0 * BATCH + b) * CAP + s0) * DM) + lane;
                const u32x2* y1 = (const u32x2*)(F.YE() + (((size_t)e1 * BATCH + b) * CAP + s1) * DM) + lane;
                u32x2 a0[NJ], a1[NJ];
#pragma unroll
                for (int j = 0; j < NJ; ++j) { a0[j] = y0[64 * j]; a1[j] = y1[64 * j]; }
#pragma unroll
                for (int j = 0; j < NJ; ++j) { v[r][j][0] += lo16(a0[j].x); v[r][j][1] += hi16(a0[j].x); v[r][j][2] += lo16(a0[j].y); v[r][j][3] += hi16(a0[j].y);
                    if (two) { v[r][j][0] += lo16(a1[j].x); v[r][j][1] += hi16(a1[j].x); v[r][j][2] += lo16(a1[j].y); v[r][j][3] += hi16(a1[j].y); } }
            }
        }
#pragma unroll
        for (int r = 0; r < R; ++r) {
            const int m = m0 + r;
            u32x2* xr = (u32x2*)((DRY ? F.XE() : F.XB(L)) + (size_t)m * DM) + lane;
            float s = 0.f;
#pragma unroll
            for (int j = 0; j < NJ; ++j) { u32x2 xo; xo.x = pk2(v[r][j][0], v[r][j][1]); xo.y = pk2(v[r][j][2], v[r][j][3]); xr[64 * j] = xo; s += (v[r][j][0] * v[r][j][0] + v[r][j][1] * v[r][j][1]) + (v[r][j][2] * v[r][j][2] + v[r][j][3] * v[r][j][3]); }
            const float rstd = frsqrt(wave_sum(s) * (1.f / DM) + NORM_EPS);
            if (lane == 0 && !DRY) F.RSTD()[M + m] = rstd;
        }
    }
}

__global__ void __launch_bounds__(NTHREADS, 2) mega_fwd(Args args) {
#ifndef HOST_EMU
    extern __shared__ __attribute__((aligned(16))) unsigned char lds_raw[];
    LAS unsigned char* lds = (LAS unsigned char*)lds_raw;
#else
    unsigned char* lds = emu::g_lds;
#endif
    Frame F;
    F.lds = lds; F.tid = threadIdx.x; F.lane = F.tid & 63; F.wave = rfl(F.tid >> 6); F.G = gridDim.x; F.wg = blockIdx.x; F.a = &args;
    unsigned char* ws = args.ws;
    const int lo = args.ph_lo, hi = args.ph_hi;
#ifndef HOST_EMU
    volatile LAS unsigned* MISC = (volatile LAS unsigned*)(lds + LDS_MISC);
    if (F.tid < 64) MISC[F.tid] = 0u;
    __syncthreads();
    XcdBarrier bar; bar.bar = (unsigned*)(ws + WS_CTL) + 4096; bar.x = 0; bar.st = MISC;
    if (hi - lo > 1) bar = xcd_barrier_post((unsigned*)(ws + WS_CTL) + 4096, MISC);
#define SEAM(k) do { if ((k) + 1 < hi) xcd_barrier(bar); } while (0)
#else
#define SEAM(k) do {} while (0)
#endif
#ifndef PH_MASK
#define PH_MASK 0xFFFFFFFFu
#endif
#ifndef DUP_MASK
#define DUP_MASK 0u
#endif
#define REPS(j) (int)(1u + ((DUP_MASK >> (j)) & 1u))
#define IN(k) (((PH_MASK >> (((k) == 0) ? 0 : (((k) - 1) % NPH) + 1)) & 1u) && lo <= (k) && (k) < hi)
#pragma unroll 1
    for (int L = -1; L < DEPTH; ++L) {
        const int pb = 1 + L * NPH;
        ASMV("" : "+v"(F.tid)); ASMV("" : "+s"(F.wg), "+s"(F.G)); F.lane = F.tid & 63; F.wave = rfl(F.tid >> 6);
        if (L >= 0 && IN(pb + 0)) { pw_experts(F, L, F.wg * NWAVES + F.wave, F.G * NWAVES); phase_pconv(F, L); SEAM(pb + 1); }
        if (L >= 0) {
        if (IN(pb + 2)) {
            pg8::Gemm g{F.XB(L), F.WIN(), M, INWP, DM, 0, 0, nullptr}; pg8::StaticOrder S; S.init(M, INWP, F.G, F.wg);
            pg8::EpiBf16 E{F.PROJ(), INWP, F.XPART(), 1.0f / DM, nullptr}; for (int rep = 0; rep < REPS(3); ++rep) pg8::gemm_phase(lds, g, S, E, F.tid);
            {
                const int nu = (M / 256) * (INWP / 256), rem = nu % F.G, g2 = rem ? (F.wg >= rem ? F.G - rem : (1 << 28)) : F.G, c2 = F.wg;
                pg8::Gemm ge{F.PB(), F.WPLE(), M, DM, PLE, 0, 0, nullptr}; pg8::StaticOrder Se; Se.init(M, DM, g2, c2);
                pg8::EpiBf16 Ee{F.XB(L + 1), DM, nullptr, 0.f, F.EPART()}; pg8::gemm_phase(lds, ge, Se, Ee, F.tid); }
            SEAM(pb + 2);
        }
        if (IN(pb + 3)) { for (int rep = 0; rep < REPS(4); ++rep) { gmlp_units(F, L); attnprep_units(F, L); gdnprep_units(F, L); } SEAM(pb + 3); }
        if (IN(pb + 4)) {
            int nsc = NCHAIN < (F.G * 3) / 4 ? NCHAIN : (F.G * 3) / 4; if (nsc < 1) nsc = 1;
            for (int rep = 0; rep < REPS(5); ++rep) {
            if (F.G == 1) { scan_chains(F, 0, 1); attn_units(F, L, 0, 1); }
            else if (F.wg < nsc) scan_chains(F, F.wg, nsc);
            else attn_units(F, L, F.wg - nsc, F.G - nsc);
            }
            SEAM(pb + 4);
        }
        if (IN(pb + 5)) { for (int rep = 0; rep < REPS(6); ++rep) phase_assemble(F, L); SEAM(pb + 5); }
        if (IN(pb + 6)) {
            pg8::Gemm g{F.ACT(), F.WOUT(), M, DM, DM, 0, 0, nullptr}; pg8::StaticOrder S; S.init(M, DM, F.G, F.wg);
            pg8::EpiResB E{F.XB(L), F.XB(L), DM}; pg8::gemm_phase(lds, g, S, E, F.tid); SEAM(pb + 6);
        }
        if (IN(pb + 7)) { for (int rep = 0; rep < REPS(8); ++rep) { phase_router(F, L); bsync(); } SEAM(pb + 7); }
        }
        if (L >= 0 ? IN(pb + 8) : IN(0)) {
            const int npair = BATCH * NEXP; int slot = F.wg, nslots = F.G;
            if (L >= 0) { phase_topk(F); if (F.G > npair) { slot = F.wg - npair; nslots = F.G - npair; } } else phase_prologue(F);
            bsync();
            if (L + 1 < DEPTH && slot >= 0) phase_pw(F, L + 1, slot, nslots);
            if (L >= 0) SEAM(pb + 8);
        }
        if (L >= 0) {
        if (IN(pb + 10)) {
            pg8::Gemm g{F.ACT(), F.WGU(), MR, 2 * DE, DM, ROWS_E / 256, (size_t)2 * DE * DM * 2, F.IDX()}; pg8::StaticOrder S; S.init(MR, 2 * DE, F.G, F.wg);
            pg8::EpiSwiGLU E{F.HID(), DE, F.RSROW()}; for (int rep = 0; rep < REPS(11); ++rep) pg8::gemm_phase<pg8::EpiSwiGLU, true>(lds, g, S, E, F.tid); SEAM(pb + 10);
        }
        if (IN(pb + 11)) {
            { pg8::Gemm g{F.HID(), F.WD(), MR, DM, DE, ROWS_E / 256, (size_t)DM * DE * 2, nullptr}; pg8::StaticOrder S; S.init(MR, DM, F.G, F.wg);
              pg8::EpiScaleBf16 E{F.YE(), DM, F.GATEV()}; for (int rep = 0; rep < REPS(12); ++rep) pg8::gemm_phase(lds, g, S, E, F.tid); }
            SEAM(pb + 11);
        }
        }
        if (L >= 0 ? IN(pb + 12) : IN(0)) {
            if (L >= 0) phase_combine<false>(F, L);
            if (L >= 0) SEAM(pb + 12); else SEAM(0);
        }
        if (L >= 0) {
        if (IN(pb + 13)) {
            pg8::Gemm g{F.XB(L), F.WPG(L), M, DM, DM, 0, 0, nullptr}; pg8::StaticOrder S; S.init(M, DM, F.G, F.wg);
            pg8::EpiPleGate E{F.XB(L), F.XB(L + 1), F.XB(L + 1), F.EPART(), F.g_ple() + (size_t)L * DM, F.XPART(), (L == DEPTH - 1) ? F.out() : (float*)nullptr, DM, F.RSTD() + M}; pg8::gemm_phase(lds, g, S, E, F.tid); SEAM(pb + 13);
        }
        }
    }
#undef IN
#undef SEAM
}

#ifndef N_LAUNCH_MODE
#define N_LAUNCH_MODE 1
#endif
extern "C" void kernel_launch(void* const* d_in, const int* in_sizes, int n_in, void* d_out, int out_size, void* d_ws, size_t ws_size, hipStream_t stream) {
    Args a;
    memset(&a, 0, sizeof(a));
    for (int i = 0; i < 25; ++i) a.in[i] = d_in[i];
    a.out = (float*)d_out; a.ws = (unsigned char*)d_ws;
#ifndef HOST_EMU
    static int grid = 0;
    if (grid == 0) {
        int dev = 0, cus = 0;
        if (n_in != 25 || out_size != M * DM || ws_size < WS_END) { fprintf(stderr, "kernel_launch: unexpected shapes (n_in %d out %d ws %zu need %zu)\n", n_in, out_size, ws_size, (size_t)WS_END); grid = -1; return; }
        if (hipGetDevice(&dev) != hipSuccess || hipDeviceGetAttribute(&cus, hipDeviceAttributeMultiprocessorCount, dev) != hipSuccess) { grid = -1; return; }
        if (hipFuncSetAttribute((const void*)mega_fwd, hipFuncAttributeMaxDynamicSharedMemorySize, LDS_BYTES) != hipSuccess) { fprintf(stderr, "kernel_launch: hipFuncSetAttribute failed\n"); grid = -1; return; }
        int per_cu = 0;
        if (hipOccupancyMaxActiveBlocksPerMultiprocessor(&per_cu, (const void*)mega_fwd, NTHREADS, LDS_BYTES) != hipSuccess || per_cu < 1) fprintf(stderr, "kernel_launch: occupancy query says %d\n", per_cu);
        (void)hipGetLastError();
        grid = cus;
    }
    if (grid < 0) return;
    (void)hipMemsetAsync((char*)d_ws + WS_CTL, 0, CTL_BYTES, stream);
    if (N_LAUNCH_MODE == 1) { a.ph_lo = 0; a.ph_hi = NPHASES; hipLaunchKernelGGL(mega_fwd, dim3(grid), dim3(NTHREADS), LDS_BYTES, stream, a); }
    else for (int ph = 0; ph < NPHASES; ++ph) { a.ph_lo = ph; a.ph_hi = ph + 1; hipLaunchKernelGGL(mega_fwd, dim3(grid), dim3(NTHREADS), LDS_BYTES, stream, a); }
#else
    (void)in_sizes; (void)n_in; (void)out_size; (void)ws_size; (void)stream;
    for (int ph = emu_ph_lo; ph < emu_ph_hi && ph < NPHASES; ++ph) { a.ph_lo = ph; a.ph_hi = ph + 1; Args aa = a; emu::launch([aa]() { mega_fwd(aa); }, emu_grid, NTHREADS, LDS_BYTES); fprintf(stderr, "phase %d done\n", ph); }
#endif
}
```

```cpp
#ifndef HOST_EMU
#include <hip/hip_runtime.h>
#include <cstdio>
#include <cstdint>
#include <cstring>
#define DEV __device__ __forceinline__
#define DEVM __device__ __forceinline__
#define LAS __attribute__((address_space(3)))
#define ASMV(...) asm volatile(__VA_ARGS__)
#else
#define DEV static inline
#define DEVM inline
#define LAS
#define ASMV(...) do {} while (0)
#define __global__
#define __launch_bounds__(...)
#endif

typedef unsigned short bf16_t;
typedef short bf16x8 __attribute__((ext_vector_type(8)));
typedef float f32x4 __attribute__((ext_vector_type(4)));
typedef float f32x16 __attribute__((ext_vector_type(16)));
typedef unsigned u32x4 __attribute__((ext_vector_type(4)));
typedef unsigned u32x2 __attribute__((ext_vector_type(2)));

#ifdef CFG_SMALL
constexpr int BATCH = 2, SEQ = 512, DM = 512, DEPTH = 2, NEXP = 4;
#else
constexpr int BATCH = 8, SEQ = 4096, DM = 1024, DEPTH = 4, NEXP = 16;
#endif
constexpr int PLE = 256, HD = 64;
constexpr int GW = DM / 4, GG = GW / HD, GCH = 128;
constexpr int BW = 3 * DM / 8, BH = BW / HD;
constexpr int CW = DM - GW - BW, CHN = CW / HD;
constexpr int CAP = 2 * SEQ / NEXP, DE = DM;
constexpr int M = BATCH * SEQ;
constexpr int O_AU = 0, O_AV = GW, O_BQ = 2 * GW, O_BK = O_BQ + BW, O_BV = O_BK + BW, O_CQKV = O_BV + BW, O_CG = O_CQKV + 3 * CW, O_CA = O_CG + CW, O_CB = O_CA + 2 * CHN, INW = O_CB + 2 * CHN;
constexpr int INWP = (INW + 255) / 256 * 256;
static_assert(INW % 4 == 0 && DM % 4 == 0 && DE % 4 == 0, "the weight conversion loads 16-byte row pieces");
constexpr int ROWS_E = BATCH * CAP, MR = NEXP * ROWS_E;
constexpr int NCH = SEQ / 64;
constexpr int NCHAIN = BATCH * CHN * 2;
constexpr int RECB = 40960;
constexpr float NORM_EPS = 1e-6f;
constexpr int NPH = 14, NPHASES = 1 + NPH * DEPTH;
constexpr int NTHREADS = 512, NWAVES = 8;
static_assert(M % 256 == 0 && ROWS_E % 256 == 0 && DM % 256 == 0 && SEQ % 256 == 0, "shape");

constexpr size_t al4k(size_t x) { return (x + 4095) & ~(size_t)4095; }
constexpr size_t WS_CTL = 0, CTL_BYTES = 1u << 20;
constexpr size_t WS_ROPE = WS_CTL + CTL_BYTES;
constexpr size_t WS_AFF = WS_ROPE + al4k((size_t)M * 16 * 4);
constexpr size_t WS_IDX = WS_AFF + al4k((size_t)BATCH * NEXP * SEQ * 4);
constexpr size_t WS_GATEV = WS_IDX + al4k((size_t)MR * 4);
constexpr size_t WS_INV = WS_GATEV + al4k((size_t)MR * 4);
constexpr size_t WS_DEN = WS_INV + al4k((size_t)M * NEXP * 4);
constexpr size_t WS_GAM = WS_DEN + al4k((size_t)3 * M * BH * 4);
constexpr size_t WS_XPART = WS_GAM + al4k((size_t)NCHAIN * NCH * 4);
constexpr size_t WS_EPART = WS_XPART + al4k((size_t)M * 16 * 4);
constexpr size_t WS_RSTD = WS_EPART + al4k((size_t)M * 16 * 4);
constexpr size_t WS_RSROW = WS_RSTD + al4k((size_t)2 * M * 4);
constexpr size_t WS_PB = WS_RSROW + al4k((size_t)MR * 4);
constexpr size_t WS_WS16 = WS_PB + al4k((size_t)M * PLE * 2);
constexpr size_t WS_WIN = WS_WS16 + al4k((size_t)GG * 128 * 128 * 2);
constexpr size_t WS_WOUT = WS_WIN + al4k((size_t)INWP * DM * 2);
constexpr size_t WS_WGU = WS_WOUT + al4k((size_t)DM * DM * 2);
constexpr size_t WS_WD = WS_WGU + al4k((size_t)NEXP * 2 * DE * DM * 2);
constexpr size_t WS_WPLE = WS_WD + al4k((size_t)NEXP * DM * DE * 2);
constexpr size_t WS_WPG = WS_WPLE + al4k((size_t)DM * PLE * 2);
constexpr size_t WS_XB = WS_WPG + 2 * al4k((size_t)DM * DM * 2);
constexpr size_t WS_ACT = WS_XB + 2 * al4k((size_t)M * DM * 2);
constexpr size_t WS_BIG = WS_ACT + al4k((size_t)M * DM * 2);
constexpr size_t WS_PROJ = WS_BIG;
constexpr size_t WS_QN = WS_PROJ + al4k((size_t)M * INWP * 2);
constexpr size_t WS_KN = WS_QN + al4k((size_t)M * BW * 2);
constexpr size_t WS_VT = WS_KN + al4k((size_t)M * BW * 2);
constexpr size_t VT_STRIDE = al4k((size_t)M * BW * 2);
constexpr size_t WS_NUM = WS_VT + 3 * VT_STRIDE;
constexpr size_t WS_REC = WS_NUM + 3 * VT_STRIDE;
constexpr size_t WS_OF = WS_REC + al4k((size_t)NCHAIN * NCH * RECB);
constexpr size_t WS_MIXEND = WS_OF + al4k((size_t)2 * M * CW * 2);
constexpr size_t WS_XE = WS_BIG;
constexpr size_t WS_HID = WS_XE + al4k((size_t)MR * DM * 2);
constexpr size_t WS_YE = WS_HID + al4k((size_t)MR * DE * 2);
constexpr size_t WS_ERAW = WS_YE + al4k((size_t)MR * DM * 2);
constexpr size_t WS_MOEEND = WS_ERAW + al4k((size_t)M * DM * 2);
constexpr size_t WS_END = WS_MIXEND > WS_MOEEND ? WS_MIXEND : WS_MOEEND;
#ifndef CFG_SMALL
static_assert(WS_END <= ((size_t)1 << 30), "workspace must fit 1 GiB");
#endif

DEV float bf2f(bf16_t b) { unsigned u = ((unsigned)b) << 16; return __builtin_bit_cast(float, u); }
#ifndef HOST_EMU
typedef __bf16 hwbf16x2 __attribute__((ext_vector_type(2)));
typedef float hwf32x2 __attribute__((ext_vector_type(2)));
DEV unsigned pk2(float lo, float hi) { return __builtin_bit_cast(unsigned, __builtin_convertvector((hwf32x2){lo, hi}, hwbf16x2)); }
DEV unsigned f2bf(float f) { return (unsigned)__builtin_bit_cast(unsigned short, (__bf16)f); }
#else
DEV unsigned f2bf(float f) { unsigned u = __builtin_bit_cast(unsigned, f); return (u + 0x7fffu + ((u >> 16) & 1u)) >> 16; }
DEV unsigned pk2(float lo, float hi) { return f2bf(lo) | (f2bf(hi) << 16); }
#endif
DEV float lo16(unsigned w) { return __builtin_bit_cast(float, w << 16); }
DEV float hi16(unsigned w) { return __builtin_bit_cast(float, w & 0xffff0000u); }
#ifndef HOST_EMU
DEV f32x4 mfma16(bf16x8 a, bf16x8 b, f32x4 c) { return __builtin_amdgcn_mfma_f32_16x16x32_bf16(a, b, c, 0, 0, 0); }
DEV f32x16 mfma32(bf16x8 a, bf16x8 b, f32x16 c) { return __builtin_amdgcn_mfma_f32_32x32x16_bf16(a, b, c, 0, 0, 0); }
DEV float shx(float v, int m) { return __shfl_xor(v, m); }
DEV unsigned shup(unsigned v, int d) { return __shfl_up(v, d); }
DEV int shfl_i(int v, int src) { return __shfl(v, src); }
DEV unsigned long long ballot_(bool p) { return __ballot(p); }
DEV void bsync() { __syncthreads(); }
DEV void wsync() { __builtin_amdgcn_wave_barrier(); }
DEV void rawbar() { __builtin_amdgcn_s_barrier(); }
DEV void lbar() { asm volatile("s_waitcnt lgkmcnt(0)" ::: "memory"); __builtin_amdgcn_s_barrier(); asm volatile("" ::: "memory"); }
DEV void glds16(const void* g, LAS void* l) { __builtin_amdgcn_global_load_lds((const unsigned*)g, (LAS unsigned*)l, 16, 0, 0); }
DEV void glds4(const void* g, LAS void* l) { __builtin_amdgcn_global_load_lds((const unsigned*)g, (LAS unsigned*)l, 4, 0, 0); }
DEV float fexp(float x) { return __expf(x); }
DEV float flog(float x) { return __logf(x); }
DEV float frsqrt(float x) { return rsqrtf(x); }
DEV float frcp(float x) { return __builtin_amdgcn_rcpf(x); }
DEV int rfl(int v) { return __builtin_amdgcn_readfirstlane(v); }
#define SETPRIO(n) __builtin_amdgcn_s_setprio(n)
#define SCHEDB() __builtin_amdgcn_sched_barrier(0)
#else
DEV f32x4 mfma16(bf16x8 a, bf16x8 b, f32x4 c) { return emu_mfma16(a, b, c); }
DEV f32x16 mfma32(bf16x8 a, bf16x8 b, f32x16 c) { return emu_mfma32(a, b, c); }
DEV float shx(float v, int m) { return emu_shfl_xor(v, m); }
DEV unsigned shup(unsigned v, int d) { return emu_shfl_up(v, d); }
DEV int shfl_i(int v, int src) { return emu_shfl(v, src); }
DEV unsigned long long ballot_(bool p) { return emu_ballot(p ? 1 : 0); }
DEV void bsync() { emu::block_barrier(); }
DEV void wsync() { int d = 0, all[64]; emu::wave_all(d, all); }
DEV void rawbar() { emu::block_barrier(); }
DEV void lbar() { emu::block_barrier(); }
DEV void glds16(const void* g, void* l) { memcpy((char*)l + (threadIdx.x & 63) * 16, g, 16); }
DEV void glds4(const void* g, void* l) { memcpy((char*)l + (threadIdx.x & 63) * 4, g, 4); }
DEV float fexp(float x) { return expf(x); }
DEV float flog(float x) { return logf(x); }
DEV float frsqrt(float x) { return 1.0f / sqrtf(x); }
DEV float frcp(float x) { return 1.0f / x; }
DEV int rfl(int v) { return v; }
#define SETPRIO(n) do {} while (0)
#define SCHEDB() do {} while (0)
#endif
DEV float wave_sum(float v) {
#pragma unroll
    for (int o = 1; o < 64; o <<= 1) v += shx(v, o);
    return v;
}
DEV float wave_max(float v) {
#pragma unroll
    for (int o = 1; o < 64; o <<= 1) v = fmaxf(v, shx(v, o));
    return v;
}
DEV float gelu_tanh(float x) { const float y = 0.7978845608028654f * (x + 0.044715f * x * x * x); const float e = fexp(2.0f * y); return 0.5f * x * (2.0f - 2.0f * frcp(e + 1.0f)); }
DEV float sigmoidf_(float x) { return frcp(1.0f + fexp(-x)); }
DEV float siluf_(float x) { return x * sigmoidf_(x); }
DEV float softplusf_(float x) { return x > 20.f ? x : flog(1.0f + fexp(x)); }
DEV void unpack8(u32x4 r, float* v) { v[0] = lo16(r.x); v[1] = hi16(r.x); v[2] = lo16(r.y); v[3] = hi16(r.y); v[4] = lo16(r.z); v[5] = hi16(r.z); v[6] = lo16(r.w); v[7] = hi16(r.w); }
DEV u32x4 pack8(const float* v) { u32x4 r; r.x = pk2(v[0], v[1]); r.y = pk2(v[2], v[3]); r.z = pk2(v[4], v[5]); r.w = pk2(v[6], v[7]); return r; }

namespace pg8 {
constexpr int BM = 256, BK = 64, HALF = 128, HTB = HALF * BK * 2, STAGE_BYTES = 8 * HTB, NXCD = 8, WGM = 8;
DEV int lds_byte(int r, int c) { const int st = (r >> 4) * 2 + (c >> 5), rr = r & 15, cc = c & 31, ob = rr * 64 + cc * 2; return st * 1024 + (ob ^ (((ob >> 9) & 1) << 5)); }
DEV void stage_rc(int b, int& R, int& C) { const int st = b / 1024, sb = b % 1024, swz = sb ^ (((sb >> 9) & 1) << 5); R = (st >> 1) * 16 + swz / 64; C = (st & 1) * 32 + (swz % 64) / 2; }
DEV int perm32(int rho) { const int n = rho >> 4, i = rho & 15; return 8 * (i >> 2) + 4 * n + (i & 3); }
struct Unit { int pm, pn; };
struct Gemm { const bf16_t* A; const bf16_t* Bt; int M, N, K; int grp_tiles; size_t grp_stride; const int* gidx; };
struct StaticOrder {
    int nM, nN, nwg, G, c;
    DEVM void init(int M_, int N_, int G_, int c_) { nM = M_ / BM; nN = N_ / BM; nwg = nM * nN; G = G_; c = c_; }
    DEVM bool next(int i, Unit& u) const {
        const long L = (long)i * G + c; if (L >= nwg) return false;
        int wgid = (int)L; { const int q = nwg / NXCD, r = nwg % NXCD, xcd = wgid % NXCD, off = wgid / NXCD; wgid = (xcd < r ? xcd * (q + 1) : r * (q + 1) + (xcd - r) * q) + off; }
        const int nig = WGM * nN, gid = wgid / nig, fm = gid * WGM, gsz = (nM - fm) < WGM ? (nM - fm) : WGM;
        u.pm = fm + ((wgid % nig) % gsz); u.pn = (wgid % nig) / gsz; return true;
    }
};
template <class Epi, bool GATHER = false>
DEV void gemm_phase(LAS unsigned char* lds, const Gemm g, const StaticOrder& S, const Epi& E, const int tid) {
    const int wid = rfl(tid >> 6), lane = tid & 63, wr = wid >> 2, wc = wid & 3, fr = lane & 15, fq = lane >> 4;
    const int K = g.K, nt = K / BK;
    unsigned voffA[2], voffB[2]; int rowA[2], colA2[2];
#pragma unroll
    for (int i = 0; i < 2; ++i) { int R, C; stage_rc(tid * 16 + i * 8192, R, C); const int Rb = Epi::PERM ? ((R & ~31) + perm32(R & 31)) : R;
        voffA[i] = (unsigned)(R * K + C) * 2u; voffB[i] = (unsigned)(Rb * K + C) * 2u; rowA[i] = R; colA2[i] = C * 2; }
    unsigned cro[2][2], nro[2][2];
#define PG8_ROFF(dst, u) do { _Pragma("unroll") for (int _h = 0; _h < 2; ++_h) _Pragma("unroll") for (int _i = 0; _i < 2; ++_i) { const int _r = (u).pm * BM + _h * HALF + rowA[_i]; \
        dst[_h][_i] = (unsigned)(((_r / CAP) % BATCH) * SEQ + g.gidx[_r]) * (unsigned)(K * 2) + (unsigned)colA2[_i]; } } while (0)
    const size_t kstep = (size_t)(BK * 2);
    const size_t hstep = (size_t)HALF * K * 2;
    const size_t tstep = 2 * hstep;
    const unsigned ldsw = (unsigned)wid * 1024u;
    const int aoff = lds_byte(wr * 64 + fr, fq * 8), boff = lds_byte(wc * 32 + fr, fq * 8);
#define PG8_SA(b, h) (((b) * 2 + (h)) * HTB)
#define PG8_SB(b, h) ((4 + (b) * 2 + (h)) * HTB)
#define PG8_STAGE(bufoff, gbase, voff) do { _Pragma("unroll") for (int _i = 0; _i < 2; ++_i) \
        glds16((const char*)(gbase) + (voff)[_i], lds + (bufoff) + ldsw + _i * 8192); } while (0)
#define PG8_STAGE_A(bufoff, ubase, kofs, h, ro) do { if (GATHER) { PG8_STAGE(bufoff, (const char*)g.A + (kofs), (ro)[h]); } else { PG8_STAGE(bufoff, (ubase) + (h) * hstep + (kofs), voffA); } } while (0)
#define PG8_LDA(dst, b, h) do { _Pragma("unroll") for (int m = 0; m < 4; ++m) _Pragma("unroll") for (int k = 0; k < 2; ++k) dst[m][k] = *(const LAS bf16x8*)(lds + PG8_SA(b, h) + aoff + m * 2048 + k * 1024); } while (0)
#define PG8_LDB(dst, b, h) do { _Pragma("unroll") for (int n = 0; n < 2; ++n) _Pragma("unroll") for (int k = 0; k < 2; ++k) dst[n][k] = *(const LAS bf16x8*)(lds + PG8_SB(b, h) + boff + n * 2048 + k * 1024); } while (0)
#define PG8_MMA(ai, bj, At, Bt) do { SETPRIO(1); _Pragma("unroll") for (int m = 0; m < 4; ++m) _Pragma("unroll") for (int n = 0; n < 2; ++n) _Pragma("unroll") for (int k = 0; k < 2; ++k) \
        acc[ai][bj][m][n] = mfma16(Bt[n][k], At[m][k], acc[ai][bj][m][n]); SETPRIO(0); } while (0)
#define PG8_WAIT_V(n) ASMV("s_waitcnt vmcnt(" #n ")" ::: "memory")
#define PG8_WAIT_L(n) ASMV("s_waitcnt lgkmcnt(" #n ")" ::: "memory")
#define PG8_BAR rawbar()
#define PG8_SCHED SCHEDB()
#define PG8_BBASE(u) ((const char*)g.Bt + (g.grp_tiles ? (size_t)((u).pm / g.grp_tiles) * g.grp_stride : (size_t)0) + (size_t)(u).pn * tstep)
    Unit cur, nxt; int ui = 0;
    if (!S.next(0, cur)) return;
    f32x4 acc[2][2][4][2];
#pragma unroll
    for (int a = 0; a < 2; ++a)
#pragma unroll
        for (int b = 0; b < 2; ++b)
#pragma unroll
            for (int m = 0; m < 4; ++m)
#pragma unroll
                for (int n = 0; n < 2; ++n) acc[a][b][m][n] = (f32x4){0.f, 0.f, 0.f, 0.f};
    bf16x8 At[4][2], B0[2][2], B1[2][2];
    const char* cA = (const char*)g.A + (size_t)cur.pm * tstep; const char* cB = PG8_BBASE(cur);
    if (GATHER) { PG8_ROFF(cro, cur); PG8_ROFF(nro, cur); }
    const int krot = (2 * (S.c & 7)) & (nt - 1);
#define PG8_KO(kt) ((size_t)(((kt) + krot) & (nt - 1)) * kstep)
    const size_t kb0 = PG8_KO(0);
    PG8_STAGE(PG8_SB(0, 0), cB + kb0, voffB); PG8_STAGE(PG8_SB(0, 1), cB + hstep + kb0, voffB); PG8_STAGE_A(PG8_SA(0, 0), cA, kb0, 0, cro); PG8_STAGE_A(PG8_SA(0, 1), cA, kb0, 1, cro);
    if (wr == 1) PG8_BAR;
    PG8_WAIT_V(2); PG8_BAR;
    PG8_STAGE(PG8_SB(1, 0), cB + kb0 + kstep, voffB); PG8_STAGE_A(PG8_SA(1, 0), cA, kb0 + kstep, 0, cro); PG8_STAGE(PG8_SB(1, 1), cB + hstep + kb0 + kstep, voffB);
    PG8_WAIT_V(6); PG8_BAR;
    for (;;) {
        const bool has_next = S.next(ui + 1, nxt);
        const char* nA = has_next ? (const char*)g.A + (size_t)nxt.pm * tstep : cA; const char* nB = has_next ? PG8_BBASE(nxt) : cB;
        if (GATHER && has_next) PG8_ROFF(nro, nxt);
        for (int t = 0; t < nt; t += 2) {
            const bool last = (t == nt - 2);
            const size_t k1 = PG8_KO(t) + kstep, k2 = PG8_KO(last ? 0 : t + 2), k3 = k2 + kstep;
            const char* a2u = last ? nA : cA; const char* b2 = (last ? nB : cB) + k2;
            const char* b3 = b2 + kstep;
            unsigned ro2[2][2];
#pragma unroll
            for (int _h = 0; _h < 2; ++_h)
#pragma unroll
                for (int _i = 0; _i < 2; ++_i) ro2[_h][_i] = last ? nro[_h][_i] : cro[_h][_i];
            PG8_LDB(B0, 0, 0); PG8_LDB(B1, 0, 1); PG8_SCHED; PG8_LDA(At, 0, 0); PG8_STAGE_A(PG8_SA(1, 1), cA, k1, 1, cro);
            PG8_WAIT_V(8); PG8_WAIT_L(0); PG8_BAR; PG8_MMA(0, 0, At, B0); PG8_MMA(0, 1, At, B1); PG8_BAR; PG8_SCHED;
            PG8_LDA(At, 0, 1); PG8_STAGE(PG8_SB(0, 0), b2, voffB); PG8_STAGE(PG8_SB(0, 1), b2 + hstep, voffB); PG8_STAGE_A(PG8_SA(0, 0), a2u, k2, 0, ro2);
            PG8_WAIT_V(8); PG8_WAIT_L(0); PG8_BAR; PG8_MMA(1, 0, At, B0); PG8_MMA(1, 1, At, B1); PG8_BAR; PG8_SCHED;
            PG8_LDB(B0, 1, 0); PG8_LDB(B1, 1, 1); PG8_SCHED; PG8_LDA(At, 1, 0); PG8_STAGE_A(PG8_SA(0, 1), a2u, k2, 1, ro2);
            PG8_WAIT_V(8); PG8_WAIT_L(0); PG8_BAR; PG8_MMA(0, 0, At, B0); PG8_MMA(0, 1, At, B1); PG8_BAR; PG8_SCHED;
            PG8_LDA(At, 1, 1); PG8_STAGE(PG8_SB(1, 0), b3, voffB); PG8_STAGE(PG8_SB(1, 1), b3 + hstep, voffB); PG8_STAGE_A(PG8_SA(1, 0), a2u, k3, 0, ro2);
            PG8_WAIT_V(8); PG8_WAIT_L(0); PG8_BAR; PG8_MMA(1, 0, At, B0); PG8_MMA(1, 1, At, B1); PG8_BAR; PG8_SCHED;
        }
        if (wr == 0) PG8_BAR;
        E(acc, cur, wr, wc, fr, fq);
        if (!has_next) break;
#pragma unroll
        for (int a = 0; a < 2; ++a)
#pragma unroll
            for (int b = 0; b < 2; ++b)
#pragma unroll
                for (int m = 0; m < 4; ++m)
#pragma unroll
                    for (int n = 0; n < 2; ++n) acc[a][b][m][n] = (f32x4){0.f, 0.f, 0.f, 0.f};
        cur = nxt; cA = nA; cB = nB; ++ui;
        if (wr == 1) PG8_BAR;
        if (GATHER) {
#pragma unroll
            for (int _h = 0; _h < 2; ++_h)
#pragma unroll
                for (int _i = 0; _i < 2; ++_i) cro[_h][_i] = nro[_h][_i]; }
    }
    PG8_WAIT_V(0);
    PG8_BAR;
#undef PG8_SA
#undef PG8_SB
#undef PG8_STAGE
#undef PG8_STAGE_A
#undef PG8_ROFF
#undef PG8_LDA
#undef PG8_LDB
#undef PG8_MMA
#undef PG8_WAIT_V
#undef PG8_WAIT_L
#undef PG8_BAR
#undef PG8_SCHED
#undef PG8_BBASE
#undef PG8_KO
}
constexpr int NPART = 16;
DEV float part_rstd(const float* part, int row, float inv_n, int fq) {
    const f32x4 a = *((const f32x4*)(part + (size_t)row * NPART) + fq);
    float s = (a[0] + a[1]) + (a[2] + a[3]);
    s += shx(s, 16); s += shx(s, 32);
    return frsqrt(s * inv_n + NORM_EPS);
}
struct EpiBf16 {
    static constexpr bool PERM = true;
    bf16_t* O; int ldc; const float* rs_part; float rs_inv_n; float* out_part;
    DEVM void operator()(const f32x4 (&acc)[2][2][4][2], const Unit& u, int wr, int wc, int fr, int fq) const {
        const int row0 = u.pm * BM + wr * 64 + fr, col0 = u.pn * BM + wc * 32 + 8 * fq;
#pragma unroll
        for (int ai = 0; ai < 2; ++ai)
#pragma unroll
            for (int m = 0; m < 4; ++m) { const int row = row0 + ai * HALF + m * 16; bf16_t* rowp = O + (size_t)row * ldc + col0;
                const float rs = rs_part ? part_rstd(rs_part, row, rs_inv_n, fq) : 1.0f; float ss = 0.f;
#pragma unroll
                for (int bj = 0; bj < 2; ++bj) { const f32x4 v0 = acc[ai][bj][m][0] * rs, v1 = acc[ai][bj][m][1] * rs;
                    ss += ((v0[0] * v0[0] + v0[1] * v0[1]) + (v0[2] * v0[2] + v0[3] * v0[3])) + ((v1[0] * v1[0] + v1[1] * v1[1]) + (v1[2] * v1[2] + v1[3] * v1[3]));
                    u32x4 w; w.x = pk2(v0[0], v0[1]); w.y = pk2(v0[2], v0[3]); w.z = pk2(v1[0], v1[1]); w.w = pk2(v1[2], v1[3]);
                    *(u32x4*)(rowp + bj * HALF) = w; }
                if (out_part) { ss += shx(ss, 16); ss += shx(ss, 32); if (fq == 0) out_part[(size_t)row * NPART + u.pn * 4 + wc] = ss; } }
    }
};
struct EpiResB {
    static constexpr bool PERM = true;
    const bf16_t* res; bf16_t* out; int ldc;
    DEVM void operator()(const f32x4 (&acc)[2][2][4][2], const Unit& u, int wr, int wc, int fr, int fq) const {
        const int row0 = u.pm * BM + wr * 64 + fr, col0 = u.pn * BM + wc * 32 + 8 * fq;
#pragma unroll
        for (int ai = 0; ai < 2; ++ai) {
            u32x4 r[4][2];
#pragma unroll
            for (int m = 0; m < 4; ++m) { const size_t off = (size_t)(row0 + ai * HALF + m * 16) * ldc + col0;
#pragma unroll
                for (int bj = 0; bj < 2; ++bj) r[m][bj] = *(const u32x4*)(res + off + bj * HALF); }
#pragma unroll
            for (int m = 0; m < 4; ++m) { const size_t off = (size_t)(row0 + ai * HALF + m * 16) * ldc + col0;
#pragma unroll
                for (int bj = 0; bj < 2; ++bj) { const f32x4 a0 = acc[ai][bj][m][0], a1 = acc[ai][bj][m][1]; const u32x4 y = r[m][bj];
                    u32x4 o; o.x = pk2(lo16(y.x) + a0[0], hi16(y.x) + a0[1]); o.y = pk2(lo16(y.y) + a0[2], hi16(y.y) + a0[3]); o.z = pk2(lo16(y.z) + a1[0], hi16(y.z) + a1[1]); o.w = pk2(lo16(y.w) + a1[2], hi16(y.w) + a1[3]);
                    *(u32x4*)(out + off + bj * HALF) = o; } }
        }
    }
};
struct EpiSwiGLU {
    static constexpr bool PERM = true;
    bf16_t* O; int ldc; const float* rstd;
    DEVM void operator()(const f32x4 (&acc)[2][2][4][2], const Unit& u, int wr, int wc, int fr, int fq) const {
        const int row0 = u.pm * BM + wr * 64 + fr, col0 = u.pn * HALF + wc * 32 + 8 * fq;
        float rs[2][4];
#pragma unroll
        for (int ai = 0; ai < 2; ++ai)
#pragma unroll
            for (int m = 0; m < 4; ++m) rs[ai][m] = 1.0f;
#pragma unroll
        for (int ai = 0; ai < 2; ++ai)
#pragma unroll
            for (int m = 0; m < 4; ++m) { bf16_t* rowp = O + (size_t)(row0 + ai * HALF + m * 16) * ldc + col0;
                float h[8];
#pragma unroll
                for (int n = 0; n < 2; ++n)
#pragma unroll
                    for (int i = 0; i < 4; ++i) { const float gt = acc[ai][0][m][n][i] * rs[ai][m], up = acc[ai][1][m][n][i] * rs[ai][m]; h[n * 4 + i] = siluf_(gt) * up; }
                *(u32x4*)rowp = pack8(h); }
    }
};
struct EpiScaleBf16 {
    static constexpr bool PERM = true;
    bf16_t* O; int ldc; const float* rowscale;
    DEVM void operator()(const f32x4 (&acc)[2][2][4][2], const Unit& u, int wr, int wc, int fr, int fq) const {
        const int row0 = u.pm * BM + wr * 64 + fr, col0 = u.pn * BM + wc * 32 + 8 * fq;
#pragma unroll
        for (int ai = 0; ai < 2; ++ai)
#pragma unroll
            for (int m = 0; m < 4; ++m) { const int row = row0 + ai * HALF + m * 16; const float sc = rowscale[row]; bf16_t* rowp = O + (size_t)row * ldc + col0;
#pragma unroll
                for (int bj = 0; bj < 2; ++bj) { const f32x4 v0 = acc[ai][bj][m][0] * sc, v1 = acc[ai][bj][m][1] * sc;
                    u32x4 w; w.x = pk2(v0[0], v0[1]); w.y = pk2(v0[2], v0[3]); w.z = pk2(v1[0], v1[1]); w.w = pk2(v1[2], v1[3]);
                    *(u32x4*)(rowp + bj * HALF) = w; } }
    }
};
struct EpiPleGate {
    static constexpr bool PERM = true;
    const bf16_t* x; bf16_t* xo; const bf16_t* eraw; const float* epart; const float* gple; float* xpart; float* outf; int ldc; const float* rstd;
    DEVM void operator()(const f32x4 (&acc)[2][2][4][2], const Unit& u, int wr, int wc, int fr, int fq) const {
        const int row0 = u.pm * BM + wr * 64 + fr, col0 = u.pn * BM + wc * 32 + 8 * fq;
        f32x4 gp[2][2];
#pragma unroll
        for (int bj = 0; bj < 2; ++bj)
#pragma unroll
            for (int n = 0; n < 2; ++n) gp[bj][n] = *(const f32x4*)(gple + col0 + bj * HALF + n * 4);
#pragma unroll
        for (int ai = 0; ai < 2; ++ai)
#pragma unroll
            for (int mp = 0; mp < 2; ++mp) {
                u32x4 r[2][2], e2[2][2]; float ers[2], xrs[2];
#pragma unroll
                for (int mm = 0; mm < 2; ++mm) { const int row = row0 + ai * HALF + (2 * mp + mm) * 16; const size_t off = (size_t)row * ldc + col0;
                    ers[mm] = part_rstd(epart, row, 1.0f / DM, fq); xrs[mm] = rstd[row];
#pragma unroll
                    for (int bj = 0; bj < 2; ++bj) { r[mm][bj] = *(const u32x4*)(x + off + bj * HALF); e2[mm][bj] = *(const u32x4*)(eraw + off + bj * HALF); } }
                f32x4 wv[2][2][2];
#pragma unroll
                for (int mm = 0; mm < 2; ++mm) { float ss = 0.f; const int row = row0 + ai * HALF + (2 * mp + mm) * 16;
#pragma unroll
                    for (int bj = 0; bj < 2; ++bj)
#pragma unroll
                        for (int n = 0; n < 2; ++n) { const f32x4 a = acc[ai][bj][2 * mp + mm][n] * xrs[mm]; const f32x4 g = gp[bj][n] * ers[mm];
                            const unsigned r0 = n ? r[mm][bj].z : r[mm][bj].x, r1 = n ? r[mm][bj].w : r[mm][bj].y, e0 = n ? e2[mm][bj].z : e2[mm][bj].x, e1 = n ? e2[mm][bj].w : e2[mm][bj].y;
                            f32x4 w; w[0] = lo16(r0) + lo16(e0) * g[0] * sigmoidf_(a[0]); w[1] = hi16(r0) + hi16(e0) * g[1] * sigmoidf_(a[1]); w[2] = lo16(r1) + lo16(e1) * g[2] * sigmoidf_(a[2]); w[3] = hi16(r1) + hi16(e1) * g[3] * sigmoidf_(a[3]);
                            ss += (w[0] * w[0] + w[1] * w[1]) + (w[2] * w[2] + w[3] * w[3]); wv[mm][bj][n] = w; }
                    ss += shx(ss, 16); ss += shx(ss, 32); if (!outf && fq == 0) xpart[(size_t)row * NPART + u.pn * 4 + wc] = ss; }
                if (outf) {
#pragma unroll
                    for (int mm = 0; mm < 2; ++mm) { const size_t off = (size_t)(row0 + ai * HALF + (2 * mp + mm) * 16) * ldc + col0;
#pragma unroll
                        for (int bj = 0; bj < 2; ++bj)
#pragma unroll
                            for (int n = 0; n < 2; ++n) *(f32x4*)(outf + off + bj * HALF + n * 4) = wv[mm][bj][n]; }
                } else {
#pragma unroll
                    for (int mm = 0; mm < 2; ++mm) { const size_t off = (size_t)(row0 + ai * HALF + (2 * mp + mm) * 16) * ldc + col0;
#pragma unroll
                        for (int bj = 0; bj < 2; ++bj) { const f32x4 w0 = wv[mm][bj][0], w1 = wv[mm][bj][1]; u32x4 o; o.x = pk2(w0[0], w0[1]); o.y = pk2(w0[2], w0[3]); o.z = pk2(w1[0], w1[1]); o.w = pk2(w1[2], w1[3]); *(u32x4*)(xo + off + bj * HALF) = o; } }
                }
            }
    }
};
}

#ifndef HOST_EMU
#define XB_TMO      128
#define XB_XCNT(j)  (256  + 64 * (j))
#define XB_XSUB(j)  (1280 + 64 * (j))
#define XB_XGEN(j)  (2304 + 64 * (j))
#define XB_TOP      3328
#define XB_TOPGEN   3392
#define XCD_BAR_WORDS 3456
#define XB_SPIN_CAP (1u << 22)
__device__ __forceinline__ unsigned xb_ld(unsigned* p)              { return __hip_atomic_load(p, __ATOMIC_RELAXED, __HIP_MEMORY_SCOPE_AGENT); }
__device__ __forceinline__ unsigned xb_add(unsigned* p, unsigned v) { return __hip_atomic_fetch_add(p, v, __ATOMIC_RELAXED, __HIP_MEMORY_SCOPE_AGENT); }
__device__ __forceinline__ unsigned xb_xcc_id() { return (unsigned)__builtin_amdgcn_s_getreg((3 << 11) | 20) & 0xFu; }
#define XB_SPIN(cond, bar) do { unsigned _sp = 0; while (cond) { __builtin_amdgcn_s_sleep(1); \
    if ((++_sp & 255u) == 0u) { if (xb_ld(&(bar)[XB_TMO])) break; if (_sp > XB_SPIN_CAP) { atomicAdd(&(bar)[XB_TMO], 1u); break; } } } } while (0)
struct XcdBarrier { unsigned* bar; unsigned x; volatile LAS unsigned* st; };
__device__ __forceinline__ XcdBarrier xcd_barrier_post(unsigned* bar, volatile LAS unsigned* st) {
    XcdBarrier b; b.bar = bar; b.x = xb_xcc_id(); b.st = st;
    if (threadIdx.x == 0) (void)xb_add(&bar[XB_XCNT(b.x)], 1u);
    return b;
}
__device__ __forceinline__ void xcd_barrier_complete(unsigned* bar, unsigned x, unsigned& nloc, unsigned& nx) {
    const unsigned G = gridDim.x * gridDim.y * gridDim.z;
    unsigned sum, cnt, mine, sp = 0u;
    for (;;) {
        sum = 0u; cnt = 0u; mine = 0u;
#pragma unroll
        for (unsigned j = 0; j < 16; ++j) { const unsigned c = xb_ld(&bar[XB_XCNT(j)]); sum += c; cnt += (c > 0u) ? 1u : 0u; mine = (j == x) ? c : mine; }
        if (sum == G) break;
        __builtin_amdgcn_s_sleep(1);
        if ((++sp & 255u) == 0u) { if (xb_ld(&bar[XB_TMO])) break; if (sp > XB_SPIN_CAP) { atomicAdd(&bar[XB_TMO], 1u); break; } }
    }
    nloc = mine > 0u ? mine : 1u; nx = cnt > 0u ? cnt : 1u;
}
__device__ __forceinline__ void xcd_barrier(const XcdBarrier& b) {
    asm volatile("s_waitcnt vmcnt(0)" ::: "memory");
    __syncthreads();
    if (threadIdx.x == 0) {
        unsigned* bar = b.bar;
        __builtin_amdgcn_s_waitcnt(0);
        unsigned nloc = b.st[0], nx = b.st[1];
        if (nloc == 0u) { xcd_barrier_complete(bar, b.x, nloc, nx); b.st[0] = nloc; b.st[1] = nx; }
        const unsigned old = xb_add(&bar[XB_XSUB(b.x)], 1u);
        const unsigned gen = old / nloc;
        if (old + 1u == (gen + 1u) * nloc) {
            __builtin_amdgcn_fence(__ATOMIC_RELEASE, "agent");
            asm volatile("s_waitcnt vmcnt(0)" ::: "memory");
            const unsigned og = xb_add(&bar[XB_TOP], 1u);
            const unsigned tg = og / nx;
            if (og + 1u == (tg + 1u) * nx) xb_add(&bar[XB_TOPGEN], 1u);
            else XB_SPIN(xb_ld(&bar[XB_TOPGEN]) == tg, bar);
            __builtin_amdgcn_fence(__ATOMIC_ACQUIRE, "agent");
            xb_add(&bar[XB_XGEN(b.x)], 1u);
            asm volatile("s_waitcnt vmcnt(0)" ::: "memory");
        } else {
            XB_SPIN(xb_ld(&bar[XB_XGEN(b.x)]) == gen, bar);
            __builtin_amdgcn_fence(__ATOMIC_ACQUIRE, "agent");
            asm volatile("s_waitcnt vmcnt(0)" ::: "memory");
        }
    }
    __syncthreads();
}
#endif

constexpr int LDS_STAGE = 131072;
constexpr int LDS_MISC = 144384;
constexpr int LDS_BYTES = 147456;
struct Args { const void* in[25]; float* out; unsigned char* ws; int ph_lo, ph_hi; };
struct Frame {
    LAS unsigned char* lds;
    int tid, lane, wave, G, wg;
    const Args* a;
    DEVM const float* x() const { return (const float*)a->in[0]; }
    DEVM const float* p() const { return (const float*)a->in[1]; }
    DEVM const int* pos() const { return (const int*)a->in[2]; }
    DEVM const float* g_mix() const { return (const float*)a->in[3]; }
    DEVM const float* w_in() const { return (const float*)a->in[4]; }
    DEVM const float* ln_v_g() const { return (const float*)a->in[5]; }
    DEVM const float* ln_v_b() const { return (const float*)a->in[6]; }
    DEVM const float* w_s() const { return (const float*)a->in[7]; }
    DEVM const float* b_s() const { return (const float*)a->in[8]; }
    DEVM const float* q_norm_g() const { return (const float*)a->in[9]; }
    DEVM const float* k_norm_g() const { return (const float*)a->in[10]; }
    DEVM const float* conv_w() const { return (const float*)a->in[11]; }
    DEVM const float* a_log() const { return (const float*)a->in[12]; }
    DEVM const float* dt_bias() const { return (const float*)a->in[13]; }
    DEVM const float* o_norm_g() const { return (const float*)a->in[14]; }
    DEVM const float* w_out() const { return (const float*)a->in[15]; }
    DEVM const float* g_ffn() const { return (const float*)a->in[16]; }
    DEVM const float* w_router() const { return (const float*)a->in[17]; }
    DEVM const float* w_e_gate() const { return (const float*)a->in[18]; }
    DEVM const float* w_e_up() const { return (const float*)a->in[19]; }
    DEVM const float* w_e_down() const { return (const float*)a->in[20]; }
    DEVM const float* w_ple() const { return (const float*)a->in[21]; }
    DEVM const float* g_ple() const { return (const float*)a->in[22]; }
    DEVM const float* g_ple_gate() const { return (const float*)a->in[23]; }
    DEVM const float* w_ple_gate() const { return (const float*)a->in[24]; }
    DEVM float* out() const { return a->out; }
    DEVM unsigned char* ws() const { return a->ws; }
    DEVM float* ROPE() const { return (float*)(a->ws + WS_ROPE); }
    DEVM float* AFF() const { return (float*)(a->ws + WS_AFF); }
    DEVM float* GATEV() const { return (float*)(a->ws + WS_GATEV); }
    DEVM float* DEN() const { return (float*)(a->ws + WS_DEN); }
    DEVM float* GAM() const { return (float*)(a->ws + WS_GAM); }
    DEVM float* XPART() const { return (float*)(a->ws + WS_XPART); }
    DEVM float* EPART() const { return (float*)(a->ws + WS_EPART); }
    DEVM float* RSTD() const { return (float*)(a->ws + WS_RSTD); }
    DEVM float* RSROW() const { return (float*)(a->ws + WS_RSROW); }
    DEVM int* IDX() const { return (int*)(a->ws + WS_IDX); }
    DEVM int* INV() const { return (int*)(a->ws + WS_INV); }
    DEVM bf16_t* PB() const { return (bf16_t*)(a->ws + WS_PB); }
    DEVM bf16_t* WS16() const { return (bf16_t*)(a->ws + WS_WS16); }
    DEVM bf16_t* WIN() const { return (bf16_t*)(a->ws + WS_WIN); }
    DEVM bf16_t* WOUT() const { return (bf16_t*)(a->ws + WS_WOUT); }
    DEVM bf16_t* WGU() const { return (bf16_t*)(a->ws + WS_WGU); }
    DEVM bf16_t* WD() const { return (bf16_t*)(a->ws + WS_WD); }
    DEVM bf16_t* WPLE() const { return (bf16_t*)(a->ws + WS_WPLE); }
    DEVM bf16_t* WPG(int L) const { return (bf16_t*)(a->ws + WS_WPG + (size_t)(L & 1) * al4k((size_t)DM * DM * 2)); }
    DEVM bf16_t* ACT() const { return (bf16_t*)(a->ws + WS_ACT); }
    DEVM bf16_t* XB(int L) const { return (bf16_t*)(a->ws + WS_XB + (size_t)(L & 1) * al4k((size_t)M * DM * 2)); }
    DEVM bf16_t* PROJ() const { return (bf16_t*)(a->ws + WS_PROJ); }
    DEVM bf16_t* QN() const { return (bf16_t*)(a->ws + WS_QN); }
    DEVM bf16_t* KN() const { return (bf16_t*)(a->ws + WS_KN); }
    DEVM bf16_t* NUM() const { return (bf16_t*)(a->ws + WS_NUM); }
    DEVM bf16_t* OFB() const { return (bf16_t*)(a->ws + WS_OF); }
    DEVM bf16_t* XE() const { return (bf16_t*)(a->ws + WS_XE); }
    DEVM bf16_t* HID() const { return (bf16_t*)(a->ws + WS_HID); }
    DEVM bf16_t* YE() const { return (bf16_t*)(a->ws + WS_YE); }
    DEVM bf16_t* ERAW() const { return (bf16_t*)(a->ws + WS_ERAW); }
    DEVM unsigned char* VT() const { return (unsigned char*)(a->ws + WS_VT); }
    DEVM unsigned char* REC() const { return (unsigned char*)(a->ws + WS_REC); }
};

constexpr int NJ = DM / 256;
DEV void phase_prologue(Frame& F) {
    { const int gw = F.wg * NWAVES + F.wave, NGW = F.G * NWAVES;
      for (int m0 = gw * 4; m0 < M; m0 += NGW * 4) {
        f32x4 v[4][NJ];
#pragma unroll
        for (int r = 0; r < 4; ++r)
#pragma unroll
            for (int j = 0; j < NJ; ++j) v[r][j] = *((const f32x4*)(F.x() + (size_t)(m0 + r) * DM) + F.lane + 64 * j);
#pragma unroll
        for (int r = 0; r < 4; ++r)
#pragma unroll
            for (int j = 0; j < NJ; ++j) { u32x2 o; o.x = pk2(v[r][j][0], v[r][j][1]); o.y = pk2(v[r][j][2], v[r][j][3]); *((u32x2*)(F.XB(0) + (size_t)(m0 + r) * DM) + F.lane + 64 * j) = o; }
#pragma unroll
        for (int r = 0; r < 4; ++r) { float ss = 0.f;
#pragma unroll
            for (int j = 0; j < NJ; ++j) ss += (v[r][j][0] * v[r][j][0] + v[r][j][1] * v[r][j][1]) + (v[r][j][2] * v[r][j][2] + v[r][j][3] * v[r][j][3]);
            ss = wave_sum(ss); if (F.lane < pg8::NPART) F.XPART()[(size_t)(m0 + r) * pg8::NPART + F.lane] = (F.lane == 0) ? ss : 0.f; }
      } }
    for (int i = F.wg * NTHREADS + F.tid; i < M * pg8::NPART; i += F.G * NTHREADS) F.EPART()[i] = 0.f;
    for (int i = F.wg * NTHREADS + F.tid; i < M * 8; i += F.G * NTHREADS) {
        const int tok = i >> 3, k = i & 7;
        const float inv_freq = powf(500000.0f, -(float)k * 0.125f);
        const float ang = (float)F.pos()[tok] * inv_freq;
        F.ROPE()[tok * 16 + k] = cosf(ang); F.ROPE()[tok * 16 + 8 + k] = sinf(ang);
    }
}

DEV void tr_item(const float* W, int K, int N, bf16_t* WT, int ldk, int k0, int n0, int drow0, LAS float* scr, int lane, const float* rowgain = nullptr) {
    f32x4 wv[8]; const int n4 = n0 + 4 * (lane & 7);
#pragma unroll
    for (int i = 0; i < 8; ++i) { const int kk = 8 * i + (lane >> 3); wv[i] = (n4 < N) ? *(const f32x4*)(W + (size_t)(k0 + kk) * N + n4) : (f32x4){0.f, 0.f, 0.f, 0.f}; }
#pragma unroll
    for (int i = 0; i < 8; ++i) { const int kk = 8 * i + (lane >> 3); const float gk = rowgain ? rowgain[k0 + kk] : 1.0f; LAS float* d = scr + kk * 33 + 4 * (lane & 7);
        d[0] = wv[i][0] * gk; d[1] = wv[i][1] * gk; d[2] = wv[i][2] * gk; d[3] = wv[i][3] * gk; }
    ASMV("s_waitcnt lgkmcnt(0)" ::: "memory"); wsync();
    const int c = lane & 7;
#pragma unroll
    for (int j = 0; j < 4; ++j) { const int n = (lane >> 3) + 8 * j; const LAS float* s = scr + (8 * c) * 33 + n;
        u32x4 o; o.x = pk2(s[0 * 33], s[1 * 33]); o.y = pk2(s[2 * 33], s[3 * 33]); o.z = pk2(s[4 * 33], s[5 * 33]); o.w = pk2(s[6 * 33], s[7 * 33]);
        *(u32x4*)(WT + (size_t)(drow0 + n) * ldk + k0 + 8 * c) = o; }
    ASMV("s_waitcnt lgkmcnt(0)" ::: "memory"); wsync();
}
constexpr int PW_I_IN = (DM / 64) * (INWP / 32), PW_I_OUT = (DM / 64) * (DM / 32), PW_I_G = (DM / 64) * (DE / 32), PW_I_D = (DE / 64) * (DM / 32), PW_I_PLE = (PLE / 64) * (DM / 32), PW_I_PG = (DM / 64) * (DM / 32);
DEV void phase_pw(Frame& F, int L, int slot, int nslots) {
    LAS float* scr = (LAS float*)(F.lds + F.wave * 16384);
    const int gw = slot * NWAVES + F.wave, NGW = nslots * NWAVES;
    constexpr int NIT = PW_I_IN + PW_I_OUT + PW_I_PLE + PW_I_PG;
    for (int it = gw; it < NIT; it += NGW) {
        int r = it;
        if (r < PW_I_IN) { const int nb = INWP / 32, kb = r / nb, n0 = (r % nb) * 32; tr_item(F.w_in() + (size_t)L * DM * INW, DM, INW, F.WIN(), DM, kb * 64, n0, n0, scr, F.lane, F.g_mix() + (size_t)L * DM); continue; } r -= PW_I_IN;
        if (r < PW_I_OUT) { const int nb = DM / 32, kb = r / nb, n0 = (r % nb) * 32; tr_item(F.w_out() + (size_t)L * DM * DM, DM, DM, F.WOUT(), DM, kb * 64, n0, n0, scr, F.lane); continue; } r -= PW_I_OUT;
        if (r < PW_I_PLE) { const int nb = DM / 32, kb = r / nb, n0 = (r % nb) * 32; tr_item(F.w_ple() + (size_t)L * PLE * DM, PLE, DM, F.WPLE(), PLE, kb * 64, n0, n0, scr, F.lane); continue; } r -= PW_I_PLE;
        { const int nb = DM / 32, kb = r / nb, n0 = (r % nb) * 32; tr_item(F.w_ple_gate() + (size_t)L * DM * DM, DM, DM, F.WPG(L), DM, kb * 64, n0, n0, scr, F.lane, F.g_ple_gate() + (size_t)L * DM); }
    }
    for (int i = slot * NTHREADS + F.tid; i < GG * 128 * 128 / 4; i += nslots * NTHREADS) {
        const f32x4 v = *(const f32x4*)(F.w_s() + (size_t)L * GG * 128 * 128 + (size_t)i * 4);
        u32x2 o; o.x = pk2(v[0], v[1]); o.y = pk2(v[2], v[3]); *(u32x2*)(F.WS16() + (size_t)i * 4) = o;
    }
}
DEV void pw_experts(Frame& F, int L, int slot_wave, int n_waves) {
    LAS float* scr = (LAS float*)(F.lds + F.wave * 16384);
    constexpr int PER_E = 2 * PW_I_G + PW_I_D;
    for (int it = slot_wave; it < NEXP * PER_E; it += n_waves) {
        const int e = it / PER_E; int q = it % PER_E;
        if (q < 2 * PW_I_G) { const int which = q / PW_I_G; q %= PW_I_G; const int nb = DE / 32, kb = q / nb, n0 = (q % nb) * 32;
            const float* W = (which ? F.w_e_up() : F.w_e_gate()) + ((size_t)L * NEXP + e) * DM * DE;
            tr_item(W, DM, DE, F.WGU() + (size_t)e * 2 * DE * DM, DM, kb * 64, n0, 256 * (n0 / 128) + 128 * which + (n0 % 128), scr, F.lane); }
        else { q -= 2 * PW_I_G; const int nb = DM / 32, kb = q / nb, n0 = (q % nb) * 32;
            tr_item(F.w_e_down() + ((size_t)L * NEXP + e) * DE * DM, DE, DM, F.WD() + (size_t)e * DM * DE, DE, kb * 64, n0, n0, scr, F.lane); }
    }
}

DEV void phase_norm1(Frame& F, int L) {
    const int gw = F.wg * NWAVES + F.wave, NGW = F.G * NWAVES;
    constexpr int R = 4;
    for (int m0 = gw * R; m0 < M; m0 += NGW * R) {
        f32x4 v[R][NJ];
#pragma unroll
        for (int r = 0; r < R; ++r)
#pragma unroll
            for (int j = 0; j < NJ; ++j) { const u32x2 y = *((const u32x2*)(F.XB(L) + (size_t)(m0 + r) * DM) + F.lane + 64 * j); v[r][j] = (f32x4){lo16(y.x), hi16(y.x), lo16(y.y), hi16(y.y)}; }
#pragma unroll
        for (int r = 0; r < R; ++r) {
            float s = 0.f;
#pragma unroll
            for (int j = 0; j < NJ; ++j) s += (v[r][j][0] * v[r][j][0] + v[r][j][1] * v[r][j][1]) + (v[r][j][2] * v[r][j][2] + v[r][j][3] * v[r][j][3]);
            const float rstd = frsqrt(wave_sum(s) * (1.f / DM) + NORM_EPS);
            u32x2* o8 = (u32x2*)(F.ACT() + (size_t)(m0 + r) * DM) + F.lane;
#pragma unroll
            for (int j = 0; j < NJ; ++j) { const f32x4 g = *((const f32x4*)(F.g_mix() + (size_t)L * DM) + F.lane + 64 * j); u32x2 o; o.x = pk2(v[r][j][0] * rstd * g[0], v[r][j][1] * rstd * g[1]); o.y = pk2(v[r][j][2] * rstd * g[2], v[r][j][3] * rstd * g[3]); o8[64 * j] = o; }
        }
    }
}

constexpr int GM_N = (M / GCH) * GG, GM_SPLIT = GM_N / 2;
DEV void gmlp_units(Frame& F, int L, int slot, int nslots, int u0, int u1) {
    LAS bf16_t* vnT = (LAS bf16_t*)F.lds;
    const int tid = F.tid, lane = F.lane, w = F.wave;
    const int j = tid >> 2, qd = tid & 3;
    const int mt = w & 1, nt = w >> 1, r = lane & 31, h = lane >> 5;
    const int nunits = u1;
    u32x4 v0, v1; bf16x8 bw[8]; u32x2 uu[4]; float bias;
#define GMLP_LOADS(unit_) do { const int g_ = (unit_) % GG, t0_ = ((unit_) / GG) * GCH, tok_ = t0_ + nt * 32 + r; \
        const bf16_t* src_ = F.PROJ() + (size_t)(t0_ + j) * INWP + O_AV + g_ * 64 + qd * 16; v0 = *(const u32x4*)src_; v1 = *(const u32x4*)(src_ + 8); \
        const bf16_t* wrow_ = F.WS16() + ((size_t)g_ * 128 + nt * 32 + r) * 128; \
        _Pragma("unroll") for (int s_ = 0; s_ < 8; ++s_) bw[s_] = *(const bf16x8*)(wrow_ + s_ * 16 + h * 8); \
        _Pragma("unroll") for (int rr_ = 0; rr_ < 4; ++rr_) uu[rr_] = *(const u32x2*)(F.PROJ() + (size_t)tok_ * INWP + O_AU + g_ * 64 + mt * 32 + 8 * rr_ + 4 * h); \
        bias = F.b_s()[((size_t)L * GG + g_) * 128 + nt * 32 + r]; } while (0)
    if (u0 + slot < nunits) GMLP_LOADS(u0 + slot);
    for (int unit = u0 + slot; unit < nunits; unit += nslots) {
        const int g = unit % GG, t0 = (unit / GG) * GCH, tok = t0 + nt * 32 + r;
        {
            float v[16]; unpack8(v0, v); unpack8(v1, v + 8);
            float s = 0.f;
#pragma unroll
            for (int i = 0; i < 16; ++i) { v[i] = gelu_tanh(v[i]); s += v[i]; }
            s += shx(s, 1); s += shx(s, 2);
            const float mu = s * (1.f / 64.f); float q = 0.f;
#pragma unroll
            for (int i = 0; i < 16; ++i) { v[i] -= mu; q += v[i] * v[i]; }
            q += shx(q, 1); q += shx(q, 2);
            const float rstd = frsqrt(q * (1.f / 64.f) + NORM_EPS);
            const float* lg = F.ln_v_g() + ((size_t)L * GG + g) * 64 + qd * 16; const float* lb = F.ln_v_b() + ((size_t)L * GG + g) * 64 + qd * 16;
#pragma unroll
            for (int i = 0; i < 16; ++i) vnT[(qd * 16 + i) * 136 + j] = (bf16_t)f2bf(v[i] * rstd * lg[i] + lb[i]);
        }
        lbar();
        u32x2 outv[4];
        {
            f32x16 acc; for (int i = 0; i < 16; ++i) acc[i] = 0.f;
#pragma unroll
            for (int s = 0; s < 8; ++s) {
                const bf16x8 a = *(const LAS bf16x8*)(vnT + (mt * 32 + r) * 136 + s * 16 + h * 8);
                acc = mfma32(a, bw[s], acc);
            }
#pragma unroll
            for (int rr = 0; rr < 4; ++rr) {
                const u32x2 u2 = uu[rr];
                const float u0 = gelu_tanh(lo16(u2.x)), u1 = gelu_tanh(hi16(u2.x)), u2f = gelu_tanh(lo16(u2.y)), u3 = gelu_tanh(hi16(u2.y));
                outv[rr].x = pk2(u0 * (acc[4 * rr + 0] + bias), u1 * (acc[4 * rr + 1] + bias)); outv[rr].y = pk2(u2f * (acc[4 * rr + 2] + bias), u3 * (acc[4 * rr + 3] + bias));
            }
        }
        if (unit + nslots < nunits) GMLP_LOADS(unit + nslots);
#pragma unroll
        for (int rr = 0; rr < 4; ++rr) *(u32x2*)(F.ACT() + (size_t)tok * DM + g * 64 + mt * 32 + 8 * rr + 4 * h) = outv[rr];
        lbar();
    }
#undef GMLP_LOADS
    bsync();
}

DEV void attnprep_units(Frame& F, int L) {
    LAS bf16_t* vt = (LAS bf16_t*)F.lds;
    const int tid = F.tid;
    for (int unit = F.wg; unit < BATCH * BH * (SEQ / 256); unit += F.G) {
        const int blk = unit % (SEQ / 256), bh = unit / (SEQ / 256), h = bh % BH, b = bh / BH, tb = blk * 256;
#pragma unroll
        for (int pass = 0; pass < 4; ++pass) {
            const int which = pass >> 1, tl = (pass & 1) * 128 + (tid >> 2), qd = tid & 3, s = tb + tl, tok = b * SEQ + s;
            const bf16_t* src = F.PROJ() + (size_t)tok * INWP + (which ? O_BK : O_BQ) + h * 64 + qd * 16;
            float v[16]; unpack8(*(const u32x4*)src, v); unpack8(*(const u32x4*)(src + 8), v + 8);
            float ss = 0.f;
#pragma unroll
            for (int i = 0; i < 16; ++i) ss += v[i] * v[i];
            ss += shx(ss, 1); ss += shx(ss, 2);
            const float rstd = frsqrt(ss * (1.f / 64.f) + NORM_EPS);
            const float* gn = (which ? F.k_norm_g() : F.q_norm_g()) + (size_t)L * 64 + qd * 16;
#pragma unroll
            for (int i = 0; i < 16; ++i) v[i] = v[i] * rstd * gn[i];
            if (qd == 0) {
                const float* rp = F.ROPE() + (size_t)tok * 16;
#pragma unroll
                for (int i = 0; i < 8; ++i) { const float c = rp[i], sn = rp[8 + i], x1 = v[i], x2 = v[8 + i]; v[i] = x1 * c - x2 * sn; v[8 + i] = x2 * c + x1 * sn; }
            }
            if (which == 0) {
#pragma unroll
                for (int i = 0; i < 16; ++i) v[i] *= 0.125f;
            }
            bf16_t* dst = (which ? F.KN() : F.QN()) + ((size_t)bh * SEQ + s) * 64 + qd * 16;
            *(u32x4*)dst = pack8(v); *(u32x4*)(dst + 8) = pack8(v + 8);
        }
#pragma unroll
        for (int i = 0; i < 4; ++i) { const int id = tid + 512 * i, tl = id >> 3, dc = id & 7;
            const u32x4 r = *(const u32x4*)(F.PROJ() + (size_t)(b * SEQ + tb + tl) * INWP + O_BV + h * 64 + dc * 8);
            const unsigned ww[4] = {r.x, r.y, r.z, r.w};
#pragma unroll
            for (int e = 0; e < 4; ++e) { vt[(dc * 8 + 2 * e) * 264 + tl] = (bf16_t)(ww[e] & 0xffffu); vt[(dc * 8 + 2 * e + 1) * 264 + tl] = (bf16_t)(ww[e] >> 16); } }
        bsync();
#pragma unroll
        for (int p = 0; p < 3; ++p) {
            const int dil = (p == 0) ? 1 : (p == 1 ? 4 : 16), Lp = SEQ / dil, cpr = 32 / dil;
            bf16_t* VTp = (bf16_t*)(F.VT() + (size_t)p * VT_STRIDE);
#pragma unroll
            for (int i = 0; i < 4; ++i) { const int item = tid + 512 * i, d = item >> 5, rc = item & 31, r = rc / cpr, c = rc % cpr;
                unsigned short e8[8];
#pragma unroll
                for (int e = 0; e < 8; ++e) e8[e] = vt[d * 264 + r + dil * (8 * c + e)];
                u32x4 o; o.x = e8[0] | ((unsigned)e8[1] << 16); o.y = e8[2] | ((unsigned)e8[3] << 16); o.z = e8[4] | ((unsigned)e8[5] << 16); o.w = e8[6] | ((unsigned)e8[7] << 16);
                *(u32x4*)(VTp + (((size_t)bh * dil + r) * 64 + d) * Lp + tb / dil + 8 * c) = o; }
        }
        bsync();
    }
}

DEV int perm_pi(int sg) { return 32 * (sg >> 5) + 16 * ((sg & 7) >> 2) + 4 * ((sg >> 3) & 3) + (sg & 3); }
DEV int perm_inv(int a) { return 32 * (a >> 5) + 8 * ((a >> 2) & 3) + 4 * ((a >> 4) & 1) + (a & 3); }
constexpr int G3_QB = 0, G3_KB = 9216, G3_VB = 18432, G3_LM = 27648, G3_TM = 62464, G3_XS = 72704, G3_VEC = 134144;
constexpr int LMP = 68, LMD = 64 * LMP, TMP = 20, TMB = 16 * TMP;
constexpr int G3_PF = 140288;
constexpr int G3_CW = 121856;
static_assert(G3_CW + 5 * 3 * CW * 2 <= G3_VEC, "LDS map");
DEV void gdnprep_units(Frame& F, int L) {
    LAS bf16_t* QB = (LAS bf16_t*)(F.lds + G3_QB); LAS bf16_t* KB = (LAS bf16_t*)(F.lds + G3_KB); LAS bf16_t* VB = (LAS bf16_t*)(F.lds + G3_VB);
    LAS float* LM = (LAS float*)(F.lds + G3_LM); LAS float* TMx = (LAS float*)(F.lds + G3_TM); LAS unsigned char* XS = F.lds + G3_XS;
    LAS float* BT = (LAS float*)(F.lds + G3_VEC); LAS float* GC = BT + 128; LAS float* EQ = BT + 256; LAS float* EK = BT + 384; LAS float* BEQ = BT + 512;
    const int tid0 = F.tid;
    LAS bf16_t* CWL = (LAS bf16_t*)(F.lds + G3_CW);
    for (int i = tid0; i < 5 * 3 * CW / 8; i += NTHREADS) { const float* wp = F.conv_w() + (size_t)L * 5 * 3 * CW + (size_t)i * 8; const f32x4 w0 = *(const f32x4*)wp, w1 = *(const f32x4*)(wp + 4);
        float t8[8] = {w0[0], w0[1], w0[2], w0[3], w1[0], w1[1], w1[2], w1[3]}; *(LAS u32x4*)(CWL + (size_t)i * 8) = pack8(t8); }
    bsync();
    for (int unit = F.wg; unit < BATCH * CHN * NCH; unit += F.G) {
        int tid = tid0; ASMV("" : "+v"(tid));
        const int lane = tid & 63, w = rfl(tid >> 6);
        const int n = unit % NCH, bhh = unit / NCH, h = bhh % CHN, b = bhh / CHN;
        {
        const int tg = tid / 24, cg = tid % 24, which = cg >> 3, c8 = cg & 7, ch = which * CW + h * 64 + c8 * 8;
        u32x4 xr[8];
        if (tid < 384) {
#pragma unroll
            for (int r = 0; r < 8; ++r) { const int sq = n * 64 + 4 * tg - 2 + r; const bool ok = sq >= 0 && sq < SEQ; const int sqc = sq < 0 ? 0 : (sq >= SEQ ? SEQ - 1 : sq);
                const u32x4 v = *(const u32x4*)(F.PROJ() + (size_t)(b * SEQ + sqc) * INWP + O_CQKV + ch);
                xr[r].x = ok ? v.x : 0u; xr[r].y = ok ? v.y : 0u; xr[r].z = ok ? v.z : 0u; xr[r].w = ok ? v.w : 0u; }
        }
        float g_t = 0.f, b_t = 0.f;
        if (tid < 128) { const int dir = tid >> 6, tt = tid & 63; const size_t tok = (size_t)b * SEQ + n * 64 + tt;
            const float a = bf2f(F.PROJ()[tok * INWP + O_CA + dir * CHN + h]), bb = bf2f(F.PROJ()[tok * INWP + O_CB + dir * CHN + h]);
            g_t = -fexp(F.a_log()[((size_t)L * 2 + dir) * CHN + h]) * softplusf_(a + F.dt_bias()[((size_t)L * 2 + dir) * CHN + h]); b_t = sigmoidf_(bb); }
        if (tid < 384) {
            float wv[5][8];
#pragma unroll
            for (int kk = 0; kk < 5; ++kk) unpack8(*(const LAS u32x4*)(CWL + (kk * 3 * CW + ch)), wv[kk]);
            float acc[4][8];
#pragma unroll
            for (int j = 0; j < 4; ++j)
#pragma unroll
                for (int e = 0; e < 8; ++e) acc[j][e] = 0.f;
#pragma unroll
            for (int r = 0; r < 8; ++r) { float xv[8]; unpack8(xr[r], xv);
#pragma unroll
                for (int j = 0; j < 4; ++j) { const int kk = r - j;
                    if (kk >= 0 && kk < 5) {
#pragma unroll
                        for (int e = 0; e < 8; ++e) acc[j][e] += xv[e] * wv[kk][e]; } } }
#pragma unroll
            for (int j = 0; j < 4; ++j) {
                float ss = 0.f;
#pragma unroll
                for (int e = 0; e < 8; ++e) { acc[j][e] = siluf_(acc[j][e]); ss += acc[j][e] * acc[j][e]; }
                ss += shx(ss, 1); ss += shx(ss, 2); ss += shx(ss, 4);
                const float sc = (which == 2) ? 1.0f : frsqrt(ss + NORM_EPS) * (which == 0 ? 0.125f : 1.0f);
#pragma unroll
                for (int e = 0; e < 8; ++e) acc[j][e] *= sc;
                *(LAS u32x4*)((which == 0 ? QB : (which == 1 ? KB : VB)) + (4 * tg + j) * 72 + c8 * 8) = pack8(acc[j]);
            }
        }
        if (w < 2) {
            const int dir = w;
            float g = dir ? __builtin_bit_cast(float, shfl_i(__builtin_bit_cast(int, g_t), 63 - lane)) : g_t;
            const float bt = dir ? __builtin_bit_cast(float, shfl_i(__builtin_bit_cast(int, b_t), 63 - lane)) : b_t;
#pragma unroll
            for (int d = 1; d < 64; d <<= 1) { const float o = __builtin_bit_cast(float, shup(__builtin_bit_cast(unsigned, g), d)); if (lane >= d) g += o; }
            const float last = __builtin_bit_cast(float, shfl_i(__builtin_bit_cast(int, g), 63)), eq = fexp(g);
            BT[dir * 64 + lane] = bt; GC[dir * 64 + lane] = g; EQ[dir * 64 + lane] = eq; EK[dir * 64 + lane] = fexp(last - g); BEQ[dir * 64 + lane] = bt * eq;
            if (lane == 63) { const int chain = (b * CHN + h) * 2 + dir, mm = dir ? NCH - 1 - n : n; F.GAM()[(size_t)chain * NCH + mm] = eq; }
        }
        lbar();
        }
        {
        {
            const int nu = unit + F.G;
            if (nu < BATCH * CHN * NCH && tid < 204) { const int n2 = nu % NCH, bh2 = nu / NCH, h2 = bh2 % CHN, b2 = bh2 / CHN, t = tid / 3, wh = tid % 3;
                int sq = n2 * 64 + t - 2; sq = sq < 0 ? 0 : (sq >= SEQ ? SEQ - 1 : sq);
                glds4(F.PROJ() + (size_t)(b2 * SEQ + sq) * INWP + O_CQKV + wh * CW + h2 * 64, F.lds + G3_PF + w * 256); }
        }
        {
            const int mat = w >> 2, tt = w & 3, c = lane & 15, g4 = lane >> 4;
            const LAS bf16_t* XA = (mat ? QB : KB) + (tt * 16 + c) * 72 + g4 * 8;
            const bf16x8 a0 = *(const LAS bf16x8*)XA, a1 = *(const LAS bf16x8*)(XA + 32);
            f32x4 acc[4];
#pragma unroll
            for (int ct = 0; ct < 4; ++ct) { const LAS bf16_t* XBp = KB + (ct * 16 + c) * 72 + g4 * 8;
                f32x4 a = {0.f, 0.f, 0.f, 0.f}; a = mfma16(a0, *(const LAS bf16x8*)XBp, a); a = mfma16(a1, *(const LAS bf16x8*)(XBp + 32), a); acc[ct] = a; }
            if (mat == 0) {
#pragma unroll 1
                for (int dir = 0; dir < 2; ++dir) {
                    float gct[4], btv[4], gcs[4];
#pragma unroll
                    for (int i = 0; i < 4; ++i) { const int t = 16 * tt + 4 * g4 + i, tau = dir ? 63 - t : t; gct[i] = GC[dir * 64 + tau]; btv[i] = BT[dir * 64 + tau]; }
#pragma unroll
                    for (int ct = 0; ct < 4; ++ct) { const int sq = 16 * ct + c, sg = dir ? 63 - sq : sq; gcs[ct] = GC[dir * 64 + sg]; }
#pragma unroll
                    for (int i = 0; i < 4; ++i) { const int t = 16 * tt + 4 * g4 + i, tau = dir ? 63 - t : t;
#pragma unroll
                        for (int ct = 0; ct < 4; ++ct) { const int sq = 16 * ct + c, sg = dir ? 63 - sq : sq;
                            LM[dir * LMD + tau * LMP + sg] = (sg < tau) ? btv[i] * acc[ct][i] * fexp(gct[i] - gcs[ct]) : 0.f; } }
                }
            } else {
#pragma unroll 1
                for (int dir = 0; dir < 2; ++dir) {
                    float gct[4], gcs[4]; int pcol[4];
#pragma unroll
                    for (int i = 0; i < 4; ++i) { const int t = 16 * tt + 4 * g4 + i, tau = dir ? 63 - t : t; gct[i] = GC[dir * 64 + tau]; }
#pragma unroll
                    for (int ct = 0; ct < 4; ++ct) { const int sq = 16 * ct + c, sg = dir ? 63 - sq : sq; gcs[ct] = GC[dir * 64 + sg]; pcol[ct] = perm_inv(sg); }
                    LAS bf16_t* QKI = (LAS bf16_t*)(XS + dir * 24576 + 16384);
#pragma unroll
                    for (int i = 0; i < 4; ++i) { const int t = 16 * tt + 4 * g4 + i, tau = dir ? 63 - t : t;
#pragma unroll
                        for (int ct = 0; ct < 4; ++ct) { const int sq = 16 * ct + c, sg = dir ? 63 - sq : sq;
                            QKI[tau * 64 + pcol[ct]] = (bf16_t)f2bf((sg <= tau) ? acc[ct][i] * fexp(gct[i] - gcs[ct]) : 0.f); } }
                }
            }
            if (mat == 0) {
                wsync();
                if (lane < 32) { const int dir = lane >> 4, blk = dir ? 3 - tt : tt;
                    const LAS float* Lb = LM + dir * LMD + (blk * 16) * LMP + blk * 16;
                    float tv[16];
#pragma unroll
                    for (int r = 0; r < 16; ++r) { float a = (r == c) ? 1.f : 0.f;
#pragma unroll
                        for (int s2 = 0; s2 < r; ++s2) a -= Lb[r * LMP + s2] * tv[s2];
                        tv[r] = a; }
                    LAS float* Tb = TMx + (dir * 4 + blk) * TMB;
#pragma unroll
                    for (int r = 0; r < 16; ++r) Tb[r * TMP + c] = tv[r]; }
            } else {
                const int t2 = tid - 256;
#pragma unroll 1
                for (int i = 0; i < 8; ++i) {
                    const int item = t2 + 256 * i, dir = item >> 10, mat2 = (item >> 9) & 1, row = (item >> 3) & 63, chk = item & 7;
                    const int chain = (b * CHN + h) * 2 + dir, mm = dir ? NCH - 1 - n : n;
                    unsigned char* rec = F.REC() + ((size_t)chain * NCH + mm) * RECB;
                    const int pi0 = 32 * (chk >> 2) + 4 * (chk & 3);
                    float o[8];
                    if (mat2 == 0) { const int t = dir ? 63 - row : row; const float eq = EQ[dir * 64 + row];
                        const u32x2 lo2 = *(const LAS u32x2*)(QB + t * 72 + pi0), hi2 = *(const LAS u32x2*)(QB + t * 72 + pi0 + 16);
                        o[0] = lo16(lo2.x) * eq; o[1] = hi16(lo2.x) * eq; o[2] = lo16(lo2.y) * eq; o[3] = hi16(lo2.y) * eq; o[4] = lo16(hi2.x) * eq; o[5] = hi16(hi2.x) * eq; o[6] = lo16(hi2.y) * eq; o[7] = hi16(hi2.y) * eq; }
                    else {
#pragma unroll
                        for (int e = 0; e < 8; ++e) { const int pi = pi0 + 16 * (e >> 2) + (e & 3), sq = dir ? 63 - pi : pi; o[e] = bf2f(KB[sq * 72 + row]) * EK[dir * 64 + pi]; } }
                    *(u32x4*)(rec + (mat2 ? 24576 : 8192) + row * 128 + chk * 16) = pack8(o);
                }
            }
        }
        lbar();
        }
        {
        {
            const int dir = w >> 2, c = lane & 15, g4 = lane >> 4;
            const LAS float* Lm = LM + dir * LMD; const LAS float* Tm = TMx + dir * 4 * TMB;
            bf16x8 AT[4], AL1, AL2, AL3a, AL3b;
#pragma unroll
            for (int i = 0; i < 4; ++i) { const f32x4 v = *(const LAS f32x4*)(Tm + i * TMB + c * TMP + 4 * g4); u32x4 t; t.x = pk2(v[0], v[1]); t.y = pk2(v[2], v[3]); t.z = 0u; t.w = 0u; AT[i] = __builtin_bit_cast(bf16x8, t); }
            { const f32x4 v = *(const LAS f32x4*)(Lm + (16 + c) * LMP + 4 * g4); u32x4 t; t.x = pk2(v[0], v[1]); t.y = pk2(v[2], v[3]); t.z = 0u; t.w = 0u; AL1 = __builtin_bit_cast(bf16x8, t); }
            { const f32x4 v = *(const LAS f32x4*)(Lm + (32 + c) * LMP + 4 * g4), v2 = *(const LAS f32x4*)(Lm + (32 + c) * LMP + 16 + 4 * g4); u32x4 t; t.x = pk2(v[0], v[1]); t.y = pk2(v[2], v[3]); t.z = pk2(v2[0], v2[1]); t.w = pk2(v2[2], v2[3]); AL2 = __builtin_bit_cast(bf16x8, t); }
            { const f32x4 v = *(const LAS f32x4*)(Lm + (48 + c) * LMP + 4 * g4), v2 = *(const LAS f32x4*)(Lm + (48 + c) * LMP + 16 + 4 * g4); u32x4 t; t.x = pk2(v[0], v[1]); t.y = pk2(v[2], v[3]); t.z = pk2(v2[0], v2[1]); t.w = pk2(v2[2], v2[3]); AL3a = __builtin_bit_cast(bf16x8, t); }
            { const f32x4 v = *(const LAS f32x4*)(Lm + (48 + c) * LMP + 32 + 4 * g4); u32x4 t; t.x = pk2(v[0], v[1]); t.y = pk2(v[2], v[3]); t.z = 0u; t.w = 0u; AL3b = __builtin_bit_cast(bf16x8, t); }
#pragma unroll 1
            for (int cti = 0; cti < 2; ++cti) {
                const int ct = 2 * (w & 3) + cti, col = 16 * ct + c;
                f32x4 R[4];
                const LAS bf16_t* rsrc = (ct < 4) ? VB + col : KB + (col - 64);
                const LAS float* rscl = ((ct < 4) ? BT : BEQ) + dir * 64;
#pragma unroll
                for (int i = 0; i < 4; ++i)
#pragma unroll
                    for (int e = 0; e < 4; ++e) { const int tau = 16 * i + 4 * g4 + e, t = dir ? 63 - tau : tau;
                        R[i][e] = bf2f(rsrc[t * 72]) * rscl[tau]; }
                const f32x4 z4 = {0.f, 0.f, 0.f, 0.f};
#define PKX(a, b2) __builtin_bit_cast(bf16x8, (u32x4){pk2((a)[0], (a)[1]), pk2((a)[2], (a)[3]), pk2((b2)[0], (b2)[1]), pk2((b2)[2], (b2)[3])})
                const f32x4 X0 = mfma16(AT[0], PKX(R[0], z4), z4);
                const f32x4 Y1 = R[1] - mfma16(AL1, PKX(X0, z4), z4);
                const f32x4 X1 = mfma16(AT[1], PKX(Y1, z4), z4);
                const bf16x8 X01 = PKX(X0, X1);
                const f32x4 Y2 = R[2] - mfma16(AL2, X01, z4);
                const f32x4 X2 = mfma16(AT[2], PKX(Y2, z4), z4);
                const f32x4 Y3 = R[3] - mfma16(AL3b, PKX(X2, z4), mfma16(AL3a, X01, z4));
                const f32x4 X3 = mfma16(AT[3], PKX(Y3, z4), z4);
#undef PKX
                const f32x4 X[4] = {X0, X1, X2, X3};
                if (ct < 4) { LAS bf16_t* U = (LAS bf16_t*)(XS + dir * 24576);
#pragma unroll
                    for (int i = 0; i < 4; ++i)
#pragma unroll
                        for (int e = 0; e < 4; ++e) U[(16 * i + 4 * g4 + e) * 64 + col] = (bf16_t)f2bf(X[i][e]); }
                else { LAS bf16_t* Wp = (LAS bf16_t*)(XS + dir * 24576 + 8192); const int sc = perm_inv(col - 64);
#pragma unroll
                    for (int i = 0; i < 4; ++i)
#pragma unroll
                        for (int e = 0; e < 4; ++e) Wp[(16 * i + 4 * g4 + e) * 64 + sc] = (bf16_t)f2bf(X[i][e]); }
            }
        }
        lbar();
        }
        {
        if (w >= 6) {
#pragma unroll 8
            for (int k = 0; k < 24; ++k) { const int off = ((tid - 384) + 128 * k) * 16, dir = off / 24576, oi = off % 24576;
                const int chain = (b * CHN + h) * 2 + dir, mm = dir ? NCH - 1 - n : n;
                unsigned char* rec = F.REC() + ((size_t)chain * NCH + mm) * RECB;
                *(u32x4*)(rec + (oi < 8192 ? 32768 + oi : (oi < 16384 ? oi - 8192 : oi))) = *(const LAS u32x4*)(XS + off); }
        }
        }
    }
    bsync();
}

constexpr int ATT_KROWS = 384;
constexpr int ATT_VPITCH = 776;
constexpr int ATT_LDS_V = ATT_KROWS * 128;
struct AttUnit { int p, dil, Lp, QB, bh, r, jq0; };
DEV int att_qb(int Lp) { return Lp < 256 ? Lp : 256; }
DEV int att_units_total() { int t = 0; for (int p = 0; p < 3; ++p) { const int dil = (p == 0) ? 1 : (p == 1 ? 4 : 16); t += BATCH * BH * (SEQ / att_qb(SEQ / dil)); } return t; }
DEV bool att_decode(int u, AttUnit& a) {
    for (int p = 0; p < 3; ++p) { const int dil = (p == 0) ? 1 : (p == 1 ? 4 : 16), Lp = SEQ / dil, QB = att_qb(Lp), n = BATCH * BH * (SEQ / QB);
        if (u < n) { const int nb = Lp / QB, per_bh = dil * nb; a.p = p; a.dil = dil; a.Lp = Lp; a.QB = QB; a.bh = u / per_bh; const int q = u % per_bh; a.r = q / nb; a.jq0 = (q % nb) * QB; return true; }
        u -= n; }
    return false;
}
DEV int att_units_per_bh() { int t = 0; for (int p = 0; p < 3; ++p) { const int dil = (p == 0) ? 1 : (p == 1 ? 4 : 16); t += SEQ / att_qb(SEQ / dil); } return t; }
DEV void att_decode_bh(int bh, int rest, AttUnit& a) {
    for (int p = 0; p < 3; ++p) { const int dil = (p == 0) ? 1 : (p == 1 ? 4 : 16), Lp = SEQ / dil, QB = att_qb(Lp), nb = Lp / QB, n = dil * nb;
        if (rest < n || p == 2) { a.p = p; a.dil = dil; a.Lp = Lp; a.QB = QB; a.bh = bh; a.r = rest / nb; a.jq0 = (rest % nb) * QB; return; }
        rest -= n; }
}
struct AttRegs { u32x4 kv[12]; };
DEV void att_load(Frame& F, const AttUnit& a, AttRegs& R) {
    const int tid = F.tid;
    const int nkeys = a.QB + 128, kbase = a.jq0 - 64;
    const bf16_t* Kb = F.KN() + (size_t)a.bh * SEQ * 64;
    const bf16_t* VTp = (const bf16_t*)(F.VT() + (size_t)a.p * VT_STRIDE) + ((size_t)a.bh * a.dil + a.r) * 64 * a.Lp;
#pragma unroll
    for (int i = 0; i < 6; ++i) {
        const int id = tid + 512 * i, row = id >> 3, cp = id & 7, j = kbase + row;
        u32x4 v = {0u, 0u, 0u, 0u};
        if (row < nkeys && j >= 0 && j < a.Lp) v = *(const u32x4*)(Kb + (size_t)(a.r + a.dil * j) * 64 + ((cp ^ (row & 7)) * 8));
        R.kv[i] = v;
    }
#pragma unroll
    for (int i = 0; i < 6; ++i) {
        const int id = tid + 512 * i, d = id / 48, ck = id % 48, j = kbase + ck * 8;
        u32x4 v = {0u, 0u, 0u, 0u};
        if (ck * 8 < nkeys && j >= 0 && j < a.Lp) v = *(const u32x4*)(VTp + (size_t)d * a.Lp + j);
        R.kv[6 + i] = v;
    }
}
DEV void att_store_lds(Frame& F, const AttRegs& R) {
    const int tid = F.tid;
#pragma unroll
    for (int i = 0; i < 6; ++i) { const int id = tid + 512 * i; *(LAS u32x4*)(F.lds + id * 16) = R.kv[i]; }
#pragma unroll
    for (int i = 0; i < 6; ++i) { const int id = tid + 512 * i, d = id / 48, ck = id % 48; LAS unsigned char* p = F.lds + ATT_LDS_V + d * ATT_VPITCH + ck * 16;
        u32x2 lo2, hi2; lo2.x = R.kv[6 + i].x; lo2.y = R.kv[6 + i].y; hi2.x = R.kv[6 + i].z; hi2.y = R.kv[6 + i].w; *(LAS u32x2*)p = lo2; *(LAS u32x2*)(p + 8) = hi2; }
}
DEV void att_loadq(Frame& F, const AttUnit& a, bf16x8 (&qf)[4]) {
    const int lane = F.lane, w = F.wave, r31 = lane & 31, hh = lane >> 5;
    if (w * 32 < a.QB) { const bf16_t* qp = F.QN() + ((size_t)a.bh * SEQ + a.r + a.dil * (a.jq0 + w * 32 + r31)) * 64 + 8 * hh;
#pragma unroll
        for (int s = 0; s < 4; ++s) qf[s] = *(const bf16x8*)(qp + 16 * s); }
}
DEV void att_compute(Frame& F, const AttUnit& a, const bf16x8 (&qf)[4], float Cb) {
    const int lane = F.lane, w = F.wave, r31 = lane & 31, hh = lane >> 5;
    if (w * 32 >= a.QB) return;
    const int jq = a.jq0 + w * 32;
    f32x16 o0, o1; for (int i = 0; i < 16; ++i) { o0[i] = 0.f; o1[i] = 0.f; }
    float lsum = 0.f;
#pragma unroll
    for (int kt = 0; kt < 5; ++kt) {
        const int jk = jq - 64 + 32 * kt, kl = 32 * w + 32 * kt;
        if (jk < 0 || jk >= a.Lp) continue;
        f32x16 sc; for (int i = 0; i < 16; ++i) sc[i] = 0.f;
        { const int row = kl + r31; const LAS unsigned char* kp = F.lds + row * 128;
#pragma unroll
          for (int s = 0; s < 4; ++s) sc = mfma32(*(const LAS bf16x8*)(kp + (((2 * s + hh) ^ (row & 7)) * 16)), qf[s], sc); }
        float pv[16];
#pragma unroll
        for (int i = 0; i < 16; ++i) { const int dlt = jk + (i & 3) + 8 * (i >> 2) + 4 * hh - (jq + r31);
            const float e = fexp(sc[i] - Cb); pv[i] = (dlt <= 64 && dlt >= -64) ? e : 0.f; lsum += pv[i]; }
        const bf16x8 p0 = __builtin_bit_cast(bf16x8, pack8(pv)), p1 = __builtin_bit_cast(bf16x8, pack8(pv + 8));
#pragma unroll
        for (int dt = 0; dt < 2; ++dt) {
            ASMV("" ::: "memory");
            const LAS unsigned char* vp = F.lds + ATT_LDS_V + (dt * 32 + r31) * ATT_VPITCH + (kl + 4 * hh) * 2;
            const u32x2 x0 = *(const LAS u32x2*)vp, x1 = *(const LAS u32x2*)(vp + 16), x2 = *(const LAS u32x2*)(vp + 32), x3 = *(const LAS u32x2*)(vp + 48);
            u32x4 a0, a1; a0.x = x0.x; a0.y = x0.y; a0.z = x1.x; a0.w = x1.y; a1.x = x2.x; a1.y = x2.y; a1.z = x3.x; a1.w = x3.y;
            if (dt == 0) { o0 = mfma32(__builtin_bit_cast(bf16x8, a0), p0, o0); o0 = mfma32(__builtin_bit_cast(bf16x8, a1), p1, o0); }
            else { o1 = mfma32(__builtin_bit_cast(bf16x8, a0), p0, o1); o1 = mfma32(__builtin_bit_cast(bf16x8, a1), p1, o1); }
        }
    }
    lsum += shx(lsum, 32);
    const int b = a.bh / BH, h = a.bh % BH; const size_t tok = (size_t)b * SEQ + a.r + a.dil * (jq + r31);
    bf16_t* np = F.NUM() + (size_t)a.p * (VT_STRIDE / 2) + tok * BW + h * 64;
#pragma unroll
    for (int g4 = 0; g4 < 4; ++g4) {
        u32x2 w0; w0.x = pk2(o0[4 * g4], o0[4 * g4 + 1]); w0.y = pk2(o0[4 * g4 + 2], o0[4 * g4 + 3]); *(u32x2*)(np + 8 * g4 + 4 * hh) = w0;
        u32x2 w1; w1.x = pk2(o1[4 * g4], o1[4 * g4 + 1]); w1.y = pk2(o1[4 * g4 + 2], o1[4 * g4 + 3]); *(u32x2*)(np + 32 + 8 * g4 + 4 * hh) = w1;
    }
    if (hh == 0) F.DEN()[((size_t)a.p * M + tok) * BH + h] = lsum;
}
DEV void attn_units(Frame& F, int L, int slot, int nslots) {
    const int lane = F.lane;
    const float gq = wave_max(fabsf(F.q_norm_g()[(size_t)L * 64 + lane])), gk = wave_max(fabsf(F.k_norm_g()[(size_t)L * 64 + lane]));
    const float Cb = 8.0f * gq * gk;
    const int total = att_units_total();
    AttUnit cur; AttRegs R; bf16x8 qf[4];
#pragma unroll
    for (int s = 0; s < 4; ++s) qf[s] = (bf16x8){0, 0, 0, 0, 0, 0, 0, 0};
    constexpr int NBH = BATCH * BH;
    const int nper = att_units_per_bh(), nx = (nslots % 8 == 0 && NBH % 8 == 0) ? 8 : 1, xg = slot % nx, nw = nslots / nx, len = (NBH / nx) * nper, q0 = slot / nx;
    (void)total;
    if (q0 < len) { att_decode_bh(xg + nx * (q0 / nper), q0 % nper, cur); att_load(F, cur, R); att_loadq(F, cur, qf); }
    for (int q = q0; q < len; q += nw) {
        att_store_lds(F, R);
        lbar();
        AttUnit nxt = cur; bf16x8 qn[4];
#pragma unroll
        for (int s = 0; s < 4; ++s) qn[s] = (bf16x8){0, 0, 0, 0, 0, 0, 0, 0};
        if (q + nw < len) { const int q2 = q + nw; att_decode_bh(xg + nx * (q2 / nper), q2 % nper, nxt); att_load(F, nxt, R); att_loadq(F, nxt, qn); }
        att_compute(F, cur, qf, Cb);
        lbar();
        cur = nxt;
#pragma unroll
        for (int s = 0; s < 4; ++s) qf[s] = qn[s];
    }
    bsync();
}

DEV void scan_store_o(Frame& F, bf16_t* Ob, int b, int h, int dir, int m) {
    const int t2 = F.tid - 256, nchunk = dir ? NCH - 1 - m : m;
    const LAS unsigned char* tile = F.lds + 3 * RECB + (m & 1) * 8192;
#pragma unroll
    for (int k = 0; k < 2; ++k) { const int id = t2 + 256 * k, tau = id >> 3, ck = id & 7, sq = nchunk * 64 + (dir ? 63 - tau : tau);
        *(u32x4*)(Ob + ((size_t)b * SEQ + sq) * CW + h * 64 + ck * 8) = *(const LAS u32x4*)(tile + tau * 128 + ck * 16); }
}
DEV void scan_chains(Frame& F, int slot, int nslots) {
    const int lane = F.lane, w = F.wave, c = lane & 15, g4 = lane >> 4;
    constexpr int NDMA = RECB / 4096;
    static_assert(NDMA == 10 && RECB % 8192 == 0, "the counted waits below assume 10 DMAs per loader wave per record");
    for (int chain = slot; chain < NCHAIN; chain += nslots) {
        const int dir = chain & 1, bhh = chain >> 1, h = bhh % CHN, b = bhh / CHN;
        const unsigned char* recs = F.REC() + (size_t)chain * NCH * RECB;
        const float* gam = F.GAM() + (size_t)chain * NCH;
#pragma unroll
        for (int it = 0; it < 2 * RECB / 8192; ++it) glds16(recs + it * 8192 + w * 1024 + lane * 16, F.lds + it * 8192 + w * 1024);
        ASMV("s_waitcnt vmcnt(0)" ::: "memory"); rawbar(); ASMV("" ::: "memory");
        f32x4 S[4];
#pragma unroll
        for (int i = 0; i < 4; ++i) S[i] = (f32x4){0.f, 0.f, 0.f, 0.f};
        bf16_t* Ob = F.OFB() + (size_t)dir * M * CW;
        int bi = 0;
#pragma unroll 1
        for (int m = 0; m < NCH; ++m) {
            LAS unsigned char* buf = F.lds + bi * RECB;
            if (w >= 4) {
                if (m + 2 < NCH) { const int bn = bi == 0 ? 2 : bi - 1;
                    const unsigned char* src = recs + (size_t)(m + 2) * RECB + (w - 4) * 1024 + lane * 16; LAS unsigned char* dst = F.lds + bn * RECB + (w - 4) * 1024;
#pragma unroll
                    for (int it = 0; it < NDMA; ++it) glds16(src + it * 4096, dst + it * 4096);
                    if (m > 0) scan_store_o(F, Ob, b, h, dir, m - 1);
                    ASMV("s_waitcnt vmcnt(12)" ::: "memory");
                } else { if (m > 0) scan_store_o(F, Ob, b, h, dir, m - 1); ASMV("s_waitcnt vmcnt(2)" ::: "memory"); }
            } else {
                const float gamma = gam[m];
                const LAS unsigned char* Wp = buf; const LAS unsigned char* Qp = buf + 8192; const LAS unsigned char* QKp = buf + 16384; const LAS unsigned char* Ktp = buf + 24576;
                const LAS bf16_t* U = (const LAS bf16_t*)(buf + 32768);
                const int aoff = c * 128 + g4 * 16;
                bf16x8 Sb[2];
#pragma unroll
                for (int ks = 0; ks < 2; ++ks) { u32x4 t; t.x = pk2(S[2 * ks][0], S[2 * ks][1]); t.y = pk2(S[2 * ks][2], S[2 * ks][3]); t.z = pk2(S[2 * ks + 1][0], S[2 * ks + 1][1]); t.w = pk2(S[2 * ks + 1][2], S[2 * ks + 1][3]); Sb[ks] = __builtin_bit_cast(bf16x8, t); }
                f32x4 VN[4];
#pragma unroll
                for (int tt = 0; tt < 4; ++tt) {
                    f32x4 a = {0.f, 0.f, 0.f, 0.f};
#pragma unroll
                    for (int ks = 0; ks < 2; ++ks) a = mfma16(*(const LAS bf16x8*)(Wp + tt * 2048 + aoff + ks * 64), Sb[ks], a);
#pragma unroll
                    for (int i = 0; i < 4; ++i) VN[tt][i] = bf2f(U[(16 * tt + 4 * g4 + i) * 64 + 16 * w + c]) - a[i];
                }
                bf16x8 VNb[2];
#pragma unroll
                for (int ks = 0; ks < 2; ++ks) { u32x4 t; t.x = pk2(VN[2 * ks][0], VN[2 * ks][1]); t.y = pk2(VN[2 * ks][2], VN[2 * ks][3]); t.z = pk2(VN[2 * ks + 1][0], VN[2 * ks + 1][1]); t.w = pk2(VN[2 * ks + 1][2], VN[2 * ks + 1][3]); VNb[ks] = __builtin_bit_cast(bf16x8, t); }
#pragma unroll
                for (int tt = 0; tt < 4; ++tt) {
                    ASMV("" ::: "memory");
                    f32x4 o = {0.f, 0.f, 0.f, 0.f};
#pragma unroll
                    for (int ks = 0; ks < 2; ++ks) o = mfma16(*(const LAS bf16x8*)(Qp + tt * 2048 + aoff + ks * 64), Sb[ks], o);
#pragma unroll
                    for (int ks = 0; ks < 2; ++ks) o = mfma16(*(const LAS bf16x8*)(QKp + tt * 2048 + aoff + ks * 64), VNb[ks], o);
#pragma unroll
                    for (int i = 0; i < 4; ++i) ((LAS bf16_t*)(F.lds + 3 * RECB + (m & 1) * 8192))[(16 * tt + 4 * g4 + i) * 64 + 16 * w + c] = (bf16_t)f2bf(o[i]);
                }
#pragma unroll
                for (int rt = 0; rt < 4; ++rt) {
                    ASMV("" ::: "memory");
                    f32x4 a = S[rt] * gamma;
#pragma unroll
                    for (int ks = 0; ks < 2; ++ks) a = mfma16(*(const LAS bf16x8*)(Ktp + rt * 2048 + aoff + ks * 64), VNb[ks], a);
                    S[rt] = a;
                }
                ASMV("s_waitcnt lgkmcnt(0)" ::: "memory");
            }
            rawbar(); ASMV("" ::: "memory");
            bi = bi == 2 ? 0 : bi + 1;
        }
        if (w >= 4) scan_store_o(F, Ob, b, h, dir, NCH - 1);
        ASMV("s_waitcnt vmcnt(0)" ::: "memory");
        rawbar();
    }
}

DEV void phase_assemble(Frame& F, int L) {
    const int nitems = M * (BH + CHN) * 4;
    const int stride = F.G * NTHREADS;
    u32x4 raw[6]; float dn[3];
#define ASM_LOADS(it_) do { const int i_ = (it_); const bool lv_ = i_ < nitems; const int qd_ = i_ & 3, hd_ = lv_ ? (i_ >> 2) % (BH + CHN) : 0, tk_ = lv_ ? (i_ >> 2) / (BH + CHN) : 0; \
        if (hd_ < BH) { _Pragma("unroll") for (int p_ = 0; p_ < 3; ++p_) { const bf16_t* np_ = F.NUM() + (size_t)p_ * (VT_STRIDE / 2) + (size_t)tk_ * BW + hd_ * 64 + qd_ * 16; raw[2 * p_] = *(const u32x4*)np_; raw[2 * p_ + 1] = *(const u32x4*)(np_ + 8); \
                dn[p_] = F.DEN()[((size_t)p_ * M + tk_) * BH + hd_]; } } \
        else { const int hc_ = hd_ - BH; const bf16_t* of_ = F.OFB() + (size_t)tk_ * CW + hc_ * 64 + qd_ * 16; const bf16_t* ob_ = of_ + (size_t)M * CW; const bf16_t* gp_ = F.PROJ() + (size_t)tk_ * INWP + O_CG + hc_ * 64 + qd_ * 16; \
            raw[0] = *(const u32x4*)of_; raw[1] = *(const u32x4*)(of_ + 8); raw[2] = *(const u32x4*)ob_; raw[3] = *(const u32x4*)(ob_ + 8); raw[4] = *(const u32x4*)gp_; raw[5] = *(const u32x4*)(gp_ + 8); dn[0] = dn[1] = dn[2] = 1.f; } } while (0)
    if (F.wg * NTHREADS < nitems) ASM_LOADS(F.wg * NTHREADS + F.tid);
    for (int it0 = F.wg * NTHREADS; it0 < nitems; it0 += stride) {
        const int it = it0 + F.tid; const bool live = it < nitems;
        const int qd = it & 3, hd = live ? (it >> 2) % (BH + CHN) : 0, tok = live ? (it >> 2) / (BH + CHN) : 0;
        float v[16]; float ss = 0.f; bf16_t* dst;
        if (hd < BH) {
#pragma unroll
            for (int i = 0; i < 16; ++i) v[i] = 0.f;
            float den = 0.f;
#pragma unroll
            for (int p = 0; p < 3; ++p) { float t[16]; unpack8(raw[2 * p], t); unpack8(raw[2 * p + 1], t + 8);
#pragma unroll
                for (int i = 0; i < 16; ++i) v[i] += t[i];
                den += dn[p]; }
            const float inv = 1.0f / den;
#pragma unroll
            for (int i = 0; i < 16; ++i) v[i] *= inv;
            dst = F.ACT() + (size_t)tok * DM + GW + hd * 64 + qd * 16;
        } else {
            const int hc = hd - BH; float bb[16], gt[16];
            unpack8(raw[0], v); unpack8(raw[1], v + 8); unpack8(raw[2], bb); unpack8(raw[3], bb + 8); unpack8(raw[4], gt); unpack8(raw[5], gt + 8);
            const float* og = F.o_norm_g() + (size_t)L * 64 + qd * 16;
#pragma unroll
            for (int i = 0; i < 16; ++i) { v[i] += bb[i]; ss += v[i] * v[i]; v[i] *= og[i] * siluf_(gt[i]); }
            dst = F.ACT() + (size_t)tok * DM + GW + BW + hc * 64 + qd * 16;
        }
        ss += shx(ss, 1); ss += shx(ss, 2);
        const float rstd = (hd < BH) ? 1.0f : frsqrt(ss * (1.f / 64.f) + NORM_EPS);
#pragma unroll
        for (int i = 0; i < 16; ++i) v[i] *= rstd;
        const u32x4 o0 = pack8(v), o1 = pack8(v + 8);
        if (it0 + stride < nitems) ASM_LOADS(it0 + stride + F.tid);
        if (live) { *(u32x4*)dst = o0; *(u32x4*)(dst + 8) = o1; }
    }
#undef ASM_LOADS
}

constexpr int RT_PITCH = DM + 8;
constexpr int RT_HI = 0, RT_LO = 16 * RT_PITCH * 2, RT_G = 2 * RT_LO;
DEV void phase_router(Frame& F, int L) {
    LAS bf16_t* WH = (LAS bf16_t*)(F.lds + RT_HI); LAS bf16_t* WL = (LAS bf16_t*)(F.lds + RT_LO); LAS float* GF = (LAS float*)(F.lds + RT_G);
    for (int i = F.tid; i < DM; i += NTHREADS) GF[i] = F.g_ffn()[(size_t)L * DM + i];
    { constexpr int NF = (DM * 16 + NTHREADS - 1) / NTHREADS;
#pragma unroll 4
      for (int i = 0; i < NF; ++i) { const int id = F.tid + NTHREADS * i; if (id < DM * 16) { const int d = id >> 4, e = id & 15;
          const float w = (e < NEXP) ? F.w_router()[(size_t)L * DM * NEXP + (size_t)d * NEXP + e] * F.g_ffn()[(size_t)L * DM + d] : 0.f;
          const unsigned hi = f2bf(w); const float lo = w - __builtin_bit_cast(float, hi << 16);
          WH[e * RT_PITCH + d] = (bf16_t)hi; WL[e * RT_PITCH + d] = (bf16_t)f2bf(lo); } } }
    bsync();
    const int gw = F.wg * NWAVES + F.wave, NGW = F.G * NWAVES, lane = F.lane, c = lane & 15, g4 = lane >> 4;
    constexpr int NKS = DM / 32;
    for (int rb = gw; rb < M / 16; rb += NGW) {
        const int row = rb * 16 + c;
        u32x4 xv[NKS];
        const u32x4* xp = (const u32x4*)(F.XB(L) + (size_t)row * DM + 8 * g4);
        u32x4* hp = (u32x4*)(F.ACT() + (size_t)row * DM + 8 * g4);
        const LAS bf16_t* whp = WH + c * RT_PITCH + 8 * g4; const LAS bf16_t* wlp = WL + c * RT_PITCH + 8 * g4; const LAS float* gfp = GF + 8 * g4;
#pragma unroll
        for (int ks = 0; ks < NKS; ++ks) xv[ks] = xp[4 * ks];
        f32x4 acc = {0.f, 0.f, 0.f, 0.f}; float ss = 0.f;
#pragma unroll
        for (int ks = 0; ks < NKS; ++ks) {
            const bf16x8 a = __builtin_bit_cast(bf16x8, xv[ks]);
            acc = mfma16(a, *(const LAS bf16x8*)(whp + 32 * ks), acc);
            acc = mfma16(a, *(const LAS bf16x8*)(wlp + 32 * ks), acc);
            float t[8]; unpack8(xv[ks], t);
#pragma unroll
            for (int e = 0; e < 8; ++e) ss += t[e] * t[e];
            if ((ks & 1) == 1) ASMV("" : "+v"(acc), "+v"(ss) :: "memory");
        }
        ss += shx(ss, 16); ss += shx(ss, 32);
        const float rstd = frsqrt(ss * (1.f / DM) + NORM_EPS);
#pragma unroll
        for (int ks = 0; ks < NKS; ++ks) { ASMV("" : "+v"(xv[ks]));
            float t[8]; unpack8(xv[ks], t);
            const f32x4 g0 = *(const LAS f32x4*)(gfp + 32 * ks), g1 = *(const LAS f32x4*)(gfp + 32 * ks + 4);
#pragma unroll
            for (int e = 0; e < 4; ++e) { t[e] *= rstd * g0[e]; t[4 + e] *= rstd * g1[e]; }
            hp[4 * ks] = pack8(t);
            ASMV("" ::: "memory"); }
#pragma unroll
        for (int i = 0; i < 4; ++i) {
            const float rs = __builtin_bit_cast(float, shfl_i(__builtin_bit_cast(int, rstd), 4 * g4 + i));
            float lg = (c < NEXP) ? acc[i] * rs : -3.0e38f;
            float mx = lg;
#pragma unroll
            for (int o = 1; o < 16; o <<= 1) mx = fmaxf(mx, shx(mx, o));
            const float ex = (c < NEXP) ? expf(lg - mx) : 0.f; float sm = ex;
#pragma unroll
            for (int o = 1; o < 16; o <<= 1) sm += shx(sm, o);
            const int m = rb * 16 + 4 * g4 + i, b = m / SEQ, sq = m % SEQ;
            if (c < NEXP) F.AFF()[((size_t)b * NEXP + c) * SEQ + sq] = ex / sm;
        }
    }
}

constexpr int KPT = (SEQ + NTHREADS - 1) / NTHREADS;
DEV unsigned block_sum_u(Frame& F, unsigned v, int parity) {
    LAS unsigned* red = (LAS unsigned*)(F.lds + 1024) + parity * 8;
    float f = (float)v; f = wave_sum(f);
    if (F.lane == 0) red[F.wave] = (unsigned)f;
    bsync();
    unsigned t = 0;
#pragma unroll
    for (int i = 0; i < NWAVES; ++i) t += red[i];
    return t;
}
DEV void phase_topk(Frame& F) {
    const int tid = F.tid, lane = F.lane;
    for (int pair = F.wg; pair < BATCH * NEXP; pair += F.G) {
        const int b = pair / NEXP, e = pair % NEXP;
        const float* aff = F.AFF() + (size_t)pair * SEQ;
        unsigned key[KPT];
#pragma unroll
        for (int i = 0; i < KPT; ++i) { const int s = tid * KPT + i; key[i] = (s < SEQ) ? __builtin_bit_cast(unsigned, aff[s]) : 0u; }
        unsigned prefix = 0u; int par = 0;
#pragma unroll 1
        for (int bit = 30; bit >= 0; --bit) {
            const unsigned cand = prefix | (1u << bit); unsigned cnt = 0;
#pragma unroll
            for (int i = 0; i < KPT; ++i) cnt += (key[i] >= cand) ? 1u : 0u;
            const unsigned tot = block_sum_u(F, cnt, par); par ^= 1;
            if (tot >= (unsigned)CAP) prefix = cand;
        }
        unsigned cgt = 0, ceq = 0;
#pragma unroll
        for (int i = 0; i < KPT; ++i) { cgt += (key[i] > prefix) ? 1u : 0u; ceq += (key[i] == prefix) ? 1u : 0u; }
        const unsigned ngt = block_sum_u(F, cgt, par); par ^= 1;
        const unsigned rr = (unsigned)CAP - ngt;
        unsigned v = cgt | (ceq << 16), inc = v;
#pragma unroll
        for (int d = 1; d < 64; d <<= 1) { const unsigned t = shup(inc, d); if (lane >= d) inc += t; }
        LAS unsigned* wt = (LAS unsigned*)(F.lds + 2048);
        if (lane == 63) wt[F.wave] = inc;
        bsync();
        unsigned base = 0;
#pragma unroll
        for (int i = 0; i < NWAVES; ++i) base += (i < F.wave) ? wt[i] : 0u;
        unsigned excl = base + inc - v; unsigned gtb = excl & 0xffffu, eqb = excl >> 16;
#pragma unroll
        for (int i = 0; i < KPT; ++i) { const int s = tid * KPT + i; if (s < SEQ) {
            const bool isgt = key[i] > prefix, iseq = key[i] == prefix; const bool sel = isgt || (iseq && eqb < rr);
            const unsigned slot = gtb + (eqb < rr ? eqb : rr);
            if (sel) { const size_t row = ((size_t)e * BATCH + b) * CAP + slot; F.IDX()[row] = s; F.GATEV()[row] = __builtin_bit_cast(float, key[i]); }
            F.INV()[((size_t)b * SEQ + s) * NEXP + e] = sel ? (int)slot : -1;
            gtb += isgt ? 1u : 0u; eqb += iseq ? 1u : 0u; } }
        bsync();
    }
}

DEV void phase_pconv(Frame& F, int L, int slot, int nslots) {
    const int gw = slot * NWAVES + F.wave, NGW = nslots * NWAVES, lane = F.lane;
    for (int m0 = gw * 4; m0 < M; m0 += NGW * 4) {
        f32x4 v[4];
#pragma unroll
        for (int r = 0; r < 4; ++r) v[r] = *((const f32x4*)(F.p() + ((size_t)L * M + m0 + r) * PLE) + lane);
#pragma unroll
        for (int r = 0; r < 4; ++r) { u32x2 o; o.x = pk2(v[r][0], v[r][1]); o.y = pk2(v[r][2], v[r][3]); *((u32x2*)(F.PB() + (size_t)(m0 + r) * PLE) + lane) = o; }
    }
}

template <bool DRY> DEV void phase_combine(Frame& F, int L) {
    const int gw = F.wg * NWAVES + F.wave, NGW = F.G * NWAVES, lane = F.lane;
    constexpr int R = 2;
    u32x2 xraw[R][NJ]; int invn[R];
#define CMB_LOADS(m_) do { _Pragma("unroll") for (int r_ = 0; r_ < R; ++r_) { invn[r_] = (lane < NEXP) ? F.INV()[(size_t)((m_) + r_) * NEXP + lane] : -1; \
        _Pragma("unroll") for (int j_ = 0; j_ < NJ; ++j_) xraw[r_][j_] = *((const u32x2*)(F.XB(L) + (size_t)((m_) + r_) * DM) + lane + 64 * j_); } } while (0)
    if (gw * R < M) CMB_LOADS(gw * R);
    for (int m0 = gw * R; m0 < M; m0 += NGW * R) {
        f32x4 v[R][NJ]; int inv[R];
#pragma unroll
        for (int r = 0; r < R; ++r) {
            inv[r] = invn[r];
#pragma unroll
            for (int j = 0; j < NJ; ++j) { const u32x2 y = xraw[r][j]; v[r][j] = (f32x4){lo16(y.x), hi16(y.x), lo16(y.y), hi16(y.y)}; }
        }
        unsigned long long mask[R]; bool any[R], two[R]; u32x2 a0[R][NJ], a1[R][NJ];
#pragma unroll
        for (int r = 0; r < R; ++r) {
            const int b = (m0 + r) / SEQ;
            mask[r] = ballot_(inv[r] >= 0); any[r] = mask[r] != 0ull;
            const int e0 = any[r] ? __builtin_ctzll(mask[r]) : 0; mask[r] &= mask[r] - 1;
            two[r] = mask[r] != 0ull; const int e1 = two[r] ? __builtin_ctzll(mask[r]) : e0; if (two[r]) mask[r] &= mask[r] - 1;
            const int s0 = shfl_i(inv[r], e0), s1 = shfl_i(inv[r], e1);
            const u32x2* y0 = (const u32x2*)(F.YE() + (((size_t)e0 * BATCH + b) * CAP + (any[r] ? s0 : 0)) * DM) + lane;
            const u32x2* y1 = (const u32x2*)(F.YE() + (((size_t)e1 * BATCH + b) * CAP + (any[r] ? s1 : 0)) * DM) + lane;
#pragma unroll
            for (int j = 0; j < NJ; ++j) { a0[r][j] = y0[64 * j]; a1[r][j] = y1[64 * j]; }
        }
#pragma unroll
        for (int r = 0; r < R; ++r) {
#pragma unroll
            for (int j = 0; j < NJ; ++j) {
                if (any[r]) { v[r][j][0] += lo16(a0[r][j].x); v[r][j][1] += hi16(a0[r][j].x); v[r][j][2] += lo16(a0[r][j].y); v[r][j][3] += hi16(a0[r][j].y); }
                if (two[r]) { v[r][j][0] += lo16(a1[r][j].x); v[r][j][1] += hi16(a1[r][j].x); v[r][j][2] += lo16(a1[r][j].y); v[r][j][3] += hi16(a1[r][j].y); } }
        }
#pragma unroll
        for (int r = 0; r < R; ++r) {
            const int b = (m0 + r) / SEQ;
            unsigned long long mk = mask[r];
            while (mk) {
                const int e0 = __builtin_ctzll(mk); mk &= mk - 1;
                const bool tw = mk != 0ull; const int e1 = tw ? __builtin_ctzll(mk) : e0; if (tw) mk &= mk - 1;
                const int s0 = shfl_i(inv[r], e0), s1 = shfl_i(inv[r], e1);
                const u32x2* y0 = (const u32x2*)(F.YE() + (((size_t)e0 * BATCH + b) * CAP + s0) * DM) + lane;
                const u32x2* y1 = (const u32x2*)(F.YE() + (((size_t)e1 * BATCH + b) * CAP + s1) * DM) + lane;
                u32x2 b0[NJ], b1[NJ];
#pragma unroll
                for (int j = 0; j < NJ; ++j) { b0[j] = y0[64 * j]; b1[j] = y1[64 * j]; }
#pragma unroll
                for (int j = 0; j < NJ; ++j) { v[r][j][0] += lo16(b0[j].x); v[r][j][1] += hi16(b0[j].x); v[r][j][2] += lo16(b0[j].y); v[r][j][3] += hi16(b0[j].y);
                    if (tw) { v[r][j][0] += lo16(b1[j].x); v[r][j][1] += hi16(b1[j].x); v[r][j][2] += lo16(b1[j].y); v[r][j][3] += hi16(b1[j].y); } }
            }
        }
        if (m0 + NGW * R < M) CMB_LOADS(m0 + NGW * R);
#pragma unroll
        for (int r = 0; r < R; ++r) {
            const int m = m0 + r;
            u32x2* xr = (u32x2*)((DRY ? F.XE() : F.XB(L)) + (size_t)m * DM) + lane;
            float s = 0.f;
#pragma unroll
            for (int j = 0; j < NJ; ++j) { u32x2 xo; xo.x = pk2(v[r][j][0], v[r][j][1]); xo.y = pk2(v[r][j][2], v[r][j][3]); xr[64 * j] = xo; s += (v[r][j][0] * v[r][j][0] + v[r][j][1] * v[r][j][1]) + (v[r][j][2] * v[r][j][2] + v[r][j][3] * v[r][j][3]); }
            const float rstd = frsqrt(wave_sum(s) * (1.f / DM) + NORM_EPS);
            if (lane == 0 && !DRY) F.RSTD()[M + m] = rstd;
        }
    }
#undef CMB_LOADS
}

__global__ void __launch_bounds__(NTHREADS, 2) mega_fwd(Args args) {
#ifndef HOST_EMU
    extern __shared__ __attribute__((aligned(16))) unsigned char lds_raw[];
    LAS unsigned char* lds = (LAS unsigned char*)lds_raw;
#else
    unsigned char* lds = emu::g_lds;
#endif
    Frame F;
    F.lds = lds; F.tid = threadIdx.x; F.lane = F.tid & 63; F.wave = rfl(F.tid >> 6); F.G = gridDim.x; F.wg = blockIdx.x; F.a = &args;
    unsigned char* ws = args.ws;
    const int lo = args.ph_lo, hi = args.ph_hi;
#ifndef HOST_EMU
    volatile LAS unsigned* MISC = (volatile LAS unsigned*)(lds + LDS_MISC);
    if (F.tid < 64) MISC[F.tid] = 0u;
    __syncthreads();
    XcdBarrier bar; bar.bar = (unsigned*)(ws + WS_CTL) + 4096; bar.x = 0; bar.st = MISC;
    if (hi - lo > 1) bar = xcd_barrier_post((unsigned*)(ws + WS_CTL) + 4096, MISC);
#define SEAM(k) do { if ((k) + 1 < hi) xcd_barrier(bar); } while (0)
#else
#define SEAM(k) do {} while (0)
#endif
#ifndef PH_MASK
#define PH_MASK 0xFFFFFFFFu
#endif
#ifndef DUP_MASK
#define DUP_MASK 0u
#endif
#define REPS(j) (int)(1u + ((DUP_MASK >> (j)) & 1u))
#define IN(k) (((PH_MASK >> (((k) == 0) ? 0 : (((k) - 1) % NPH) + 1)) & 1u) && lo <= (k) && (k) < hi)
#pragma unroll 1
    for (int L = -1; L < DEPTH; ++L) {
        const int pb = 1 + L * NPH;
        ASMV("" : "+v"(F.tid)); ASMV("" : "+s"(F.wg), "+s"(F.G)); F.lane = F.tid & 63; F.wave = rfl(F.tid >> 6);
        if (L >= 0 && IN(pb + 0)) { if (L == 0 || (F.wg & 1)) pw_experts(F, L, F.wg * NWAVES + F.wave, F.G * NWAVES); if (L == 0) { phase_pconv(F, 0, F.wg, F.G); SEAM(pb + 1); } else bsync(); }
        if (L >= 0) {
        if (IN(pb + 2)) {
            pg8::Gemm g{F.XB(L), F.WIN(), M, INWP, DM, 0, 0, nullptr}; pg8::StaticOrder S; S.init(M, INWP, F.G, F.wg);
            pg8::EpiBf16 E{F.PROJ(), INWP, F.XPART(), 1.0f / DM, nullptr}; for (int rep = 0; rep < REPS(3); ++rep) pg8::gemm_phase(lds, g, S, E, F.tid);
            {
                const int nu = (M / 256) * (INWP / 256), rem = nu % F.G, g2 = rem ? (F.wg >= rem ? F.G - rem : (1 << 28)) : F.G, c2 = F.wg;
                pg8::Gemm ge{F.PB(), F.WPLE(), M, DM, PLE, 0, 0, nullptr}; pg8::StaticOrder Se; Se.init(M, DM, g2, c2);
                pg8::EpiBf16 Ee{F.XB(L + 1), DM, nullptr, 0.f, F.EPART()}; pg8::gemm_phase(lds, ge, Se, Ee, F.tid); }
            if (L >= 1 && !(F.wg & 1)) { bsync(); pw_experts(F, L, F.wg * NWAVES + F.wave, F.G * NWAVES); }
            SEAM(pb + 2);
        }
        if (IN(pb + 3)) { for (int rep = 0; rep < REPS(4); ++rep) { gmlp_units(F, L, F.wg, F.G, 0, GM_SPLIT); attnprep_units(F, L); gdnprep_units(F, L); } SEAM(pb + 3); }
        if (IN(pb + 4)) {
            int nsc = NCHAIN < (F.G * 3) / 4 ? NCHAIN : (F.G * 3) / 4; if (nsc < 1) nsc = 1;
            for (int rep = 0; rep < REPS(5); ++rep) {
            if (F.G == 1) { scan_chains(F, 0, 1); attn_units(F, L, 0, 1); }
            else if (F.wg < nsc) scan_chains(F, F.wg, nsc);
            else attn_units(F, L, F.wg - nsc, F.G - nsc);
            }
            if (F.G == 1 || F.wg >= nsc) gmlp_units(F, L, F.G == 1 ? 0 : F.wg - nsc, F.G == 1 ? 1 : F.G - nsc, GM_SPLIT, GM_N);
            if (L + 1 < DEPTH && (F.G == 1 || F.wg >= nsc)) phase_pconv(F, L + 1, F.G == 1 ? 0 : F.wg - nsc, F.G == 1 ? 1 : F.G - nsc);
            SEAM(pb + 4);
        }
        if (IN(pb + 5)) { for (int rep = 0; rep < REPS(6); ++rep) phase_assemble(F, L); SEAM(pb + 5); }
        if (IN(pb + 6)) {
            pg8::Gemm g{F.ACT(), F.WOUT(), M, DM, DM, 0, 0, nullptr}; pg8::StaticOrder S; S.init(M, DM, F.G, F.wg);
            pg8::EpiResB E{F.XB(L), F.XB(L), DM}; pg8::gemm_phase(lds, g, S, E, F.tid); SEAM(pb + 6);
        }
        if (IN(pb + 7)) { for (int rep = 0; rep < REPS(8); ++rep) { phase_router(F, L); bsync(); } SEAM(pb + 7); }
        }
        if (L >= 0 ? IN(pb + 8) : IN(0)) {
            const int npair = BATCH * NEXP; int slot = F.wg, nslots = F.G;
            if (L >= 0) { phase_topk(F); if (F.G > npair) { slot = F.wg - npair; nslots = F.G - npair; } } else phase_prologue(F);
            bsync();
            if (L + 1 < DEPTH && slot >= 0) phase_pw(F, L + 1, slot, nslots);
            if (L >= 0) SEAM(pb + 8);
        }
        if (L >= 0) {
        if (IN(pb + 10)) {
            pg8::Gemm g{F.ACT(), F.WGU(), MR, 2 * DE, DM, ROWS_E / 256, (size_t)2 * DE * DM * 2, F.IDX()}; pg8::StaticOrder S; S.init(MR, 2 * DE, F.G, F.wg);
            pg8::EpiSwiGLU E{F.HID(), DE, F.RSROW()}; for (int rep = 0; rep < REPS(11); ++rep) pg8::gemm_phase<pg8::EpiSwiGLU, true>(lds, g, S, E, F.tid); SEAM(pb + 10);
        }
        if (IN(pb + 11)) {
            { pg8::Gemm g{F.HID(), F.WD(), MR, DM, DE, ROWS_E / 256, (size_t)DM * DE * 2, nullptr}; pg8::StaticOrder S; S.init(MR, DM, F.G, F.wg);
              pg8::EpiScaleBf16 E{F.YE(), DM, F.GATEV()}; for (int rep = 0; rep < REPS(12); ++rep) pg8::gemm_phase(lds, g, S, E, F.tid); }
            SEAM(pb + 11);
        }
        }
        if (L >= 0 ? IN(pb + 12) : IN(0)) {
            if (L >= 0) phase_combine<false>(F, L);
            if (L >= 0) SEAM(pb + 12); else SEAM(0);
        }
        if (L >= 0) {
        if (IN(pb + 13)) {
            pg8::Gemm g{F.XB(L), F.WPG(L), M, DM, DM, 0, 0, nullptr}; pg8::StaticOrder S; S.init(M, DM, F.G, F.wg);
            pg8::EpiPleGate E{F.XB(L), F.XB(L + 1), F.XB(L + 1), F.EPART(), F.g_ple() + (size_t)L * DM, F.XPART(), (L == DEPTH - 1) ? F.out() : (float*)nullptr, DM, F.RSTD() + M}; pg8::gemm_phase(lds, g, S, E, F.tid); SEAM(pb + 13);
        }
        }
    }
#undef IN
#undef SEAM
}

#ifndef N_LAUNCH_MODE
#define N_LAUNCH_MODE 1
#endif
extern "C" void kernel_launch(void* const* d_in, const int* in_sizes, int n_in, void* d_out, int out_size, void* d_ws, size_t ws_size, hipStream_t stream) {
    Args a;
    memset(&a, 0, sizeof(a));
    for (int i = 0; i < 25; ++i) a.in[i] = d_in[i];
    a.out = (float*)d_out; a.ws = (unsigned char*)d_ws;
#ifndef HOST_EMU
    static int grid = 0;
    if (grid == 0) {
        int dev = 0, cus = 0;
        if (n_in != 25 || out_size != M * DM || ws_size < WS_END) { fprintf(stderr, "kernel_launch: unexpected shapes (n_in %d out %d ws %zu need %zu)\n", n_in, out_size, ws_size, (size_t)WS_END); grid = -1; return; }
        if (hipGetDevice(&dev) != hipSuccess || hipDeviceGetAttribute(&cus, hipDeviceAttributeMultiprocessorCount, dev) != hipSuccess) { grid = -1; return; }
        if (hipFuncSetAttribute((const void*)mega_fwd, hipFuncAttributeMaxDynamicSharedMemorySize, LDS_BYTES) != hipSuccess) { fprintf(stderr, "kernel_launch: hipFuncSetAttribute failed\n"); grid = -1; return; }
        int per_cu = 0;
        if (hipOccupancyMaxActiveBlocksPerMultiprocessor(&per_cu, (const void*)mega_fwd, NTHREADS, LDS_BYTES) != hipSuccess || per_cu < 1) fprintf(stderr, "kernel_launch: occupancy query says %d\n", per_cu);
        (void)hipGetLastError();
        grid = cus;
    }
    if (grid < 0) return;
    (void)hipMemsetAsync((char*)d_ws + WS_CTL, 0, CTL_BYTES, stream);
    if (N_LAUNCH_MODE == 1) { a.ph_lo = 0; a.ph_hi = NPHASES; hipLaunchKernelGGL(mega_fwd, dim3(grid), dim3(NTHREADS), LDS_BYTES, stream, a); }
    else for (int ph = 0; ph < NPHASES; ++ph) { a.ph_lo = ph; a.ph_hi = ph + 1; hipLaunchKernelGGL(mega_fwd, dim3(grid), dim3(NTHREADS), LDS_BYTES, stream, a); }
#else
    (void)in_sizes; (void)n_in; (void)out_size; (void)ws_size; (void)stream;
    for (int ph = emu_ph_lo; ph < emu_ph_hi && ph < NPHASES; ++ph) { a.ph_lo = ph; a.ph_hi = ph + 1; Args aa = a; emu::launch([aa]() { mega_fwd(aa); }, emu_grid, NTHREADS, LDS_BYTES); fprintf(stderr, "phase %d done\n", ph); }
#endif
}
```
